# Optimizing an MI355X kernel written in HIP

```python
import jax, jax.numpy as jnp
from jax import lax
import numpy as np

D_MODEL = 1024
BATCH = 8
SEQ = 4096
DEPTH = 4

N_MIXERS = 2
HEAD_DIM = 64
N_HEADS = D_MODEL // HEAD_DIM
MIX_WIDTH = N_HEADS * HEAD_DIM
N_KV_A = max(1, N_HEADS // 8)
N_KV_B = max(1, N_HEADS // 4)
WINDOW = 128
MOBA_BLOCK = 256
MOBA_TOPK = 3
MOBA_Q_CHUNK = 16
ROPE_THETA = 10000.0
NORM_EPS = 1e-5
NEG = -1e30
N_LAYERS_A = (DEPTH + 1) // 2
N_LAYERS_B = DEPTH // 2
IN_A = 2 * MIX_WIDTH + 2 * N_KV_A * HEAD_DIM
IN_B = 2 * MIX_WIDTH + 2 * N_KV_B * HEAD_DIM

kernel_name = "hybrid_swa_sink_moba_gated"


def rmsnorm(x, g):
    xf = x.astype(jnp.float32)
    y = xf * lax.rsqrt(jnp.mean(xf * xf, axis=-1, keepdims=True) + NORM_EPS)
    return (y * g.astype(jnp.float32)).astype(x.dtype)


def rope_tables(seq):
    pos = jnp.arange(seq, dtype=jnp.float32)
    inv = ROPE_THETA ** (-jnp.arange(0, HEAD_DIM, 2, dtype=jnp.float32) / HEAD_DIM)
    ang = pos[:, None] * inv[None, :]
    return jnp.cos(ang), jnp.sin(ang)


def apply_rope(x, cos, sin):
    half = HEAD_DIM // 2
    x1, x2 = x[..., :half], x[..., half:]
    c, s = cos[None, :, None, :], sin[None, :, None, :]
    out = jnp.concatenate([x1 * c - x2 * s, x2 * c + x1 * s], axis=-1)
    return out.astype(x.dtype)


def split_proj(h, w_in, n_kv):
    B, S, _ = h.shape
    proj = h @ w_in
    kvw = n_kv * HEAD_DIM
    q = proj[..., :MIX_WIDTH].reshape(B, S, N_HEADS, HEAD_DIM)
    k = proj[..., MIX_WIDTH:MIX_WIDTH + kvw].reshape(B, S, n_kv, HEAD_DIM)
    v = proj[..., MIX_WIDTH + kvw:MIX_WIDTH + 2 * kvw].reshape(B, S, n_kv, HEAD_DIM)
    z = proj[..., MIX_WIDTH + 2 * kvw:]
    return q, k, v, z


def sliding_window_sink_attention(q, k, v, sinks):
    B, S, H, d = q.shape
    kvh = k.shape[2]
    G = H // kvh
    nq = S // WINDOW
    scale = 1.0 / np.sqrt(d)
    qb = q.reshape(B, nq, WINDOW, kvh, G, d)
    pad = ((0, 0), (WINDOW, 0), (0, 0), (0, 0))
    kb = jnp.pad(k, pad).reshape(B, nq + 1, WINDOW, kvh, d)
    vb = jnp.pad(v, pad).reshape(B, nq + 1, WINDOW, kvh, d)
    kband = jnp.concatenate([kb[:, :-1], kb[:, 1:]], axis=2)
    vband = jnp.concatenate([vb[:, :-1], vb[:, 1:]], axis=2)
    s = jnp.einsum('bnikgd,bnjkd->bnkgij', qb, kband).astype(jnp.float32) * scale
    i = jnp.arange(WINDOW)[:, None]
    j = jnp.arange(2 * WINDOW)[None, :]
    band = (j > i) & (j <= i + WINDOW)
    not_pad = (jnp.arange(nq)[:, None, None] > 0) | (j[None] >= WINDOW)
    mask = band[None] & not_pad
    s = jnp.where(mask[None, :, None, None], s, NEG)
    sink = jnp.broadcast_to(sinks.astype(jnp.float32).reshape(kvh, G)[None, None, :, :, None, None],
                            s.shape[:-1] + (1,))
    p = jax.nn.softmax(jnp.concatenate([s, sink], axis=-1), axis=-1)[..., :-1]
    o = jnp.einsum('bnkgij,bnjkd->bnikgd', p.astype(v.dtype), vband)
    return o.reshape(B, S, H, d)


def moba_attention(q, k, v):
    B, S, H, d = q.shape
    kvh = k.shape[2]
    G = H // kvh
    nb = -(-S // MOBA_BLOCK)
    Sp = nb * MOBA_BLOCK
    scale = 1.0 / np.sqrt(d)
    pad = ((0, 0), (0, Sp - S), (0, 0), (0, 0))
    kblk = jnp.pad(k, pad).reshape(B, nb, MOBA_BLOCK, kvh, d).transpose(0, 3, 1, 2, 4)
    vblk = jnp.pad(v, pad).reshape(B, nb, MOBA_BLOCK, kvh, d).transpose(0, 3, 1, 2, 4)
    kmean = jnp.mean(kblk.astype(jnp.float32), axis=3)
    qg = q.reshape(B, S, kvh, G, d)
    gate = jnp.einsum('bskgd,bknd->bskgn', qg.astype(jnp.float32), kmean)
    qblock = jnp.arange(S) // MOBA_BLOCK
    past = jnp.arange(nb)[None, :] < qblock[:, None]
    gate = jnp.where(past[None, :, None, None, :], gate, NEG)
    kk = min(MOBA_TOPK, nb)
    _, idx = lax.top_k(gate, kk)
    nc = S // MOBA_Q_CHUNK
    q_c = qg.reshape(B, nc, MOBA_Q_CHUNK, kvh, G, d).transpose(1, 0, 2, 3, 4, 5)
    idx_c = idx.reshape(B, nc, MOBA_Q_CHUNK, kvh, G, kk).transpose(1, 0, 2, 3, 4, 5)
    bi = jnp.arange(B)[:, None, None, None, None]
    ki = jnp.arange(kvh)[None, None, :, None, None]

    def chunk(args):
        ci, qc, ic = args
        t0 = ci * MOBA_Q_CHUNK
        t = t0 + jnp.arange(MOBA_Q_CHUNK)
        cblk = t0 // MOBA_BLOCK
        ksel = kblk[bi, ki, ic]
        vsel = vblk[bi, ki, ic]
        s_sel = jnp.einsum('bqkgd,bqkgsnd->bqkgsn', qc, ksel).astype(jnp.float32) * scale
        slot_ok = jnp.arange(kk) < cblk
        s_sel = jnp.where(slot_ok[:, None], s_sel, NEG)
        kown = lax.dynamic_index_in_dim(kblk, cblk, axis=2, keepdims=False)
        vown = lax.dynamic_index_in_dim(vblk, cblk, axis=2, keepdims=False)
        s_own = jnp.einsum('bqkgd,bknd->bqkgn', qc, kown).astype(jnp.float32) * scale
        kpos = cblk * MOBA_BLOCK + jnp.arange(MOBA_BLOCK)
        causal = kpos[None, :] <= t[:, None]
        s_own = jnp.where(causal[None, :, None, None, :], s_own, NEG)
        nsel = kk * MOBA_BLOCK
        logits = jnp.concatenate([s_sel.reshape(B, MOBA_Q_CHUNK, kvh, G, nsel), s_own], axis=-1)
        p = jax.nn.softmax(logits, axis=-1).astype(v.dtype)
        o = jnp.einsum('bqkgm,bqkgmd->bqkgd', p[..., :nsel],
                       vsel.reshape(B, MOBA_Q_CHUNK, kvh, G, nsel, d))
        o = o + jnp.einsum('bqkgn,bknd->bqkgd', p[..., nsel:], vown)
        return o

    out = lax.map(chunk, (jnp.arange(nc), q_c, idx_c))
    return out.transpose(1, 0, 2, 3, 4, 5).reshape(B, S, H, d)


def setup_inputs(seed: int = 0) -> dict:
    key = jax.random.key(seed)
    ks = jax.random.split(key, 7)
    x = jax.random.normal(ks[0], (BATCH, SEQ, D_MODEL), jnp.float32)
    norm_g = 1.0 + 0.02 * jax.random.normal(ks[1], (DEPTH, D_MODEL), jnp.float32)
    w_in_a = jax.random.normal(ks[2], (N_LAYERS_A, D_MODEL, IN_A), jnp.float32) * D_MODEL ** -0.5
    sinks_a = jax.random.normal(ks[3], (N_LAYERS_A, N_HEADS), jnp.float32)
    w_in_b = jax.random.normal(ks[4], (N_LAYERS_B, D_MODEL, IN_B), jnp.float32) * D_MODEL ** -0.5
    w_out = jax.random.normal(ks[5], (DEPTH, MIX_WIDTH, D_MODEL), jnp.float32) * MIX_WIDTH ** -0.5
    final_g = 1.0 + 0.02 * jax.random.normal(ks[6], (D_MODEL,), jnp.float32)
    return {"x": x, "norm_g": norm_g, "w_in_a": w_in_a, "sinks_a": sinks_a,
            "w_in_b": w_in_b, "w_out": w_out, "final_g": final_g}


def reference(x, norm_g, w_in_a, sinks_a, w_in_b, w_out, final_g):
    B, S, _ = x.shape
    cos, sin = rope_tables(S)
    h = x
    for i in range(DEPTH):
        hn = rmsnorm(h, norm_g[i])
        j = i // N_MIXERS
        if i % N_MIXERS == 0:
            q, k, v, z = split_proj(hn, w_in_a[j], N_KV_A)
            q, k = apply_rope(q, cos, sin), apply_rope(k, cos, sin)
            o = sliding_window_sink_attention(q, k, v, sinks_a[j])
        else:
            q, k, v, z = split_proj(hn, w_in_b[j], N_KV_B)
            q, k = apply_rope(q, cos, sin), apply_rope(k, cos, sin)
            o = moba_attention(q, k, v)
        o = o.reshape(B, S, MIX_WIDTH) * jax.nn.silu(z)
        h = h + o @ w_out[i]
    return rmsnorm(h, final_g)
```

```cpp
#include <hip/hip_runtime.h>
#include <cstdint>
#include <cstdio>

typedef unsigned short bf16_t;
typedef short bf16x8 __attribute__((ext_vector_type(8)));
typedef float f32x4 __attribute__((ext_vector_type(4)));
typedef unsigned u32x4 __attribute__((ext_vector_type(4)));

constexpr int BATCH = 8, SEQ = 4096, DM = 1024, DEPTH = 4, HD = 64, NH = 16;
constexpr int M = BATCH * SEQ;
constexpr int IN_A = 2304, IN_B = 2560;
constexpr int WINDOW = 128, MBLK = 256, NBLK = SEQ / MBLK;
constexpr float EPS = 1e-5f;
constexpr float LOG2E = 1.4426950408889634f;
constexpr float C2 = 0.125f * LOG2E;

constexpr size_t MiB = 1u << 20;
constexpr size_t WS_CTL = 0, WS_ROPE = 1 * MiB, WS_W1T = 2 * MiB, WS_W2T = 22 * MiB, WS_SS = 30 * MiB, WS_KS = 32 * MiB;
constexpr size_t WS_HB = 64 * MiB, WS_Q = 128 * MiB, WS_Z = 192 * MiB, WS_G = 256 * MiB, WS_K = 320 * MiB, WS_V = 336 * MiB, WS_END = 352 * MiB;
constexpr size_t W1T_STRIDE = 5 * MiB, W2T_STRIDE = 2 * MiB;

__device__ __forceinline__ unsigned f2bf(float f) { unsigned u = __builtin_bit_cast(unsigned, f); return (u + 0x7fffu + ((u >> 16) & 1u)) >> 16; }
__device__ __forceinline__ float bf2f(unsigned h) { return __builtin_bit_cast(float, h << 16); }
__host__ __device__ __forceinline__ int dmap(int cc) { return (((cc >> 2) & 1) << 5) | ((cc >> 5) << 4) | (((cc >> 3) & 3) << 2) | (cc & 3); }
__host__ __device__ __forceinline__ int dinv(int d) { return (((d >> 4) & 1) << 5) | (((d >> 2) & 3) << 3) | ((d >> 5) << 2) | (d & 3); }
__device__ __forceinline__ float wave_sum(float v) {
#pragma unroll
    for (int o = 1; o < 64; o <<= 1) v += __shfl_xor(v, o);
    return v;
}
__device__ __forceinline__ float wave_max(float v) {
#pragma unroll
    for (int o = 1; o < 64; o <<= 1) v = fmaxf(v, __shfl_xor(v, o));
    return v;
}

__global__ void k_prep_rope(float2* tab) {
    const int idx = blockIdx.x * blockDim.x + threadIdx.x; if (idx >= SEQ * 32) return;
    const int pos = idx >> 5, i = idx & 31;
    const float inv = (float)pow(10000.0, -(double)i / 32.0);
    const float ang = (float)pos * inv;
    tab[idx] = make_float2((float)cos((double)ang), (float)sin((double)ang));
}
__global__ void k_prep_w1(const float* __restrict__ Win, const float* __restrict__ g, bf16_t* __restrict__ W1t, int IN, int KVW) {
    const size_t idx = (size_t)blockIdx.x * blockDim.x + threadIdx.x; if (idx >= (size_t)IN * DM) return;
    const int cp = (int)(idx / DM), k = (int)(idx % DM);
    int col = cp;
    if (cp < 1024 + KVW) col = (cp & ~63) + dmap(cp & 63);
    W1t[idx] = (bf16_t)f2bf(g[k] * Win[(size_t)k * IN + col]);
}
__global__ void k_prep_w2(const float* __restrict__ Wout, bf16_t* __restrict__ W2t) {
    const size_t idx = (size_t)blockIdx.x * blockDim.x + threadIdx.x; if (idx >= (size_t)DM * DM) return;
    const int n = (int)(idx / DM), k = (int)(idx % DM);
    W2t[idx] = (bf16_t)f2bf(Wout[(size_t)k * DM + n]);
}
__global__ void k_prep_x(const float* __restrict__ x, bf16_t* __restrict__ Hb, float* __restrict__ ss) {
    const int row = (blockIdx.x * blockDim.x + threadIdx.x) >> 6, lane = threadIdx.x & 63; if (row >= M) return;
    const f32x4* xr = (const f32x4*)(x + (size_t)row * DM) + lane; float s = 0.f;
    unsigned long long* o8 = (unsigned long long*)(Hb + (size_t)row * DM) + lane;
#pragma unroll
    for (int j = 0; j < 4; ++j) { const f32x4 v = xr[64 * j]; s += (v.x * v.x + v.y * v.y) + (v.z * v.z + v.w * v.w);
        o8[64 * j] = (unsigned long long)(f2bf(v.x) | (f2bf(v.y) << 16)) | ((unsigned long long)(f2bf(v.z) | (f2bf(v.w) << 16)) << 32); }
    s = wave_sum(s);
    if (lane < 16) ss[(size_t)row * 16 + lane] = lane == 0 ? s : 0.f;
}

template <int KVH>
__global__ __launch_bounds__(256) void k_gemm1_naive(const bf16_t* __restrict__ Hb, const bf16_t* __restrict__ W1t, const float* __restrict__ ss, const float2* __restrict__ rope,
                                                     bf16_t* __restrict__ Q, bf16_t* __restrict__ K, bf16_t* __restrict__ V, bf16_t* __restrict__ Z) {
    constexpr int KVW = KVH * 64, IN = 2048 + 2 * KVW, NG = IN / 64;
    const int wave = (int)(((size_t)blockIdx.x * 256 + threadIdx.x) >> 6), lane = threadIdx.x & 63;
    const int rt = wave / NG, cg = wave % NG; if (rt >= M / 16) return;
    const int row0 = rt * 16, lr = lane & 15, lq = lane >> 4;
    const bool rot = cg < 16 + KVH;
    f32x4 acc[4];
#pragma unroll
    for (int nb = 0; nb < 4; ++nb) acc[nb] = (f32x4){0.f, 0.f, 0.f, 0.f};
    const bf16_t* ap = Hb + (size_t)(row0 + lr) * DM + 8 * lq;
    const bf16_t* bp[4];
#pragma unroll
    for (int nb = 0; nb < 4; ++nb) { const int d = 16 * nb + lr; bp[nb] = W1t + (size_t)(cg * 64 + (rot ? dinv(d) : d)) * DM + 8 * lq; }
    for (int k0 = 0; k0 < DM; k0 += 32) {
        const bf16x8 a = *(const bf16x8*)(ap + k0);
#pragma unroll
        for (int nb = 0; nb < 4; ++nb) { const bf16x8 b = *(const bf16x8*)(bp[nb] + k0); acc[nb] = __builtin_amdgcn_mfma_f32_16x16x32_bf16(a, b, acc[nb], 0, 0, 0); }
    }
#pragma unroll
    for (int reg = 0; reg < 4; ++reg) {
        const int row = row0 + 4 * lq + reg, pos = row & (SEQ - 1);
        const f32x4* sp = (const f32x4*)(ss + (size_t)row * 16);
        const f32x4 s0 = sp[0], s1 = sp[1], s2 = sp[2], s3 = sp[3];
        const float tot = ((s0.x + s0.y) + (s0.z + s0.w)) + ((s1.x + s1.y) + (s1.z + s1.w)) + ((s2.x + s2.y) + (s2.z + s2.w)) + ((s3.x + s3.y) + (s3.z + s3.w));
        const float rstd = rsqrtf(tot * (1.0f / DM) + EPS);
        if (rot) {
            const bool isq = cg < 16; const float sc = isq ? rstd * C2 : rstd;
            bf16_t* dst = isq ? Q + (size_t)row * DM + cg * 64 : K + (size_t)row * KVW + (cg - 16) * 64;
#pragma unroll
            for (int nb = 0; nb < 2; ++nb) { const int i = 16 * nb + lr; const float2 cs = rope[pos * 32 + i];
                const float x1 = acc[nb][reg] * sc, x2 = acc[nb + 2][reg] * sc;
                dst[i] = (bf16_t)f2bf(x1 * cs.x - x2 * cs.y); dst[i + 32] = (bf16_t)f2bf(x2 * cs.x + x1 * cs.y); }
        } else {
            const bool isv = cg < 16 + 2 * KVH;
            bf16_t* dst = isv ? V + (size_t)row * KVW + (cg - 16 - KVH) * 64 : Z + (size_t)row * DM + (cg - 16 - 2 * KVH) * 64;
#pragma unroll
            for (int nb = 0; nb < 4; ++nb) dst[16 * nb + lr] = (bf16_t)f2bf(acc[nb][reg] * rstd);
        }
    }
}
__global__ void k_ksum_naive(const bf16_t* __restrict__ K, float* __restrict__ KS) {
    const int bb = blockIdx.x, c = threadIdx.x;
    float s = 0.f;
    for (int r = 0; r < MBLK; ++r) s += bf2f(K[((size_t)bb * MBLK + r) * 256 + c]);
    KS[((size_t)bb * 2 + 0) * 256 + c] = s; KS[((size_t)bb * 2 + 1) * 256 + c] = 0.f;
}

__global__ __launch_bounds__(256) void k_attn_swa_naive(const bf16_t* __restrict__ Q, const bf16_t* __restrict__ K, const bf16_t* __restrict__ V, const bf16_t* __restrict__ Z,
                                                        const float* __restrict__ sinks, bf16_t* __restrict__ G) {
    __shared__ float sh[4][64 + 128];
    const int w = threadIdx.x >> 6, lane = threadIdx.x & 63;
    const int gw = blockIdx.x * 4 + w, row = gw >> 4, h = gw & 15, t = row & (SEQ - 1), kvh = h >> 3;
    float* qs = sh[w]; float* ps = sh[w] + 64;
    qs[lane] = bf2f(Q[(size_t)row * DM + h * 64 + lane]);
    __syncthreads();
    float s[2];
#pragma unroll
    for (int r = 0; r < 2; ++r) { const int kk = lane + 64 * r; float a = -INFINITY;
        if (kk <= t) { const u32x4* kp = (const u32x4*)(K + (size_t)(row - kk) * 128 + kvh * 64); a = 0.f;
#pragma unroll
            for (int c = 0; c < 8; ++c) { const u32x4 v = kp[c];
                a += qs[8 * c + 0] * bf2f(v.x & 0xffff) + qs[8 * c + 1] * bf2f(v.x >> 16) + qs[8 * c + 2] * bf2f(v.y & 0xffff) + qs[8 * c + 3] * bf2f(v.y >> 16)
                   + qs[8 * c + 4] * bf2f(v.z & 0xffff) + qs[8 * c + 5] * bf2f(v.z >> 16) + qs[8 * c + 6] * bf2f(v.w & 0xffff) + qs[8 * c + 7] * bf2f(v.w >> 16); } }
        s[r] = a; }
    const float sinkl = sinks[h] * LOG2E;
    const float m = fmaxf(wave_max(fmaxf(s[0], s[1])), sinkl);
    const float p0 = exp2f(s[0] - m), p1 = exp2f(s[1] - m);
    const float l = wave_sum(p0 + p1) + exp2f(sinkl - m);
    ps[lane] = p0; ps[lane + 64] = p1;
    __syncthreads();
    const int nk = t + 1 < WINDOW ? t + 1 : WINDOW; float o = 0.f;
    for (int kk = 0; kk < nk; ++kk) o += ps[kk] * bf2f(V[(size_t)(row - kk) * 128 + kvh * 64 + lane]);
    o /= l;
    const float z = bf2f(Z[(size_t)row * DM + h * 64 + lane]);
    G[(size_t)row * DM + h * 64 + lane] = (bf16_t)f2bf(o * z / (1.f + __expf(-z)));
}
__global__ __launch_bounds__(256) void k_attn_moba_naive(const bf16_t* __restrict__ Q, const bf16_t* __restrict__ K, const bf16_t* __restrict__ V, const bf16_t* __restrict__ Z,
                                                         const float* __restrict__ KS, bf16_t* __restrict__ G) {
    __shared__ float sh[4][64 + 1024];
    const int w = threadIdx.x >> 6, lane = threadIdx.x & 63;
    const int gw = blockIdx.x * 4 + w, row = gw >> 4, h = gw & 15, t = row & (SEQ - 1), b = row >> 12, kvh = h >> 2, qblk = t >> 8;
    float* qs = sh[w]; float* ps = sh[w] + 64;
    qs[lane] = bf2f(Q[(size_t)row * DM + h * 64 + lane]);
    __syncthreads();
    float gate = -INFINITY;
    if (lane < qblk) { const float* k0 = KS + ((size_t)(b * NBLK + lane) * 2) * 256 + kvh * 64; const float* k1 = k0 + 256; float a = 0.f;
        for (int d = 0; d < 64; ++d) a += qs[d] * ((k0[d] + k1[d]) * (1.0f / MBLK));
        gate = a; }
    unsigned chosen = 0; const int nsel = qblk < 3 ? qblk : 3;
    for (int si = 0; si < nsel; ++si) { float best = -INFINITY; int bi = -1;
        for (int j = 0; j < qblk; ++j) { const float gj = __shfl(gate, j); if (!((chosen >> j) & 1u) && (bi < 0 || gj > best)) { best = gj; bi = j; } }
        chosen |= 1u << bi; }
    chosen |= 1u << qblk;
    float mx = -INFINITY; int nslot = 0; int blks[4] = {0, 0, 0, 0};
    for (int j = 0; j <= qblk; ++j) { if (!((chosen >> j) & 1u)) continue;
        if (nslot == 0) blks[0] = j; else if (nslot == 1) blks[1] = j; else if (nslot == 2) blks[2] = j; else blks[3] = j;
#pragma unroll
        for (int r = 0; r < 4; ++r) { const int key = j * 256 + r * 64 + lane; float a = -INFINITY;
            if (key <= t) { const u32x4* kp = (const u32x4*)(K + ((size_t)b * SEQ + key) * 256 + kvh * 64); a = 0.f;
#pragma unroll
                for (int c = 0; c < 8; ++c) { const u32x4 v = kp[c];
                    a += qs[8 * c + 0] * bf2f(v.x & 0xffff) + qs[8 * c + 1] * bf2f(v.x >> 16) + qs[8 * c + 2] * bf2f(v.y & 0xffff) + qs[8 * c + 3] * bf2f(v.y >> 16)
                       + qs[8 * c + 4] * bf2f(v.z & 0xffff) + qs[8 * c + 5] * bf2f(v.z >> 16) + qs[8 * c + 6] * bf2f(v.w & 0xffff) + qs[8 * c + 7] * bf2f(v.w >> 16); } }
            ps[nslot * 256 + r * 64 + lane] = a; mx = fmaxf(mx, a); }
        ++nslot; }
    mx = wave_max(mx);
    float l = 0.f;
    for (int i = lane; i < nslot * 256; i += 64) { const float p = exp2f(ps[i] - mx); ps[i] = p; l += p; }
    l = wave_sum(l);
    __syncthreads();
    float o = 0.f;
    for (int sl = 0; sl < nslot; ++sl) { const int j = sl == 0 ? blks[0] : sl == 1 ? blks[1] : sl == 2 ? blks[2] : blks[3];
        const bf16_t* vp = V + ((size_t)b * SEQ + j * 256) * 256 + kvh * 64 + lane; const float* pp = ps + sl * 256;
        const int nk = (j == qblk) ? (t - j * 256 + 1) : 256;
        for (int kk = 0; kk < nk; ++kk) o += pp[kk] * bf2f(vp[(size_t)kk * 256]); }
    o /= l;
    const float z = bf2f(Z[(size_t)row * DM + h * 64 + lane]);
    G[(size_t)row * DM + h * 64 + lane] = (bf16_t)f2bf(o * z / (1.f + __expf(-z)));
}

__global__ __launch_bounds__(256) void k_gemm2_naive(const bf16_t* __restrict__ Gb, const bf16_t* __restrict__ W2t, const float* hold, float* H, bf16_t* __restrict__ Hb, float* __restrict__ ss) {
    const int wave = (int)(((size_t)blockIdx.x * 256 + threadIdx.x) >> 6), lane = threadIdx.x & 63;
    const int rt = wave >> 4, cg = wave & 15; if (rt >= M / 16) return;
    const int row0 = rt * 16, lr = lane & 15, lq = lane >> 4;
    f32x4 acc[4];
#pragma unroll
    for (int nb = 0; nb < 4; ++nb) acc[nb] = (f32x4){0.f, 0.f, 0.f, 0.f};
    const bf16_t* ap = Gb + (size_t)(row0 + lr) * DM + 8 * lq;
    const bf16_t* bp = W2t + (size_t)(cg * 64 + lr) * DM + 8 * lq;
    for (int k0 = 0; k0 < DM; k0 += 32) {
        const bf16x8 a = *(const bf16x8*)(ap + k0);
#pragma unroll
        for (int nb = 0; nb < 4; ++nb) { const bf16x8 b = *(const bf16x8*)(bp + (size_t)nb * 16 * DM + k0); acc[nb] = __builtin_amdgcn_mfma_f32_16x16x32_bf16(a, b, acc[nb], 0, 0, 0); }
    }
#pragma unroll
    for (int reg = 0; reg < 4; ++reg) {
        const int row = row0 + 4 * lq + reg; float s = 0.f;
#pragma unroll
        for (int nb = 0; nb < 4; ++nb) { const size_t off = (size_t)row * DM + cg * 64 + 16 * nb + lr; const float hn = hold[off] + acc[nb][reg]; H[off] = hn; Hb[off] = (bf16_t)f2bf(hn); s += hn * hn; }
        s += __shfl_xor(s, 1); s += __shfl_xor(s, 2); s += __shfl_xor(s, 4); s += __shfl_xor(s, 8);
        if (lr == 0) ss[(size_t)row * 16 + cg] = s;
    }
}
__global__ void k_final(float* H, const float* __restrict__ fg) {
    const int row = (blockIdx.x * blockDim.x + threadIdx.x) >> 6, lane = threadIdx.x & 63; if (row >= M) return;
    f32x4* hr = (f32x4*)(H + (size_t)row * DM) + lane; const f32x4* gr = (const f32x4*)fg + lane;
    f32x4 v[4]; float s = 0.f;
#pragma unroll
    for (int j = 0; j < 4; ++j) { v[j] = hr[64 * j]; s += (v[j].x * v[j].x + v[j].y * v[j].y) + (v[j].z * v[j].z + v[j].w * v[j].w); }
    const float rstd = rsqrtf(wave_sum(s) * (1.0f / DM) + EPS);
#pragma unroll
    for (int j = 0; j < 4; ++j) hr[64 * j] = v[j] * rstd * gr[64 * j];
}

extern "C" void kernel_launch(void* const* d_in, const int* in_sizes, int n_in, void* d_out, int out_size, void* d_ws, size_t ws_size, hipStream_t stream) {
    if (n_in != 7 || in_sizes[0] != M * DM || out_size != M * DM || ws_size < WS_END) { fprintf(stderr, "kernel_launch: unexpected shapes (n_in %d, in0 %d, out %d, ws %zu)\n", n_in, n_in > 0 ? in_sizes[0] : -1, out_size, ws_size); return; }
    const float* x = (const float*)d_in[0]; const float* norm_g = (const float*)d_in[1]; const float* w_in_a = (const float*)d_in[2]; const float* sinks_a = (const float*)d_in[3];
    const float* w_in_b = (const float*)d_in[4]; const float* w_out = (const float*)d_in[5]; const float* final_g = (const float*)d_in[6];
    unsigned char* ws = (unsigned char*)d_ws; float* H = (float*)d_out;
    float2* rope = (float2*)(ws + WS_ROPE); float* ss = (float*)(ws + WS_SS); float* KS = (float*)(ws + WS_KS);
    bf16_t* Hb = (bf16_t*)(ws + WS_HB); bf16_t* Qb = (bf16_t*)(ws + WS_Q); bf16_t* Zb = (bf16_t*)(ws + WS_Z); bf16_t* Gb = (bf16_t*)(ws + WS_G); bf16_t* Kb = (bf16_t*)(ws + WS_K); bf16_t* Vb = (bf16_t*)(ws + WS_V);
    k_prep_rope<<<SEQ * 32 / 256, 256, 0, stream>>>(rope);
    for (int l = 0; l < DEPTH; ++l) {
        const bool isB = l & 1; const int IN = isB ? IN_B : IN_A, KVW = isB ? 256 : 128;
        const float* Win = (isB ? w_in_b : w_in_a) + (size_t)(l >> 1) * DM * IN;
        k_prep_w1<<<(unsigned)(((size_t)IN * DM + 255) / 256), 256, 0, stream>>>(Win, norm_g + l * DM, (bf16_t*)(ws + WS_W1T + l * W1T_STRIDE), IN, KVW);
        k_prep_w2<<<DM * DM / 256, 256, 0, stream>>>(w_out + (size_t)l * DM * DM, (bf16_t*)(ws + WS_W2T + l * W2T_STRIDE));
    }
    k_prep_x<<<M / 4, 256, 0, stream>>>(x, Hb, ss);
    for (int l = 0; l < DEPTH; ++l) {
        const bool isB = l & 1;
        const bf16_t* W1t = (const bf16_t*)(ws + WS_W1T + l * W1T_STRIDE); const bf16_t* W2t = (const bf16_t*)(ws + WS_W2T + l * W2T_STRIDE);
        if (!isB) {
            k_gemm1_naive<2><<<(M / 16) * (IN_A / 64) / 4, 256, 0, stream>>>(Hb, W1t, ss, rope, Qb, Kb, Vb, Zb);
            k_attn_swa_naive<<<M * NH / 4, 256, 0, stream>>>(Qb, Kb, Vb, Zb, sinks_a + (l >> 1) * NH, Gb);
        } else {
            k_gemm1_naive<4><<<(M / 16) * (IN_B / 64) / 4, 256, 0, stream>>>(Hb, W1t, ss, rope, Qb, Kb, Vb, Zb);
            k_ksum_naive<<<BATCH * NBLK, 256, 0, stream>>>(Kb, KS);
            k_attn_moba_naive<<<M * NH / 4, 256, 0, stream>>>(Qb, Kb, Vb, Zb, KS, Gb);
        }
        k_gemm2_naive<<<(M / 16) * 16 / 4, 256, 0, stream>>>(Gb, W2t, l == 0 ? x : H, H, Hb, ss);
    }
    k_final<<<M / 4, 256, 0, stream>>>(H, final_g);
}
```

```cpp
#define MK_FAST_MASK 0x3fff
#define MK_ONE_LAUNCH 1
#include <hip/hip_runtime.h>
#include <cstdint>
#include <cstdio>

typedef unsigned short bf16_t;
typedef short bf16x8 __attribute__((ext_vector_type(8)));
typedef float f32x4 __attribute__((ext_vector_type(4)));
typedef unsigned u32x4 __attribute__((ext_vector_type(4)));

constexpr int BATCH = 8, SEQ = 4096, DM = 1024, DEPTH = 4, HD = 64, NH = 16;
constexpr int M = BATCH * SEQ;
constexpr int IN_A = 2304, IN_B = 2560;
constexpr int WINDOW = 128, MBLK = 256, NBLK = SEQ / MBLK;
constexpr float EPS = 1e-5f;
constexpr float LOG2E = 1.4426950408889634f;
constexpr float C2 = 0.125f * LOG2E;

constexpr size_t MiB = 1u << 20;
constexpr size_t WS_CTL = 0, WS_ROPE = 1 * MiB, WS_W1T = 2 * MiB, WS_W2T = 22 * MiB, WS_SS = 30 * MiB, WS_KS = 32 * MiB;
constexpr size_t WS_HB = 64 * MiB, WS_Q = 128 * MiB, WS_Z = 192 * MiB, WS_G = 256 * MiB, WS_K = 320 * MiB, WS_V = 336 * MiB, WS_END = 352 * MiB;
constexpr size_t W1T_STRIDE = 5 * MiB, W2T_STRIDE = 2 * MiB;

__device__ __forceinline__ unsigned f2bf(float f) { unsigned u = __builtin_bit_cast(unsigned, f); return (u + 0x7fffu + ((u >> 16) & 1u)) >> 16; }
__device__ __forceinline__ float bf2f(unsigned h) { return __builtin_bit_cast(float, h << 16); }
__host__ __device__ __forceinline__ int dmap(int cc) { return (((cc >> 2) & 1) << 5) | ((cc >> 5) << 4) | (((cc >> 3) & 3) << 2) | (cc & 3); }
__host__ __device__ __forceinline__ int dinv(int d) { return (((d >> 4) & 1) << 5) | (((d >> 2) & 3) << 3) | ((d >> 5) << 2) | (d & 3); }
__device__ __forceinline__ float wave_sum(float v) {
#pragma unroll
    for (int o = 1; o < 64; o <<= 1) v += __shfl_xor(v, o);
    return v;
}
__device__ __forceinline__ float wave_max(float v) {
#pragma unroll
    for (int o = 1; o < 64; o <<= 1) v = fmaxf(v, __shfl_xor(v, o));
    return v;
}

__global__ void k_prep_rope(float2* tab) {
    const int idx = blockIdx.x * blockDim.x + threadIdx.x; if (idx >= SEQ * 32) return;
    const int pos = idx >> 5, i = idx & 31;
    const float inv = (float)pow(10000.0, -(double)i / 32.0);
    const float ang = (float)pos * inv;
    tab[idx] = make_float2((float)cos((double)ang), (float)sin((double)ang));
}
__global__ void k_prep_w1(const float* __restrict__ Win, const float* __restrict__ g, bf16_t* __restrict__ W1t, int IN, int KVW) {
    const size_t idx = (size_t)blockIdx.x * blockDim.x + threadIdx.x; if (idx >= (size_t)IN * DM) return;
    const int cp = (int)(idx / DM), k = (int)(idx % DM);
    int col = cp;
    if (cp < 1024 + KVW) col = (cp & ~63) + dmap(cp & 63);
    W1t[idx] = (bf16_t)f2bf(g[k] * Win[(size_t)k * IN + col]);
}
__global__ void k_prep_w2(const float* __restrict__ Wout, bf16_t* __restrict__ W2t) {
    const size_t idx = (size_t)blockIdx.x * blockDim.x + threadIdx.x; if (idx >= (size_t)DM * DM) return;
    const int n = (int)(idx / DM), k = (int)(idx % DM);
    W2t[idx] = (bf16_t)f2bf(Wout[(size_t)k * DM + n]);
}
__global__ void k_prep_x(const float* __restrict__ x, bf16_t* __restrict__ Hb, float* __restrict__ ss) {
    const int row = (blockIdx.x * blockDim.x + threadIdx.x) >> 6, lane = threadIdx.x & 63; if (row >= M) return;
    const f32x4* xr = (const f32x4*)(x + (size_t)row * DM) + lane; float s = 0.f;
    unsigned long long* o8 = (unsigned long long*)(Hb + (size_t)row * DM) + lane;
#pragma unroll
    for (int j = 0; j < 4; ++j) { const f32x4 v = xr[64 * j]; s += (v.x * v.x + v.y * v.y) + (v.z * v.z + v.w * v.w);
        o8[64 * j] = (unsigned long long)(f2bf(v.x) | (f2bf(v.y) << 16)) | ((unsigned long long)(f2bf(v.z) | (f2bf(v.w) << 16)) << 32); }
    s = wave_sum(s);
    if (lane < 16) ss[(size_t)row * 16 + lane] = lane == 0 ? s : 0.f;
}

template <int KVH>
__global__ __launch_bounds__(256) void k_gemm1_naive(const bf16_t* __restrict__ Hb, const bf16_t* __restrict__ W1t, const float* __restrict__ ss, const float2* __restrict__ rope,
                                                     bf16_t* __restrict__ Q, bf16_t* __restrict__ K, bf16_t* __restrict__ V, bf16_t* __restrict__ Z) {
    constexpr int KVW = KVH * 64, IN = 2048 + 2 * KVW, NG = IN / 64;
    const int wave = (int)(((size_t)blockIdx.x * 256 + threadIdx.x) >> 6), lane = threadIdx.x & 63;
    const int rt = wave / NG, cg = wave % NG; if (rt >= M / 16) return;
    const int row0 = rt * 16, lr = lane & 15, lq = lane >> 4;
    const bool rot = cg < 16 + KVH;
    f32x4 acc[4];
#pragma unroll
    for (int nb = 0; nb < 4; ++nb) acc[nb] = (f32x4){0.f, 0.f, 0.f, 0.f};
    const bf16_t* ap = Hb + (size_t)(row0 + lr) * DM + 8 * lq;
    const bf16_t* bp[4];
#pragma unroll
    for (int nb = 0; nb < 4; ++nb) { const int d = 16 * nb + lr; bp[nb] = W1t + (size_t)(cg * 64 + (rot ? dinv(d) : d)) * DM + 8 * lq; }
    for (int k0 = 0; k0 < DM; k0 += 32) {
        const bf16x8 a = *(const bf16x8*)(ap + k0);
#pragma unroll
        for (int nb = 0; nb < 4; ++nb) { const bf16x8 b = *(const bf16x8*)(bp[nb] + k0); acc[nb] = __builtin_amdgcn_mfma_f32_16x16x32_bf16(a, b, acc[nb], 0, 0, 0); }
    }
#pragma unroll
    for (int reg = 0; reg < 4; ++reg) {
        const int row = row0 + 4 * lq + reg, pos = row & (SEQ - 1);
        const f32x4* sp = (const f32x4*)(ss + (size_t)row * 16);
        const f32x4 s0 = sp[0], s1 = sp[1], s2 = sp[2], s3 = sp[3];
        const float tot = ((s0.x + s0.y) + (s0.z + s0.w)) + ((s1.x + s1.y) + (s1.z + s1.w)) + ((s2.x + s2.y) + (s2.z + s2.w)) + ((s3.x + s3.y) + (s3.z + s3.w));
        const float rstd = rsqrtf(tot * (1.0f / DM) + EPS);
        if (rot) {
            const bool isq = cg < 16; const float sc = isq ? rstd * C2 : rstd;
            bf16_t* dst = isq ? Q + (size_t)row * DM + cg * 64 : K + (size_t)row * KVW + (cg - 16) * 64;
#pragma unroll
            for (int nb = 0; nb < 2; ++nb) { const int i = 16 * nb + lr; const float2 cs = rope[pos * 32 + i];
                const float x1 = acc[nb][reg] * sc, x2 = acc[nb + 2][reg] * sc;
                dst[i] = (bf16_t)f2bf(x1 * cs.x - x2 * cs.y); dst[i + 32] = (bf16_t)f2bf(x2 * cs.x + x1 * cs.y); }
        } else {
            const bool isv = cg < 16 + 2 * KVH;
            bf16_t* dst = isv ? V + (size_t)row * KVW + (cg - 16 - KVH) * 64 : Z + (size_t)row * DM + (cg - 16 - 2 * KVH) * 64;
#pragma unroll
            for (int nb = 0; nb < 4; ++nb) dst[16 * nb + lr] = (bf16_t)f2bf(acc[nb][reg] * rstd);
        }
    }
}
__global__ void k_ksum_naive(const bf16_t* __restrict__ K, float* __restrict__ KS) {
    const int bb = blockIdx.x, c = threadIdx.x;
    float s = 0.f;
    for (int r = 0; r < MBLK; ++r) s += bf2f(K[((size_t)bb * MBLK + r) * 256 + c]);
    KS[((size_t)bb * 2 + 0) * 256 + c] = s; KS[((size_t)bb * 2 + 1) * 256 + c] = 0.f;
}

__global__ __launch_bounds__(256) void k_attn_swa_naive(const bf16_t* __restrict__ Q, const bf16_t* __restrict__ K, const bf16_t* __restrict__ V, const bf16_t* __restrict__ Z,
                                                        const float* __restrict__ sinks, bf16_t* __restrict__ G) {
    __shared__ float sh[4][64 + 128];
    const int w = threadIdx.x >> 6, lane = threadIdx.x & 63;
    const int gw = blockIdx.x * 4 + w, row = gw >> 4, h = gw & 15, t = row & (SEQ - 1), kvh = h >> 3;
    float* qs = sh[w]; float* ps = sh[w] + 64;
    qs[lane] = bf2f(Q[(size_t)row * DM + h * 64 + lane]);
    __syncthreads();
    float s[2];
#pragma unroll
    for (int r = 0; r < 2; ++r) { const int kk = lane + 64 * r; float a = -INFINITY;
        if (kk <= t) { const u32x4* kp = (const u32x4*)(K + (size_t)(row - kk) * 128 + kvh * 64); a = 0.f;
#pragma unroll
            for (int c = 0; c < 8; ++c) { const u32x4 v = kp[c];
                a += qs[8 * c + 0] * bf2f(v.x & 0xffff) + qs[8 * c + 1] * bf2f(v.x >> 16) + qs[8 * c + 2] * bf2f(v.y & 0xffff) + qs[8 * c + 3] * bf2f(v.y >> 16)
                   + qs[8 * c + 4] * bf2f(v.z & 0xffff) + qs[8 * c + 5] * bf2f(v.z >> 16) + qs[8 * c + 6] * bf2f(v.w & 0xffff) + qs[8 * c + 7] * bf2f(v.w >> 16); } }
        s[r] = a; }
    const float sinkl = sinks[h] * LOG2E;
    const float m = fmaxf(wave_max(fmaxf(s[0], s[1])), sinkl);
    const float p0 = exp2f(s[0] - m), p1 = exp2f(s[1] - m);
    const float l = wave_sum(p0 + p1) + exp2f(sinkl - m);
    ps[lane] = p0; ps[lane + 64] = p1;
    __syncthreads();
    const int nk = t + 1 < WINDOW ? t + 1 : WINDOW; float o = 0.f;
    for (int kk = 0; kk < nk; ++kk) o += ps[kk] * bf2f(V[(size_t)(row - kk) * 128 + kvh * 64 + lane]);
    o /= l;
    const float z = bf2f(Z[(size_t)row * DM + h * 64 + lane]);
    G[(size_t)row * DM + h * 64 + lane] = (bf16_t)f2bf(o * z / (1.f + __expf(-z)));
}
__global__ __launch_bounds__(256) void k_attn_moba_naive(const bf16_t* __restrict__ Q, const bf16_t* __restrict__ K, const bf16_t* __restrict__ V, const bf16_t* __restrict__ Z,
                                                         const float* __restrict__ KS, bf16_t* __restrict__ G) {
    __shared__ float sh[4][64 + 1024];
    const int w = threadIdx.x >> 6, lane = threadIdx.x & 63;
    const int gw = blockIdx.x * 4 + w, row = gw >> 4, h = gw & 15, t = row & (SEQ - 1), b = row >> 12, kvh = h >> 2, qblk = t >> 8;
    float* qs = sh[w]; float* ps = sh[w] + 64;
    qs[lane] = bf2f(Q[(size_t)row * DM + h * 64 + lane]);
    __syncthreads();
    float gate = -INFINITY;
    if (lane < qblk) { const float* k0 = KS + ((size_t)(b * NBLK + lane) * 2) * 256 + kvh * 64; const float* k1 = k0 + 256; float a = 0.f;
        for (int d = 0; d < 64; ++d) a += qs[d] * ((k0[d] + k1[d]) * (1.0f / MBLK));
        gate = a; }
    unsigned chosen = 0; const int nsel = qblk < 3 ? qblk : 3;
    for (int si = 0; si < nsel; ++si) { float best = -INFINITY; int bi = -1;
        for (int j = 0; j < qblk; ++j) { const float gj = __shfl(gate, j); if (!((chosen >> j) & 1u) && (bi < 0 || gj > best)) { best = gj; bi = j; } }
        chosen |= 1u << bi; }
    chosen |= 1u << qblk;
    float mx = -INFINITY; int nslot = 0; int blks[4] = {0, 0, 0, 0};
    for (int j = 0; j <= qblk; ++j) { if (!((chosen >> j) & 1u)) continue;
        if (nslot == 0) blks[0] = j; else if (nslot == 1) blks[1] = j; else if (nslot == 2) blks[2] = j; else blks[3] = j;
#pragma unroll
        for (int r = 0; r < 4; ++r) { const int key = j * 256 + r * 64 + lane; float a = -INFINITY;
            if (key <= t) { const u32x4* kp = (const u32x4*)(K + ((size_t)b * SEQ + key) * 256 + kvh * 64); a = 0.f;
#pragma unroll
                for (int c = 0; c < 8; ++c) { const u32x4 v = kp[c];
                    a += qs[8 * c + 0] * bf2f(v.x & 0xffff) + qs[8 * c + 1] * bf2f(v.x >> 16) + qs[8 * c + 2] * bf2f(v.y & 0xffff) + qs[8 * c + 3] * bf2f(v.y >> 16)
                       + qs[8 * c + 4] * bf2f(v.z & 0xffff) + qs[8 * c + 5] * bf2f(v.z >> 16) + qs[8 * c + 6] * bf2f(v.w & 0xffff) + qs[8 * c + 7] * bf2f(v.w >> 16); } }
            ps[nslot * 256 + r * 64 + lane] = a; mx = fmaxf(mx, a); }
        ++nslot; }
    mx = wave_max(mx);
    float l = 0.f;
    for (int i = lane; i < nslot * 256; i += 64) { const float p = exp2f(ps[i] - mx); ps[i] = p; l += p; }
    l = wave_sum(l);
    __syncthreads();
    float o = 0.f;
    for (int sl = 0; sl < nslot; ++sl) { const int j = sl == 0 ? blks[0] : sl == 1 ? blks[1] : sl == 2 ? blks[2] : blks[3];
        const bf16_t* vp = V + ((size_t)b * SEQ + j * 256) * 256 + kvh * 64 + lane; const float* pp = ps + sl * 256;
        const int nk = (j == qblk) ? (t - j * 256 + 1) : 256;
        for (int kk = 0; kk < nk; ++kk) o += pp[kk] * bf2f(vp[(size_t)kk * 256]); }
    o /= l;
    const float z = bf2f(Z[(size_t)row * DM + h * 64 + lane]);
    G[(size_t)row * DM + h * 64 + lane] = (bf16_t)f2bf(o * z / (1.f + __expf(-z)));
}

__global__ __launch_bounds__(256) void k_gemm2_naive(const bf16_t* __restrict__ Gb, const bf16_t* __restrict__ W2t, const float* hold, float* H, bf16_t* __restrict__ Hb, float* __restrict__ ss) {
    const int wave = (int)(((size_t)blockIdx.x * 256 + threadIdx.x) >> 6), lane = threadIdx.x & 63;
    const int rt = wave >> 4, cg = wave & 15; if (rt >= M / 16) return;
    const int row0 = rt * 16, lr = lane & 15, lq = lane >> 4;
    f32x4 acc[4];
#pragma unroll
    for (int nb = 0; nb < 4; ++nb) acc[nb] = (f32x4){0.f, 0.f, 0.f, 0.f};
    const bf16_t* ap = Gb + (size_t)(row0 + lr) * DM + 8 * lq;
    const bf16_t* bp = W2t + (size_t)(cg * 64 + lr) * DM + 8 * lq;
    for (int k0 = 0; k0 < DM; k0 += 32) {
        const bf16x8 a = *(const bf16x8*)(ap + k0);
#pragma unroll
        for (int nb = 0; nb < 4; ++nb) { const bf16x8 b = *(const bf16x8*)(bp + (size_t)nb * 16 * DM + k0); acc[nb] = __builtin_amdgcn_mfma_f32_16x16x32_bf16(a, b, acc[nb], 0, 0, 0); }
    }
#pragma unroll
    for (int reg = 0; reg < 4; ++reg) {
        const int row = row0 + 4 * lq + reg; float s = 0.f;
#pragma unroll
        for (int nb = 0; nb < 4; ++nb) { const size_t off = (size_t)row * DM + cg * 64 + 16 * nb + lr; const float hn = hold[off] + acc[nb][reg]; H[off] = hn; Hb[off] = (bf16_t)f2bf(hn); s += hn * hn; }
        s += __shfl_xor(s, 1); s += __shfl_xor(s, 2); s += __shfl_xor(s, 4); s += __shfl_xor(s, 8);
        if (lr == 0) ss[(size_t)row * 16 + cg] = s;
    }
}
__global__ void k_final(float* H, const float* __restrict__ fg) {
    const int row = (blockIdx.x * blockDim.x + threadIdx.x) >> 6, lane = threadIdx.x & 63; if (row >= M) return;
    f32x4* hr = (f32x4*)(H + (size_t)row * DM) + lane; const f32x4* gr = (const f32x4*)fg + lane;
    f32x4 v[4]; float s = 0.f;
#pragma unroll
    for (int j = 0; j < 4; ++j) { v[j] = hr[64 * j]; s += (v[j].x * v[j].x + v[j].y * v[j].y) + (v[j].z * v[j].z + v[j].w * v[j].w); }
    const float rstd = rsqrtf(wave_sum(s) * (1.0f / DM) + EPS);
#pragma unroll
    for (int j = 0; j < 4; ++j) hr[64 * j] = v[j] * rstd * gr[64 * j];
}


namespace pg8 {
#define PG8_LAS __attribute__((address_space(3)))
typedef unsigned short bf16_t;
typedef short bf16x8 __attribute__((ext_vector_type(8)));
typedef float f32x4 __attribute__((ext_vector_type(4)));
typedef unsigned u32x4 __attribute__((ext_vector_type(4)));
constexpr int BM = 256, BK = 64, HALF = 128, HTB = HALF * BK * 2  , STAGE_BYTES = 8 * HTB, NXCD = 8, WGM = 8;

__host__ __device__ __forceinline__ int lds_byte(int r, int c) { const int st = (r >> 4) * 2 + (c >> 5), rr = r & 15, cc = c & 31, ob = rr * 64 + cc * 2; return st * 1024 + (ob ^ (((ob >> 9) & 1) << 5)); }
__host__ __device__ __forceinline__ void stage_rc(int b, int& R, int& C) { const int st = b / 1024, sb = b % 1024, swz = sb ^ (((sb >> 9) & 1) << 5); R = (st >> 1) * 16 + swz / 64; C = (st & 1) * 32 + (swz % 64) / 2; }
__host__ __device__ __forceinline__ int perm32(int rho) { const int n = rho >> 4, i = rho & 15; return 8 * (i >> 2) + 4 * n + (i & 3); }

struct Unit { int pm, pn; };
struct Gemm { const bf16_t* A; const bf16_t* Bt; int M, N, K; };

struct StaticOrder {
    int nM, nN, nwg, G, c;
    __host__ __device__ void init(int M, int N, int G_, int c_) { nM = M / BM; nN = N / BM; nwg = nM * nN; G = G_; c = c_; }
    __host__ __device__ bool next(int i, Unit& u) const {
        const long L = (long)i * G + c; if (L >= nwg) return false;
        int wgid = (int)L; { const int q = nwg / NXCD, r = nwg % NXCD, xcd = wgid % NXCD, off = wgid / NXCD; wgid = (xcd < r ? xcd * (q + 1) : r * (q + 1) + (xcd - r) * q) + off; }
        const int nig = WGM * nN, gid = wgid / nig, fm = gid * WGM, gsz = (nM - fm) < WGM ? (nM - fm) : WGM;
        u.pm = fm + ((wgid % nig) % gsz); u.pn = (wgid % nig) / gsz; return true;
    }
    __device__ __forceinline__ void a_ready(const Unit&) const {}
    __device__ __forceinline__ void done(const Unit&) const {}
};

__device__ __forceinline__ unsigned cvt_pk_bf16(float lo, float hi) { unsigned r; asm volatile("v_cvt_pk_bf16_f32 %0, %1, %2" : "=v"(r) : "v"(lo), "v"(hi)); return r; }
typedef unsigned u32x2 __attribute__((ext_vector_type(2)));

template <int KVH> struct EpiG1 {
    static constexpr bool PERM = true, AFTER_DRAIN = false;
    bf16_t *Q, *K, *V, *Z; const float* ss; const float* rope; float* KS;
    __device__ __forceinline__ float rstd_of(int row) const {
        const f32x4* sp = (const f32x4*)(ss + (size_t)row * 16);
        const f32x4 s0 = sp[0], s1 = sp[1], s2 = sp[2], s3 = sp[3];
        const float tot = ((s0[0] + s0[1]) + (s0[2] + s0[3])) + ((s1[0] + s1[1]) + (s1[2] + s1[3])) + ((s2[0] + s2[1]) + (s2[2] + s2[3])) + ((s3[0] + s3[1]) + (s3[2] + s3[3]));
        return __builtin_amdgcn_rsqf(tot * (1.0f / 1024.0f) + 1e-5f);
    }
    __device__ __forceinline__ void operator()(const f32x4 (&acc)[2][2][4][2], const Unit& u, int wr, int wc, int fr, int fq) const {
        constexpr int KVW = KVH * 64; constexpr float C2 = 0.125f * 1.4426950408889634f;
        const int pn = u.pn, wcl = wc & 1, hp = wc >> 1;
        const int row0 = u.pm * BM + wr * 64 + fr;
        if (pn < 4 || (pn == 4 && KVH == 4)) {
            const bool isq = pn < 4;
            f32x4 ks[2][2];
#pragma unroll
            for (int bj = 0; bj < 2; ++bj) { ks[bj][0] = (f32x4){0.f, 0.f, 0.f, 0.f}; ks[bj][1] = (f32x4){0.f, 0.f, 0.f, 0.f}; }
#pragma unroll
            for (int ai = 0; ai < 2; ++ai)
#pragma unroll
                for (int m = 0; m < 4; ++m) {
                    const int row = row0 + ai * HALF + m * 16, pos = row & 4095;
                    const float rs = rstd_of(row), sc = isq ? rs * C2 : rs;
                    const f32x4* rp = (const f32x4*)(rope + ((size_t)pos * 32 + 16 * wcl + 4 * fq) * 2);
                    const f32x4 t0 = rp[0], t1 = rp[1];
                    const f32x4 cc = (f32x4){t0[0], t0[2], t1[0], t1[2]}, sn = (f32x4){t0[1], t0[3], t1[1], t1[3]};
#pragma unroll
                    for (int bj = 0; bj < 2; ++bj) {
                        const f32x4 x1 = acc[ai][bj][m][0] * sc, x2 = acc[ai][bj][m][1] * sc;
                        const f32x4 o1 = x1 * cc - x2 * sn, o2 = x2 * cc + x1 * sn;
                        bf16_t* dst = isq ? Q + (size_t)row * 1024 + (4 * pn + 2 * bj + hp) * 64 + 16 * wcl + 4 * fq : K + (size_t)row * KVW + (2 * bj + hp) * 64 + 16 * wcl + 4 * fq;
                        u32x2 w1, w2; w1.x = cvt_pk_bf16(o1[0], o1[1]); w1.y = cvt_pk_bf16(o1[2], o1[3]); w2.x = cvt_pk_bf16(o2[0], o2[1]); w2.y = cvt_pk_bf16(o2[2], o2[3]);
                        *(u32x2*)dst = w1; *(u32x2*)(dst + 32) = w2;
                        if (!isq) { ks[bj][0] += o1; ks[bj][1] += o2; }
                    }
                }
            if (!isq) {
#pragma unroll
                for (int bj = 0; bj < 2; ++bj)
#pragma unroll
                    for (int n = 0; n < 2; ++n) {
                        f32x4 v = ks[bj][n];
#pragma unroll
                        for (int j = 0; j < 4; ++j) { float s = v[j]; s += __shfl_xor(s, 1); s += __shfl_xor(s, 2); s += __shfl_xor(s, 4); s += __shfl_xor(s, 8); v[j] = s; }
                        if (fr == 0) *(f32x4*)(KS + ((size_t)(u.pm * 2 + wr)) * 256 + (2 * bj + hp) * 64 + 32 * n + 16 * wcl + 4 * fq) = v;
                    }
            }
        } else if (pn == 4) {
#pragma unroll
            for (int ai = 0; ai < 2; ++ai)
#pragma unroll
                for (int m = 0; m < 4; ++m) {
                    const int row = row0 + ai * HALF + m * 16, pos = row & 4095;
                    const float rs = rstd_of(row);
                    const f32x4* rp = (const f32x4*)(rope + ((size_t)pos * 32 + 16 * wcl + 4 * fq) * 2);
                    const f32x4 t0 = rp[0], t1 = rp[1];
                    const f32x4 cc = (f32x4){t0[0], t0[2], t1[0], t1[2]}, sn = (f32x4){t0[1], t0[3], t1[1], t1[3]};
                    { const f32x4 x1 = acc[ai][0][m][0] * rs, x2 = acc[ai][0][m][1] * rs;
                      const f32x4 o1 = x1 * cc - x2 * sn, o2 = x2 * cc + x1 * sn;
                      bf16_t* dst = K + (size_t)row * KVW + hp * 64 + 16 * wcl + 4 * fq;
                      u32x2 w1, w2; w1.x = cvt_pk_bf16(o1[0], o1[1]); w1.y = cvt_pk_bf16(o1[2], o1[3]); w2.x = cvt_pk_bf16(o2[0], o2[1]); w2.y = cvt_pk_bf16(o2[2], o2[3]);
                      *(u32x2*)dst = w1; *(u32x2*)(dst + 32) = w2; }
                    { const f32x4 v0 = acc[ai][1][m][0] * rs, v1 = acc[ai][1][m][1] * rs;
                      u32x4 w; w.x = cvt_pk_bf16(v0[0], v0[1]); w.y = cvt_pk_bf16(v0[2], v0[3]); w.z = cvt_pk_bf16(v1[0], v1[1]); w.w = cvt_pk_bf16(v1[2], v1[3]);
                      *(u32x4*)(V + (size_t)row * KVW + 32 * wc + 8 * fq) = w; }
                }
        } else {
            const bool isv = (KVH == 4 && pn == 5);
            const int zt = pn - (KVH == 4 ? 6 : 5);
#pragma unroll
            for (int ai = 0; ai < 2; ++ai)
#pragma unroll
                for (int m = 0; m < 4; ++m) {
                    const int row = row0 + ai * HALF + m * 16;
                    const float rs = rstd_of(row);
                    bf16_t* dst = isv ? V + (size_t)row * KVW + 32 * wc + 8 * fq : Z + (size_t)row * 1024 + zt * 256 + 32 * wc + 8 * fq;
#pragma unroll
                    for (int bj = 0; bj < 2; ++bj) {
                        const f32x4 v0 = acc[ai][bj][m][0] * rs, v1 = acc[ai][bj][m][1] * rs;
                        u32x4 w; w.x = cvt_pk_bf16(v0[0], v0[1]); w.y = cvt_pk_bf16(v0[2], v0[3]); w.z = cvt_pk_bf16(v1[0], v1[1]); w.w = cvt_pk_bf16(v1[2], v1[3]);
                        *(u32x4*)(dst + bj * HALF) = w;
                    }
                }
        }
    }
};
struct EpiG2 {
    static constexpr bool PERM = true, AFTER_DRAIN = false;
    const float* hold; float* H; bf16_t* Hb; float* ss; int write_hb;
    __device__ __forceinline__ void operator()(const f32x4 (&acc)[2][2][4][2], const Unit& u, int wr, int wc, int fr, int fq) const {
        const int row0 = u.pm * BM + wr * 64 + fr, col0 = u.pn * BM + 32 * wc + 8 * fq;
#pragma unroll
        for (int ai = 0; ai < 2; ++ai)
#pragma unroll
            for (int m = 0; m < 4; ++m) {
                const int row = row0 + ai * HALF + m * 16; float s = 0.f;
#pragma unroll
                for (int bj = 0; bj < 2; ++bj) {
                    const size_t off = (size_t)row * 1024 + col0 + bj * HALF;
                    const f32x4 v0 = *(const f32x4*)(hold + off) + acc[ai][bj][m][0], v1 = *(const f32x4*)(hold + off + 4) + acc[ai][bj][m][1];
                    *(f32x4*)(H + off) = v0; *(f32x4*)(H + off + 4) = v1;
                    s += ((v0[0] * v0[0] + v0[1] * v0[1]) + (v0[2] * v0[2] + v0[3] * v0[3])) + ((v1[0] * v1[0] + v1[1] * v1[1]) + (v1[2] * v1[2] + v1[3] * v1[3]));
                    if (write_hb) { u32x4 w; w.x = cvt_pk_bf16(v0[0], v0[1]); w.y = cvt_pk_bf16(v0[2], v0[3]); w.z = cvt_pk_bf16(v1[0], v1[1]); w.w = cvt_pk_bf16(v1[2], v1[3]); *(u32x4*)(Hb + off) = w; }
                }
                s += __shfl_xor(s, 16); s += __shfl_xor(s, 32);
                if (fq == 0) ss[(size_t)row * 16 + 4 * u.pn + wc] = s;
            }
    }
};
template <class Epi, class Sched, bool ALIGN_EPI = false, bool SP2 = false>
__device__ __forceinline__ void gemm_phase(PG8_LAS unsigned char* lds, const Gemm g, const Sched& S, const Epi& E) {
    int tid_ = threadIdx.x; asm volatile("" : "+v"(tid_));
    const int tid = tid_, wid = __builtin_amdgcn_readfirstlane(tid >> 6), lane = tid & 63, wr = wid >> 2, wc = wid & 3, fr = lane & 15, fq = lane >> 4;
    const int K = g.K, nt = K / BK;
    unsigned voffA[2], voffB[2];
#pragma unroll
    for (int i = 0; i < 2; ++i) { int R, C; stage_rc(tid * 16 + i * 8192, R, C); const int Rb = Epi::PERM ? ((R & ~31) + perm32(R & 31)) : R;
        voffA[i] = (unsigned)(R * K + C) * 2u; voffB[i] = (unsigned)(Rb * K + C) * 2u; }
    const size_t kstep = (size_t)(BK * 2);
    const size_t hstep = (size_t)HALF * K * 2;
    const size_t tstep = 2 * hstep;
    const unsigned ldsw = (unsigned)wid * 1024u;
    const int aoff = lds_byte(wr * 64 + fr, fq * 8), boff = lds_byte(wc * 32 + fr, fq * 8);
#define PG8_SA(b, h) (((b) * 2 + (h)) * HTB)
#define PG8_SB(b, h) ((4 + (b) * 2 + (h)) * HTB)
#define PG8_STAGE(bufoff, gbase, voff) do { _Pragma("unroll") for (int _i = 0; _i < 2; ++_i) \
        __builtin_amdgcn_global_load_lds((const unsigned*)((const char*)(gbase) + (voff)[_i]), (PG8_LAS unsigned*)(lds + (bufoff) + ldsw + _i * 8192), 16, 0, 0); } while (0)
#define PG8_LDA(dst, b, h) do { _Pragma("unroll") for (int m = 0; m < 4; ++m) _Pragma("unroll") for (int k = 0; k < 2; ++k) dst[m][k] = *(const PG8_LAS bf16x8*)(lds + PG8_SA(b, h) + aoff + m * 2048 + k * 1024); } while (0)
#define PG8_LDB(dst, b, h) do { _Pragma("unroll") for (int n = 0; n < 2; ++n) _Pragma("unroll") for (int k = 0; k < 2; ++k) dst[n][k] = *(const PG8_LAS bf16x8*)(lds + PG8_SB(b, h) + boff + n * 2048 + k * 1024); } while (0)
#define PG8_MMA(ai, bj, At, Bt) do { __builtin_amdgcn_s_setprio(1); _Pragma("unroll") for (int m = 0; m < 4; ++m) _Pragma("unroll") for (int n = 0; n < 2; ++n) _Pragma("unroll") for (int k = 0; k < 2; ++k) \
        acc[ai][bj][m][n] = __builtin_amdgcn_mfma_f32_16x16x32_bf16(Bt[n][k], At[m][k], acc[ai][bj][m][n], 0, 0, 0); __builtin_amdgcn_s_setprio(0); } while (0)
#define PG8_WAIT_V(n) asm volatile("s_waitcnt vmcnt(" #n ")" ::: "memory")
#define PG8_WAIT_L(n) asm volatile("s_waitcnt lgkmcnt(" #n ")" ::: "memory")
#define PG8_BAR __builtin_amdgcn_s_barrier()
#define PG8_SCHED __builtin_amdgcn_sched_barrier(0)
    Unit cur, nxt; int ui = 0;
    if (!S.next(0, cur)) return;
    f32x4 acc[2][2][4][2];
#pragma unroll
    for (int a = 0; a < 2; ++a)
#pragma unroll
        for (int b = 0; b < 2; ++b)
#pragma unroll
            for (int m = 0; m < 4; ++m)
#pragma unroll
                for (int n = 0; n < 2; ++n) acc[a][b][m][n] = (f32x4){0.f, 0.f, 0.f, 0.f};
    bf16x8 At[4][2], B0[2][2], B1[2][2];
    const char* cA = (const char*)g.A + (size_t)cur.pm * tstep; const char* cB = (const char*)g.Bt + (size_t)cur.pn * tstep;
    S.a_ready(cur);
    if constexpr (SP2) {
        PG8_STAGE(PG8_SB(0, 0), cB, voffB); PG8_STAGE(PG8_SB(0, 1), cB + hstep, voffB); PG8_STAGE(PG8_SA(0, 0), cA, voffA); PG8_STAGE(PG8_SA(0, 1), cA + hstep, voffA);
        if (wr == 1) PG8_BAR;
        PG8_WAIT_V(2); PG8_BAR;
        PG8_STAGE(PG8_SB(1, 0), cB + kstep, voffB); PG8_STAGE(PG8_SA(1, 0), cA + kstep, voffA); PG8_STAGE(PG8_SB(1, 1), cB + hstep + kstep, voffB);
        PG8_WAIT_V(6); PG8_BAR;
    } else {
        PG8_STAGE(PG8_SB(0, 0), cB, voffB); PG8_STAGE(PG8_SA(0, 0), cA, voffA); PG8_STAGE(PG8_SB(0, 1), cB + hstep, voffB); PG8_STAGE(PG8_SA(0, 1), cA + hstep, voffA);
        if (wr == 1) PG8_BAR;
        PG8_WAIT_V(4); PG8_BAR;
        PG8_STAGE(PG8_SB(1, 0), cB + kstep, voffB); PG8_STAGE(PG8_SA(1, 0), cA + kstep, voffA); PG8_STAGE(PG8_SB(1, 1), cB + hstep + kstep, voffB);
        PG8_WAIT_V(6); PG8_BAR;
    }
    for (;;) {
        const bool has_next = S.next(ui + 1, nxt);
        const char* nA = has_next ? (const char*)g.A + (size_t)nxt.pm * tstep : cA; const char* nB = has_next ? (const char*)g.Bt + (size_t)nxt.pn * tstep : cB;
        for (int t = 0; t < nt; t += 2) {
            const bool last = (t == nt - 2);
            const char* a1 = cA + (size_t)(t + 1) * kstep;
            const char* a2 = last ? nA : cA + (size_t)(t + 2) * kstep; const char* b2 = last ? nB : cB + (size_t)(t + 2) * kstep;
            const char* a3 = a2 + kstep; const char* b3 = b2 + kstep;
            if (last && has_next) S.a_ready(nxt);
            if constexpr (SP2) {
            PG8_LDB(B0, 0, 0); PG8_LDB(B1, 0, 1); PG8_SCHED; PG8_LDA(At, 0, 0); PG8_STAGE(PG8_SA(1, 1), a1 + hstep, voffA);
            PG8_WAIT_V(8); PG8_WAIT_L(0); PG8_BAR; PG8_MMA(0, 0, At, B0); PG8_MMA(0, 1, At, B1); PG8_BAR; PG8_SCHED;
            PG8_LDA(At, 0, 1); PG8_STAGE(PG8_SB(0, 0), b2, voffB); PG8_STAGE(PG8_SB(0, 1), b2 + hstep, voffB); PG8_STAGE(PG8_SA(0, 0), a2, voffA);
            PG8_WAIT_V(8); PG8_WAIT_L(0); PG8_BAR; PG8_MMA(1, 0, At, B0); PG8_MMA(1, 1, At, B1); PG8_BAR; PG8_SCHED;
            PG8_LDB(B0, 1, 0); PG8_LDB(B1, 1, 1); PG8_SCHED; PG8_LDA(At, 1, 0); PG8_STAGE(PG8_SA(0, 1), a2 + hstep, voffA);
            PG8_WAIT_V(8); PG8_WAIT_L(0); PG8_BAR; PG8_MMA(0, 0, At, B0); PG8_MMA(0, 1, At, B1); PG8_BAR; PG8_SCHED;
            PG8_LDA(At, 1, 1); PG8_STAGE(PG8_SB(1, 0), b3, voffB); PG8_STAGE(PG8_SB(1, 1), b3 + hstep, voffB); PG8_STAGE(PG8_SA(1, 0), a3, voffA);
            PG8_WAIT_V(8); PG8_WAIT_L(0); PG8_BAR; PG8_MMA(1, 0, At, B0); PG8_MMA(1, 1, At, B1); PG8_BAR; PG8_SCHED;
            } else {
            PG8_LDB(B0, 0, 0); PG8_SCHED; PG8_LDA(At, 0, 0); PG8_STAGE(PG8_SA(1, 1), a1 + hstep, voffA);
            PG8_WAIT_L(8); PG8_BAR; PG8_WAIT_L(0); PG8_MMA(0, 0, At, B0); PG8_BAR; PG8_SCHED;
            PG8_LDB(B1, 0, 1); PG8_STAGE(PG8_SB(0, 0), b2, voffB);
            PG8_BAR; PG8_WAIT_L(0); PG8_MMA(0, 1, At, B1); PG8_BAR;
            PG8_LDA(At, 0, 1); PG8_STAGE(PG8_SA(0, 0), a2, voffA);
            PG8_BAR; PG8_WAIT_L(0); PG8_MMA(1, 0, At, B0); PG8_BAR; PG8_SCHED;
            PG8_STAGE(PG8_SB(0, 1), b2 + hstep, voffB);
            PG8_WAIT_V(6); PG8_BAR; PG8_MMA(1, 1, At, B1); PG8_BAR;
            PG8_LDB(B0, 1, 0); PG8_SCHED; PG8_LDA(At, 1, 0); PG8_STAGE(PG8_SA(0, 1), a2 + hstep, voffA);
            PG8_WAIT_L(8); PG8_BAR; PG8_WAIT_L(0); PG8_MMA(0, 0, At, B0); PG8_BAR; PG8_SCHED;
            PG8_LDB(B1, 1, 1); PG8_STAGE(PG8_SB(1, 0), b3, voffB);
            PG8_BAR; PG8_WAIT_L(0); PG8_MMA(0, 1, At, B1); PG8_BAR;
            PG8_LDA(At, 1, 1); PG8_STAGE(PG8_SA(1, 0), a3, voffA);
            PG8_BAR; PG8_WAIT_L(0); PG8_MMA(1, 0, At, B0); PG8_BAR; PG8_SCHED;
            PG8_STAGE(PG8_SB(1, 1), b3 + hstep, voffB);
            PG8_WAIT_V(6); PG8_BAR; PG8_MMA(1, 1, At, B1); PG8_BAR;
            }
        }
        if constexpr (ALIGN_EPI) { if (wr == 0) PG8_BAR; }
        if constexpr (!Epi::AFTER_DRAIN) { E(acc, cur, wr, wc, fr, fq); S.done(cur); }
        if (!has_next) break;
#pragma unroll
        for (int a = 0; a < 2; ++a)
#pragma unroll
            for (int b = 0; b < 2; ++b)
#pragma unroll
                for (int m = 0; m < 4; ++m)
#pragma unroll
                    for (int n = 0; n < 2; ++n) acc[a][b][m][n] = (f32x4){0.f, 0.f, 0.f, 0.f};
        cur = nxt; cA = nA; cB = nB; ++ui;
        if constexpr (ALIGN_EPI) { if (wr == 1) PG8_BAR; }
    }
    PG8_WAIT_V(0);
    if constexpr (!ALIGN_EPI) { if (wr == 0) PG8_BAR; }
    PG8_BAR;
    if constexpr (Epi::AFTER_DRAIN) { E.fused(acc, cur, wr, wc, fr, fq, lds, wid, lane); S.done(cur); }
#undef PG8_SA
#undef PG8_SB
#undef PG8_STAGE
#undef PG8_LDA
#undef PG8_LDB
#undef PG8_MMA
#undef PG8_WAIT_V
#undef PG8_WAIT_L
#undef PG8_BAR
#undef PG8_SCHED
}
}

namespace attn_body {
using bf16=unsigned short;
using bf16x8=__attribute__((ext_vector_type(8)))short;
using s16x4=__attribute__((ext_vector_type(4)))short;
using f32x16=__attribute__((ext_vector_type(16)))float;
using u32x4=__attribute__((ext_vector_type(4)))unsigned;
constexpr int ASEQ=4096,D=64,ADM=1024;
constexpr int NW=8,QBLK=32,QB=QBLK*NW,KVBLK=64;
__device__ __forceinline__ int crow(int r,int hi){return (r&3)+8*(r>>2)+4*hi;}
#define SBAR() __builtin_amdgcn_sched_barrier(0)
__device__ __forceinline__ void cmask(f32x16&p0,f32x16&p1,int jb,int qrel,int hi){
  const float NEG=-INFINITY; int kb=qrel-(64*jb+4*hi); asm volatile("":"+v"(kb));
  #pragma unroll
  for(int r=0;r<16;++r){const int c=(r&3)+8*(r>>2); if(c>kb)p0[r]=NEG; if(c+32>kb)p1[r]=NEG;}
}
__device__ __forceinline__ void wmask(f32x16&p0,f32x16&p1,int delta,int hi){
  const float NEG=-INFINITY; int d0=delta-4*hi; asm volatile("":"+v"(d0));
  #pragma unroll
  for(int r=0;r<16;++r){const int dd=d0-((r&3)+8*(r>>2)); if((unsigned)dd>=128u)p0[r]=NEG; if((unsigned)(dd-32)>=128u)p1[r]=NEG;}
}

constexpr int NSLOT=3, SLOTB=8192;
constexpr int LDS_K=0, LDS_V=NSLOT*SLOTB, LDS_WS=2*NSLOT*SLOTB, LDS_OST=LDS_WS+NW*64*4, LDS_KM=LDS_OST+NW*8192, LDS_BYTES=LDS_KM+4096;
__device__ __forceinline__ void glds16(const void*sbase,unsigned voff,unsigned lds_dst){unsigned keep;
  asm volatile("s_nop 4\n\ts_mov_b32 %0, m0\n\ts_mov_b32 m0, %2\n\ts_nop 0\n\tglobal_load_lds_dwordx4 %1, %3\n\ts_mov_b32 m0, %0":"=&s"(keep):"v"(voff),"s"(lds_dst),"s"(sbase):"memory");}
__device__ __forceinline__ float max3f(float a,float b,float c){float r;asm("v_max3_f32 %0, %1, %2, %3":"=v"(r):"v"(a),"v"(b),"v"(c));return r;}
__device__ __forceinline__ float max2f(float a,float b){float r;asm("v_max_f32_e32 %0, %1, %2":"=v"(r):"v"(a),"v"(b));return r;}
__device__ __forceinline__ float fadd_s(float a,float b){float r;asm("v_add_f32_e32 %0, %1, %2":"=v"(r):"v"(a),"v"(b));return r;}
__device__ __forceinline__ float fsub_s(float a,float b){float r;asm("v_sub_f32_e32 %0, %1, %2":"=v"(r):"v"(a),"v"(b));return r;}
typedef float f32x2_t __attribute__((ext_vector_type(2))); typedef __bf16 bf16x2_t __attribute__((ext_vector_type(2)));
__device__ __forceinline__ unsigned cvtpk_s(float lo,float hi){f32x2_t v={lo,hi};bf16x2_t b=__builtin_convertvector(v,bf16x2_t);return __builtin_bit_cast(unsigned,b);}
#define WAIT_BAR(N) asm volatile("s_waitcnt vmcnt(" #N ") lgkmcnt(0)\n\ts_barrier":::"memory")

__device__ __forceinline__ void qkt(f32x16&p0,f32x16&p1,const char*Kslot,const bf16x8*qr,const f32x16&negm,int r32,int hi){
  const char*kb=Kslot+hi*1024+r32*16;
  #pragma unroll
  for(int d0=0;d0<4;++d0){
    const bf16x8 b0=*reinterpret_cast<const bf16x8*>(kb+d0*2048);
    const bf16x8 b1=*reinterpret_cast<const bf16x8*>(kb+d0*2048+512);
    if(d0==0){p0=__builtin_amdgcn_mfma_f32_32x32x16_bf16(b0,qr[0],negm,0,0,0);p1=__builtin_amdgcn_mfma_f32_32x32x16_bf16(b1,qr[0],negm,0,0,0);}
    else{p0=__builtin_amdgcn_mfma_f32_32x32x16_bf16(b0,qr[d0],p0,0,0,0);p1=__builtin_amdgcn_mfma_f32_32x32x16_bf16(b1,qr[d0],p1,0,0,0);}}
}
typedef __attribute__((address_space(3))) const char* lds_cptr;
typedef short v4i16_t __attribute__((ext_vector_type(4)));
__device__ __forceinline__ void kload8(bf16x8*kf,lds_cptr kp){
  kf[0]=*(const __attribute__((address_space(3))) bf16x8*)(kp);      kf[1]=*(const __attribute__((address_space(3))) bf16x8*)(kp+512);
  kf[2]=*(const __attribute__((address_space(3))) bf16x8*)(kp+2048); kf[3]=*(const __attribute__((address_space(3))) bf16x8*)(kp+2560);
  kf[4]=*(const __attribute__((address_space(3))) bf16x8*)(kp+4096); kf[5]=*(const __attribute__((address_space(3))) bf16x8*)(kp+4608);
  kf[6]=*(const __attribute__((address_space(3))) bf16x8*)(kp+6144); kf[7]=*(const __attribute__((address_space(3))) bf16x8*)(kp+6656);
}
__device__ __forceinline__ void kload2(bf16x8*kf,lds_cptr kp,int j){ kf[2*j]=*(const __attribute__((address_space(3))) bf16x8*)(kp+j*2048); kf[2*j+1]=*(const __attribute__((address_space(3))) bf16x8*)(kp+j*2048+512); }
__device__ __forceinline__ s16x4 vtr(lds_cptr p){ return __builtin_bit_cast(s16x4,__builtin_amdgcn_ds_read_tr16_b64_v4i16((__attribute__((address_space(3))) v4i16_t*)p)); }
__device__ __forceinline__ float rowmax(const f32x16&p0,const f32x16&p1){
  float a=max3f(p0[0],p0[1],p1[0]),b=max3f(p0[2],p0[3],p1[1]);a=max3f(a,p1[2],p1[3]);
  #pragma unroll
  for(int r=4;r<16;r+=4){a=max3f(a,p0[r],p0[r+1]);b=max3f(b,p0[r+2],p0[r+3]);a=max3f(a,p1[r],p1[r+1]);b=max3f(b,p1[r+2],p1[r+3]);}
  const float m=max2f(a,b);
  auto rr=__builtin_amdgcn_permlane32_swap(__float_as_uint(m),__float_as_uint(m),false,false);
  return max2f(__uint_as_float(rr[0]),__uint_as_float(rr[1]));
}
__device__ __forceinline__ void pv(f32x16*o,int vb,bf16x8 pa0,bf16x8 pa1,bf16x8 pa2,bf16x8 pa3){
  #pragma unroll
  for(int d0=0;d0<2;++d0){s16x4 lo[4],hi[4];
    #pragma unroll
    for(int ks=0;ks<4;++ks){
      asm volatile("ds_read_b64_tr_b16 %0,%1 offset:%c2":"=&v"(lo[ks]):"v"(vb),"i"(d0*4096+ks*1024):"memory");
      asm volatile("ds_read_b64_tr_b16 %0,%1 offset:%c2":"=&v"(hi[ks]):"v"(vb),"i"(d0*4096+ks*1024+512):"memory");}
    asm volatile("s_waitcnt lgkmcnt(0)":::"memory");SBAR();
    #define PK(k) (bf16x8){lo[k][0],lo[k][1],lo[k][2],lo[k][3],hi[k][0],hi[k][1],hi[k][2],hi[k][3]}
    o[d0]=__builtin_amdgcn_mfma_f32_32x32x16_bf16(pa0,PK(0),o[d0],0,0,0);
    o[d0]=__builtin_amdgcn_mfma_f32_32x32x16_bf16(pa1,PK(1),o[d0],0,0,0);
    o[d0]=__builtin_amdgcn_mfma_f32_32x32x16_bf16(pa2,PK(2),o[d0],0,0,0);
    o[d0]=__builtin_amdgcn_mfma_f32_32x32x16_bf16(pa3,PK(3),o[d0],0,0,0);
    #undef PK
  }
}

template<int MODE,int THRL> __device__ __forceinline__ void attn_unit(int b,int h,int qb,const bf16*Q,const bf16*__restrict__ K,const bf16*__restrict__ V,const bf16*__restrict__ Z,bf16*G,const float*__restrict__ aux,char*shm){
  constexpr int KVW=MODE?256:128;
  const int kvh=MODE?(h>>2):(h>>3);
  int tid_=threadIdx.x; asm volatile("":"+v"(tid_));
  const int tid=tid_,lane=tid&63,r32=lane&31,hi=lane>>5; const int wid=__builtin_amdgcn_readfirstlane(tid>>6);
  const long rowbase=(long)b*ASEQ; const int q0=qb*QB;
  const bf16*Qw=Q+(rowbase+q0+wid*QBLK)*ADM+h*D;
  const bf16*Kh=K+rowbase*KVW+kvh*D,*Vh=V+rowbase*KVW+kvh*D;
  const unsigned lds0=(unsigned)(uintptr_t)shm;
  float*wsf=(float*)(shm+LDS_WS)+wid*64;
  const int NT=MODE?(4*qb+4):(qb?6:4);
  const int ktA=MODE?(4*qb):(qb?4*qb-2:0);
  #define KT(s) (MODE?(((s)<4)?(ktA+(s)):((s)-4)):(ktA+(s)))
  if(MODE){ float*km=(float*)(shm+LDS_KM); const float*ks=aux+((size_t)(b*16)*2)*256+kvh*64;
    for(int idx=tid;idx<qb*64;idx+=512){const int j=idx>>6,d=idx&63; km[idx]=(ks[(size_t)(2*j)*256+d]+ks[(size_t)(2*j+1)*256+d])*(1.0f/256.0f);} }
  const unsigned kvoff=(unsigned)(lane*KVW+wid*8)*2u;
  const unsigned vvoff=(unsigned)((16*(wid&3)+(lane>>2))*KVW+(wid>>2)*32+(lane&3)*8)*2u;
  const unsigned kdst=lds0+LDS_K+wid*1024, vdst=lds0+LDS_V+wid*1024;
  #define DMA_K(s,slot) glds16(Kh+(long)KT(s)*KVBLK*KVW,kvoff,(unsigned)__builtin_amdgcn_readfirstlane(kdst+(slot)))
  #define DMA_V(s,slot) glds16(Vh+(long)KT(s)*KVBLK*KVW,vvoff,(unsigned)__builtin_amdgcn_readfirstlane(vdst+(slot)))
  const int vb0=(int)(lds0+LDS_V)+((lane>>4)&1)*32+(lane&3)*8+(4*hi+((lane&15)>>2))*64;
  const char*Kbase=shm+LDS_K; bf16x8 kf[8];
  const lds_cptr shm3=(lds_cptr)shm; const lds_cptr kp0=shm3+LDS_K+hi*1024+r32*16; const lds_cptr vp0=shm3+LDS_V+((lane>>4)&1)*32+(lane&3)*8+(4*hi+((lane&15)>>2))*64;
  DMA_K(0,0);DMA_V(0,0);DMA_K(1,SLOTB);
  bf16x8 qr[4];
  #pragma unroll
  for(int d0=0;d0<4;++d0)qr[d0]=*reinterpret_cast<const bf16x8*>(&Qw[(long)r32*ADM+d0*16+hi*8]);
  float mhat=0.f,l_reg=0.f;f32x16 o[2];o[0]=f32x16{};o[1]=f32x16{};
  const f32x16 zc=f32x16{};
  const int qrel=wid*QBLK+r32;
  #define AMASK(P0,P1,s) do{ if(MODE){ if((s)<4)cmask(P0,P1,(s),qrel,hi); } else { wmask(P0,P1,q0+qrel-64*KT(s),hi); } }while(0)
  bool resc=false; unsigned selmask=0u; unsigned pm_=0xffffffffu;
  #define PMOF(s) ((MODE&&(s)>=4)?((((selmask>>((((s)-4)>>2)&31))&1u)!=0u)?0xffffffffu:0u):0xffffffffu)
  #define RESC() do{ if(resc){ asm volatile("s_waitcnt lgkmcnt(0)":::"memory"); \
      _Pragma("unroll") for(int d_=0;d_<2;++d_) _Pragma("unroll") for(int r=0;r<16;++r)o[d_][r]*=wsf[crow(r,hi)]; } }while(0)
  #define REFUPD(C0,C1,rm,LOWOK) do{ resc=false; \
      const float gr_=rm-mhat; \
      if(__builtin_expect(__any((gr_>(float)THRL)||((LOWOK)&&(rm<-60.f)&&(rm>-INFINITY))),0)){ \
        const float dl=((LOWOK)&&(rm<-60.f)&&(rm>-INFINITY))?gr_:__builtin_fmaxf(gr_,0.f); mhat+=dl; \
        const float f=__builtin_amdgcn_exp2f(-dl); l_reg*=f; if(hi==0)wsf[r32]=f; resc=true; } \
      if(__builtin_expect(__any(mhat!=0.f),0)){ _Pragma("unroll") for(int r=0;r<16;++r){C0[r]-=mhat;C1[r]-=mhat;} } }while(0)
  f32x16 pA0,pA1,pB0,pB1;
  int sl_prev=0,sl_cur=0,sl_next=SLOTB;
  #define ROT() do{sl_prev=sl_cur;sl_cur=sl_next;sl_next=(sl_next==(NSLOT-1)*SLOTB)?0:sl_next+SLOTB;}while(0)
  DMA_K(2,2*SLOTB);
  WAIT_BAR(3);
  SBAR();
  if(MODE){
    const float*km=(const float*)(shm+LDS_KM)+8*hi; float qf[32];
    #pragma unroll
    for(int d0=0;d0<4;++d0){
      #pragma unroll
      for(int e=0;e<8;++e)qf[d0*8+e]=__uint_as_float(((unsigned)(unsigned short)qr[d0][e])<<16);}
    float v1=-INFINITY,v2=-INFINITY,v3=-INFINITY; unsigned b1=0u,b2=0u,b3=0u;
    for(int j=0;j<qb;++j){ const float*kp=km+j*64; float g=0.f;
      #pragma unroll
      for(int d0=0;d0<4;++d0){
        #pragma unroll
        for(int e=0;e<8;++e)g+=qf[d0*8+e]*kp[16*d0+e];}
      g+=__shfl_xor(g,32);
      const unsigned bj=1u<<j; const bool c1=g>v1,c2=g>v2,c3=g>v3;
      v3=c2?v2:(c3?g:v3); b3=c2?b2:(c3?bj:b3);
      v2=c1?v1:(c2?g:v2); b2=c1?b1:(c2?bj:b2);
      v1=c1?g:v1;         b1=c1?bj:b1; }
    selmask=b1|b2|b3; asm volatile("":"+v"(selmask)); }
  SBAR();
  qkt(pA0,pA1,Kbase,qr,zc,r32,hi);asm volatile("s_nop 15\n\ts_nop 7":"+v"(pA0),"+v"(pA1));AMASK(pA0,pA1,0);
  { const float rm0=rowmax(pA0,pA1); REFUPD(pA0,pA1,rm0,true); }
  _Pragma("unroll") for(int r=0;r<16;++r)pA0[r]=__builtin_amdgcn_exp2f(pA0[r]);
  _Pragma("unroll") for(int r=0;r<16;++r)pA1[r]=__builtin_amdgcn_exp2f(pA1[r]);
  WAIT_BAR(0);
  DMA_K(3,0);DMA_V(1,SLOTB);
  ROT();
  kload8(kf,kp0+sl_cur);
  WAIT_BAR(2);
  s16x4 vlo[8],vhi[8]; u32x4 pw0,pw1,pw2,pw3;
  #define PKW(P,B) (MODE?(cvtpk_s(P[B],P[B+1])&pm_):cvtpk_s(P[B],P[B+1]))
  #define PAF(k) __builtin_bit_cast(bf16x8,pw##k)
  #define VFR(i) (bf16x8){vlo[i][0],vlo[i][1],vlo[i][2],vlo[i][3],vhi[i][0],vhi[i][1],vhi[i][2],vhi[i][3]}
  #define PIN(x) asm volatile("":"+v"(x))
  #define MX3(a,b,c) __builtin_fmaxf(__builtin_fmaxf((a),(b)),(c))
  #define GAPA(MF,A0,A1,A2,A3,W0,W1,PW) do{ MF; sacc+=A0; sacc+=A1; sacc+=A2; sacc+=A3; PIN(sacc); W0; W1; PIN(PW); SBAR(); }while(0)
  #define EX(v) __builtin_amdgcn_exp2f(v)
  #define GAPB(MF,X,B) do{ MF; X[B]=EX(X[B]); X[B+1]=EX(X[B+1]); X[B+2]=EX(X[B+2]); X[B+3]=EX(X[B+3]); PIN(X); SBAR(); }while(0)
  #define VRD(i) do{ vlo[i]=vtr(vp_+(((i)>>2)*4096+((i)&3)*1024)); vhi[i]=vtr(vp_+(((i)>>2)*4096+((i)&3)*1024+512)); }while(0)
  #define KRD(G,j) do{ if(G){ kload2(kf,kp0+sl_next,j); SBAR(); } }while(0)
  #define STEP(C0,C1,P0,P1,t,GK,GV,GL) do{ SBAR(); \
    const lds_cptr vp_=vp0+sl_prev; \
    VRD(0); SBAR(); float sacc=(P0[0]+P0[1]); \
    GAPA(C0=__builtin_amdgcn_mfma_f32_32x32x16_bf16(kf[0],qr[0],zc,0,0,0), P0[2],P0[3],P0[4],P0[5],     pw0[0]=PKW(P0,0), pw0[1]=PKW(P0,2), pw0); \
    VRD(4); SBAR(); GAPA(C1=__builtin_amdgcn_mfma_f32_32x32x16_bf16(kf[1],qr[0],zc,0,0,0), P0[6],P0[7],P0[8],P0[9],     pw0[2]=PKW(P0,4), pw0[3]=PKW(P0,6), pw0); \
    VRD(1); SBAR(); GAPA(C0=__builtin_amdgcn_mfma_f32_32x32x16_bf16(kf[2],qr[1],C0,0,0,0),   P0[10],P0[11],P0[12],P0[13], pw1[0]=PKW(P0,8), pw1[1]=PKW(P0,10), pw1); \
    VRD(5); SBAR(); GAPA(C1=__builtin_amdgcn_mfma_f32_32x32x16_bf16(kf[3],qr[1],C1,0,0,0),   P0[14],P0[15],P1[0],P1[1],   pw1[2]=PKW(P0,12),pw1[3]=PKW(P0,14), pw1); \
    VRD(2); SBAR(); GAPA(C0=__builtin_amdgcn_mfma_f32_32x32x16_bf16(kf[4],qr[2],C0,0,0,0),   P1[2],P1[3],P1[4],P1[5],     pw2[0]=PKW(P1,0), pw2[1]=PKW(P1,2), pw2); \
    VRD(6); SBAR(); GAPA(C1=__builtin_amdgcn_mfma_f32_32x32x16_bf16(kf[5],qr[2],C1,0,0,0),   P1[6],P1[7],P1[8],P1[9],     pw2[2]=PKW(P1,4), pw2[3]=PKW(P1,6), pw2); \
    VRD(3); SBAR(); GAPA(C0=__builtin_amdgcn_mfma_f32_32x32x16_bf16(kf[6],qr[3],C0,0,0,0),   P1[10],P1[11],P1[12],P1[13], pw3[0]=PKW(P1,8), pw3[1]=PKW(P1,10), pw3); \
    VRD(7); SBAR(); GAPA(C1=__builtin_amdgcn_mfma_f32_32x32x16_bf16(kf[7],qr[3],C1,0,0,0),   P1[14],P1[15],0.f,0.f,       pw3[2]=PKW(P1,12),pw3[3]=PKW(P1,14), pw3); \
    l_reg+=(MODE?(pm_?sacc:0.f):sacc); \
    if(GK){DMA_K((t)+3,sl_cur);} if(GV){DMA_V((t)+1,sl_next);} \
    AMASK(C0,C1,t); \
    { float a=MX3(C0[0],C0[1],C1[0]),b=MX3(C0[2],C0[3],C1[1]); a=MX3(a,C1[2],C1[3]); \
      _Pragma("unroll") for(int r=4;r<16;r+=4){a=MX3(a,C0[r],C0[r+1]);b=MX3(b,C0[r+2],C0[r+3]);a=MX3(a,C1[r],C1[r+1]);b=MX3(b,C1[r+2],C1[r+3]);} \
      float rm=__builtin_fmaxf(a,b); { auto rr=__builtin_amdgcn_permlane32_swap(__float_as_uint(rm),__float_as_uint(rm),false,false); rm=__builtin_fmaxf(__uint_as_float(rr[0]),__uint_as_float(rr[1])); } \
      pm_=PMOF(t); if(MODE){ rm=pm_?rm:-INFINITY; } \
      REFUPD(C0,C1,rm,false); } \
    SBAR(); \
    GAPB(o[0]=__builtin_amdgcn_mfma_f32_32x32x16_bf16(PAF(0),VFR(0),o[0],0,0,0), C0,0); \
    GAPB(o[1]=__builtin_amdgcn_mfma_f32_32x32x16_bf16(PAF(0),VFR(4),o[1],0,0,0), C0,4); \
    KRD(GL,0); GAPB(o[0]=__builtin_amdgcn_mfma_f32_32x32x16_bf16(PAF(1),VFR(1),o[0],0,0,0), C0,8); \
    KRD(GL,1); GAPB(o[1]=__builtin_amdgcn_mfma_f32_32x32x16_bf16(PAF(1),VFR(5),o[1],0,0,0), C0,12); \
    KRD(GL,2); GAPB(o[0]=__builtin_amdgcn_mfma_f32_32x32x16_bf16(PAF(2),VFR(2),o[0],0,0,0), C1,0); \
    KRD(GL,3); GAPB(o[1]=__builtin_amdgcn_mfma_f32_32x32x16_bf16(PAF(2),VFR(6),o[1],0,0,0), C1,4); \
    GAPB(o[0]=__builtin_amdgcn_mfma_f32_32x32x16_bf16(PAF(3),VFR(3),o[0],0,0,0), C1,8); \
    GAPB(o[1]=__builtin_amdgcn_mfma_f32_32x32x16_bf16(PAF(3),VFR(7),o[1],0,0,0), C1,12); \
    }while(0)
  int t=1;
  for(;t+5<NT;t+=2){
    STEP(pB0,pB1,pA0,pA1,t,true,true,true);     WAIT_BAR(2); RESC(); ROT();
    STEP(pA0,pA1,pB0,pB1,t+1,true,true,true);   WAIT_BAR(2); RESC(); ROT();
  }
  #define ENDW(tt) do{ if((tt)+3<NT){WAIT_BAR(2);} else if((tt)+2<NT){WAIT_BAR(1);} else {WAIT_BAR(0);} }while(0)
  for(;t+1<NT;t+=2){
    STEP(pB0,pB1,pA0,pA1,t,(t+3<NT),(t+1<NT),(t+1<NT));       ENDW(t);   RESC(); ROT();
    STEP(pA0,pA1,pB0,pB1,t+1,(t+4<NT),(t+2<NT),(t+2<NT));     ENDW(t+1); RESC(); ROT();
  }
  STEP(pB0,pB1,pA0,pA1,NT-1,false,false,false); RESC();
  { float sacc=pB0[0]+pB0[1]; _Pragma("unroll") for(int r=2;r<16;++r)sacc+=pB0[r]; _Pragma("unroll") for(int r=0;r<16;++r)sacc+=pB1[r]; l_reg+=(MODE?(pm_?sacc:0.f):sacc);
    pw0=(u32x4){PKW(pB0,0),PKW(pB0,2),PKW(pB0,4),PKW(pB0,6)};pw1=(u32x4){PKW(pB0,8),PKW(pB0,10),PKW(pB0,12),PKW(pB0,14)};pw2=(u32x4){PKW(pB1,0),PKW(pB1,2),PKW(pB1,4),PKW(pB1,6)};pw3=(u32x4){PKW(pB1,8),PKW(pB1,10),PKW(pB1,12),PKW(pB1,14)};
    SBAR(); pv(o,vb0+sl_cur,PAF(0),PAF(1),PAF(2),PAF(3)); }
  #undef PKW
  #undef PAF
  #undef VFR
  #undef PIN
  #undef MX3
  #undef GAPA
  #undef GAPB
  #undef EX
  #undef VRD
  #undef KRD
  #undef STEP
  #undef ENDW
  {auto rr=__builtin_amdgcn_permlane32_swap(__float_as_uint(l_reg),__float_as_uint(l_reg),false,false);l_reg=__uint_as_float(rr[0])+__uint_as_float(rr[1]);}
  if(!MODE)l_reg+=__builtin_amdgcn_exp2f(aux[h]*1.4426950408889634f-mhat);
  long grow0=rowbase+q0+wid*QBLK; asm volatile("":"+v"(grow0));
  u32x4 zv[4];
  #pragma unroll
  for(int i=0;i<4;++i){const int row=i*8+(lane>>3),ch=lane&7; zv[i]=*(const u32x4*)(Z+(grow0+row)*ADM+h*D+ch*8);}
  if(hi==0)wsf[32+r32]=l_reg;asm volatile("s_waitcnt lgkmcnt(0)":::"memory");
  float rli[16];
  #pragma unroll
  for(int r=0;r<16;++r)rli[r]=__builtin_amdgcn_rcpf(wsf[32+crow(r,hi)]);
  { float*stg=(float*)(shm+LDS_OST)+wid*2048;
    #pragma unroll
    for(int r=0;r<16;++r){const int orow=crow(r,hi);
      #pragma unroll
      for(int d0=0;d0<2;++d0)stg[orow*64+d0*32+r32]=o[d0][r]*rli[r];}
    asm volatile("s_waitcnt lgkmcnt(0)":::"memory");
    #pragma unroll
    for(int i=0;i<4;++i){const int row=i*8+(lane>>3),ch=lane&7; const f32x4 a0=*(const f32x4*)(stg+row*64+ch*8),a1=*(const f32x4*)(stg+row*64+ch*8+4);
      float zf[8]; zf[0]=__uint_as_float(zv[i].x<<16);zf[1]=__uint_as_float(zv[i].x&0xffff0000u);zf[2]=__uint_as_float(zv[i].y<<16);zf[3]=__uint_as_float(zv[i].y&0xffff0000u);
      zf[4]=__uint_as_float(zv[i].z<<16);zf[5]=__uint_as_float(zv[i].z&0xffff0000u);zf[6]=__uint_as_float(zv[i].w<<16);zf[7]=__uint_as_float(zv[i].w&0xffff0000u);
      float gv[8];
      #pragma unroll
      for(int e=0;e<8;++e){const float ov=e<4?a0[e]:a1[e-4]; gv[e]=ov*zf[e]*__builtin_amdgcn_rcpf(1.0f+__builtin_amdgcn_exp2f(-1.4426950408889634f*zf[e]));}
      u32x4 w; w.x=cvtpk_s(gv[0],gv[1]);w.y=cvtpk_s(gv[2],gv[3]);w.z=cvtpk_s(gv[4],gv[5]);w.w=cvtpk_s(gv[6],gv[7]);
      *(u32x4*)(G+(grow0+row)*ADM+h*D+ch*8)=w;} }
  asm volatile("s_waitcnt lgkmcnt(0)\n\ts_barrier":::"memory");
  #undef DMA_K
  #undef DMA_V
  #undef KT
  #undef AMASK
  #undef PMOF
  #undef REFUPD
  #undef RESC
  #undef ROT
}
constexpr int ATTN_LDS_BYTES=LDS_BYTES;
#undef SBAR
#undef WAIT_BAR
}

#define GAS __attribute__((address_space(1)))
#define LAS __attribute__((address_space(3)))
typedef unsigned short bf16;
typedef unsigned v4u __attribute__((ext_vector_type(4)));
typedef float f32x4 __attribute__((ext_vector_type(4)));
typedef short bf16x8 __attribute__((ext_vector_type(8)));
typedef GAS unsigned gu32;
typedef GAS unsigned long long gu64;
#define RLX_AGENT __ATOMIC_RELAXED, __HIP_MEMORY_SCOPE_AGENT
#define LDS_WAIT() asm volatile("s_waitcnt lgkmcnt(0)" ::: "memory")
#define VM_WAIT() asm volatile("s_waitcnt vmcnt(0)" ::: "memory")
__device__ __forceinline__ unsigned long long rt() { return __builtin_amdgcn_s_memrealtime(); }
__device__ __forceinline__ unsigned pk2(float lo, float hi) { return f2bf(lo) | (f2bf(hi) << 16); }

#define XB_TMO      128
#define XB_XCNT(j)  (256  + 64 * (j))
#define XB_XSUB(j)  (1280 + 64 * (j))
#define XB_XGEN(j)  (2304 + 64 * (j))
#define XB_TOP      3328
#define XB_TOPGEN   3392
#define XCD_BAR_WORDS 3456
#define XB_SPIN_CAP (1u << 18)

__device__ __forceinline__ unsigned xb_ld(unsigned* p)              { return __hip_atomic_load(p, __ATOMIC_RELAXED, __HIP_MEMORY_SCOPE_AGENT); }
__device__ __forceinline__ unsigned xb_add(unsigned* p, unsigned v) { return __hip_atomic_fetch_add(p, v, __ATOMIC_RELAXED, __HIP_MEMORY_SCOPE_AGENT); }
__device__ __forceinline__ unsigned xb_xcc_id() { return (unsigned)__builtin_amdgcn_s_getreg((3 << 11) | 20) & 0xFu; }
#define XB_SPIN(cond, bar) do { unsigned _sp = 0; while (cond) { __builtin_amdgcn_s_sleep(1); \
    if ((++_sp & 255u) == 0u) { if (xb_ld(&(bar)[XB_TMO])) break; if (_sp > XB_SPIN_CAP) { atomicAdd(&(bar)[XB_TMO], 1u); break; } } } } while (0)

struct XcdBarrier {
    unsigned* bar; unsigned x;
    volatile LAS unsigned* st;
};

__device__ __forceinline__ XcdBarrier xcd_barrier_post(unsigned* bar, volatile LAS unsigned* st) {
    XcdBarrier b; b.bar = bar; b.x = xb_xcc_id(); b.st = st;
    if (threadIdx.x == 0) (void)xb_add(&bar[XB_XCNT(b.x)], 1u);
    return b;
}
__device__ __forceinline__ void xcd_barrier_complete(unsigned* bar, unsigned x, unsigned& nloc, unsigned& nx) {
    const unsigned G = gridDim.x * gridDim.y * gridDim.z;
    unsigned sum, cnt, mine, sp = 0u;
    for (;;) {
        sum = 0u; cnt = 0u; mine = 0u;
#pragma unroll
        for (unsigned j = 0; j < 16; ++j) { const unsigned c = xb_ld(&bar[XB_XCNT(j)]); sum += c; cnt += (c > 0u) ? 1u : 0u; mine = (j == x) ? c : mine; }
        if (sum == G) break;
        __builtin_amdgcn_s_sleep(1);
        if ((++sp & 255u) == 0u) { if (xb_ld(&bar[XB_TMO])) break; if (sp > XB_SPIN_CAP) { atomicAdd(&bar[XB_TMO], 1u); break; } }
    }
    nloc = mine > 0u ? mine : 1u; nx = cnt > 0u ? cnt : 1u;
}

__device__ __forceinline__ void xcd_barrier(const XcdBarrier& b) {
    asm volatile("s_waitcnt vmcnt(0)" ::: "memory");
    __syncthreads();
    if (threadIdx.x == 0) {
        unsigned* bar = b.bar;
        __builtin_amdgcn_s_waitcnt(0);
        unsigned nloc = b.st[0], nx = b.st[1];
        if (nloc == 0u) { xcd_barrier_complete(bar, b.x, nloc, nx); b.st[0] = nloc; b.st[1] = nx; }
        const unsigned old = xb_add(&bar[XB_XSUB(b.x)], 1u);
        const unsigned gen = old / nloc;
        if (old + 1u == (gen + 1u) * nloc) {
            __builtin_amdgcn_fence(__ATOMIC_RELEASE, "agent");
            asm volatile("s_waitcnt vmcnt(0)" ::: "memory");
            const unsigned og = xb_add(&bar[XB_TOP], 1u);
            const unsigned tg = og / nx;
            if (og + 1u == (tg + 1u) * nx) xb_add(&bar[XB_TOPGEN], 1u);
            else XB_SPIN(xb_ld(&bar[XB_TOPGEN]) == tg, bar);
            __builtin_amdgcn_fence(__ATOMIC_ACQUIRE, "agent");
            xb_add(&bar[XB_XGEN(b.x)], 1u);
            asm volatile("s_waitcnt vmcnt(0)" ::: "memory");
        } else {
            XB_SPIN(xb_ld(&bar[XB_XGEN(b.x)]) == gen, bar);
            __builtin_amdgcn_fence(__ATOMIC_ACQUIRE, "agent");
            asm volatile("s_waitcnt vmcnt(0)" ::: "memory");
        }
    }
    __syncthreads();
}

constexpr int NWAVES = 8;
#ifndef MK_EN
#define MK_EN 15
#endif
constexpr int NPH = 14;
constexpr int RING_OFF = 0, RING_BYTES = 131072;
constexpr int LDS_BYTES = 147456;
constexpr int LDSCTL_OFF = LDS_BYTES - 512, MISC_OFF = LDSCTL_OFF + 320;
constexpr int CW_TMO = 0, CW_BAR = 4096;
constexpr size_t CTL_ZERO_BYTES = 64 * 1024;
static_assert((CW_BAR + XCD_BAR_WORDS) * 4 <= (int)CTL_ZERO_BYTES, "barrier words inside the memset region");
static_assert(attn_body::ATTN_LDS_BYTES <= RING_BYTES, "attention LDS");

__constant__ const unsigned ROPE_INV_BITS[32] = {0x3f800000u, 0x3f3ff911u, 0x3f0ff59au, 0x3ed7e89bu, 0x3ea1e89bu, 0x3e72d424u, 0x3e361887u, 0x3e088d77u, 0x3dcccccdu, 0x3d99940eu, 0x3d6655c3u, 0x3d2cba15u, 0x3d0186e2u, 0x3cc24350u, 0x3c91ad39u, 0x3c5a7bf1u,
    0x3c23d70au, 0x3bf5b9b0u, 0x3bb8449cu, 0x3b8a2e77u, 0x3b4f3e37u, 0x3b1b690du, 0x3ae91528u, 0x3aaec98eu, 0x3a83126fu, 0x3a44948cu, 0x3a136a16u, 0x39dd1726u, 0x39a5cb5fu, 0x3978a814u, 0x393a7753u, 0x390bd472u};
struct Args { const float* in[7]; float* out; unsigned char* ws; int ph_lo, ph_hi; };

__device__ __forceinline__ void p0_w_item(const float* __restrict__ W, int ldw, int k0, int n0, bool perm, const float* __restrict__ g, bf16_t* __restrict__ Wt, LAS float* scr, int lane) {
#pragma unroll 8
    for (int kk = 0; kk < 64; ++kk) { const float gv = g ? g[k0 + kk] : 1.0f; scr[kk * 65 + lane] = W[(size_t)(k0 + kk) * ldw + n0 + lane] * gv; }
    LDS_WAIT(); asm volatile("" ::: "memory");
    const int c = lane & 7;
#pragma unroll
    for (int j = 0; j < 8; ++j) { const int n = (lane >> 3) + 8 * j; const int sc = perm ? dmap(n) : n; const LAS float* s = scr + (8 * c) * 65 + sc;
        v4u o; o.x = pk2(s[0 * 65], s[1 * 65]); o.y = pk2(s[2 * 65], s[3 * 65]); o.z = pk2(s[4 * 65], s[5 * 65]); o.w = pk2(s[6 * 65], s[7 * 65]);
        *(GAS v4u*)(Wt + (size_t)(n0 + n) * 1024 + k0 + 8 * c) = o; }
    LDS_WAIT(); asm volatile("" ::: "memory");
}

__global__ void __launch_bounds__(NWAVES * 64, 2) mk_fwd(Args args) {
    extern __shared__ __attribute__((aligned(16))) unsigned char lds[];
    LAS unsigned char* ldsp = (LAS unsigned char*)lds;
    volatile LAS unsigned* MISC = (volatile LAS unsigned*)(ldsp + MISC_OFF);
    const int tid0 = threadIdx.x;
    gu32* ctl = (gu32*)(args.ws + WS_CTL);
    for (int u = tid0; u < (LDS_BYTES - LDSCTL_OFF) / 4; u += NWAVES * 64) ((LAS unsigned*)(ldsp + LDSCTL_OFF))[u] = 0u;
    __syncthreads();
    const int lo = args.ph_lo, hi = args.ph_hi;
    XcdBarrier bar; bar.bar = (unsigned*)(ctl + CW_BAR); bar.x = 0; bar.st = nullptr;
    if (hi - lo > 1) bar = xcd_barrier_post((unsigned*)(ctl + CW_BAR), MISC + 8);

    for (int p = lo; p < hi; ++p) {
        int tid = threadIdx.x, G = gridDim.x, bx = blockIdx.x; asm volatile("" : "+v"(tid), "+s"(G), "+s"(bx));
        const int lane = tid & 63, wave = __builtin_amdgcn_readfirstlane(tid >> 6);
        const int vcu = (G % 8 == 0) ? (bx % 8) * (G / 8) + bx / 8 : bx;
        const int gw = vcu * NWAVES + wave, NGW = G * NWAVES;
        GAS unsigned char* wsg = (GAS unsigned char*)args.ws; asm volatile("" : "+s"(wsg)); unsigned char* ws = (unsigned char*)wsg;
#define xin (args.in[0])
#define norm_g (args.in[1])
#define w_in_a (args.in[2])
#define sinks_a (args.in[3])
#define w_in_b (args.in[4])
#define w_out (args.in[5])
#define final_g (args.in[6])
#define H (args.out)
#define rope ((float*)(ws + WS_ROPE))
#define ss ((float*)(ws + WS_SS))
#define KS ((float*)(ws + WS_KS))
#define Hb ((bf16_t*)(ws + WS_HB))
#define Qb ((bf16_t*)(ws + WS_Q))
#define Zb ((bf16_t*)(ws + WS_Z))
#define Gb ((bf16_t*)(ws + WS_G))
#define Kb ((bf16_t*)(ws + WS_K))
#define Vb ((bf16_t*)(ws + WS_V))
        if (p == 0) {
            for (int idx = bx * (NWAVES * 64) + tid; idx < SEQ * 32; idx += G * NWAVES * 64) {
                const int pos = idx >> 5, i = idx & 31;
                const float ang = (float)pos * __uint_as_float(ROPE_INV_BITS[i]);
                float sn, cs; sincosf(ang, &sn, &cs);
                rope[2 * idx] = cs; rope[2 * idx + 1] = sn;
            }
            LAS float* scr = (LAS float*)(ldsp + RING_OFF + wave * 16640);
            constexpr int I_A = (IN_A / 64) * 16, I_B = (IN_B / 64) * 16, I_O = 256, I_L2 = I_A + I_O + I_B + I_O, NITEMS = 2 * I_L2;
            for (int it = gw; it < NITEMS; it += NGW) {
                const int l2 = it / I_L2; int r = it % I_L2; int l; bool isw2 = false; int IN = IN_A;
                if (r < I_A) { l = 2 * l2; }
                else if (r < I_A + I_O) { r -= I_A; l = 2 * l2; isw2 = true; }
                else if (r < I_A + I_O + I_B) { r -= I_A + I_O; l = 2 * l2 + 1; IN = IN_B; }
                else { r -= I_A + I_O + I_B; l = 2 * l2 + 1; isw2 = true; }
                const int cg = r >> 4, kg = r & 15;
                if (isw2) p0_w_item(w_out + (size_t)l * DM * DM, DM, kg * 64, cg * 64, false, nullptr, (bf16_t*)(ws + WS_W2T + l * W2T_STRIDE), scr, lane);
                else { const float* Win = (l & 1) ? w_in_b + (size_t)l2 * DM * IN_B : w_in_a + (size_t)l2 * DM * IN_A; const int kvw = (l & 1) ? 256 : 128;
                       p0_w_item(Win, IN, kg * 64, cg * 64, cg * 64 < 1024 + kvw, norm_g + l * DM, (bf16_t*)(ws + WS_W1T + l * W1T_STRIDE), scr, lane); }
            }
            for (int row = gw; row < M; row += NGW) {
                const f32x4* xr = (const f32x4*)(xin + (size_t)row * DM) + lane; float s = 0.f;
                unsigned long long* o8 = (unsigned long long*)(Hb + (size_t)row * DM) + lane;
#pragma unroll
                for (int j = 0; j < 4; ++j) { const f32x4 v = xr[64 * j]; s += (v[0] * v[0] + v[1] * v[1]) + (v[2] * v[2] + v[3] * v[3]);
                    o8[64 * j] = (unsigned long long)pk2(v[0], v[1]) | ((unsigned long long)pk2(v[2], v[3]) << 32); }
                s = wave_sum(s);
                if (lane < 16) ss[(size_t)row * 16 + lane] = lane == 0 ? s : 0.f;
            }
        } else if (p == NPH - 1) {
            for (int row = gw; row < M; row += NGW) {
                f32x4* hr = (f32x4*)(H + (size_t)row * DM) + lane; const f32x4* gr = (const f32x4*)final_g + lane;
                f32x4 v[4]; float s = 0.f;
#pragma unroll
                for (int j = 0; j < 4; ++j) { v[j] = hr[64 * j]; s += (v[j][0] * v[j][0] + v[j][1] * v[j][1]) + (v[j][2] * v[j][2] + v[j][3] * v[j][3]); }
                const float rstd = __builtin_amdgcn_rsqf(wave_sum(s) * (1.0f / DM) + EPS);
#pragma unroll
                for (int j = 0; j < 4; ++j) hr[64 * j] = v[j] * rstd * gr[64 * j];
            }
        } else {
            const int l = (p - 1) / 3, kind = (p - 1) % 3; const bool isB = l & 1;
            if (kind == 0) {
                const bf16_t* W1t = (const bf16_t*)(ws + WS_W1T + l * W1T_STRIDE);
                if (!(MK_EN & 1)) {} else if (!isB) { pg8::Gemm g{Hb, W1t, M, IN_A, DM}; pg8::StaticOrder S; S.init(M, IN_A, G, bx);
                    pg8::EpiG1<2> E{Qb, Kb, Vb, Zb, ss, rope, KS};
                    pg8::gemm_phase<pg8::EpiG1<2>, pg8::StaticOrder, true, true>(ldsp + RING_OFF, g, S, E);
                } else { pg8::Gemm g{Hb, W1t, M, IN_B, DM}; pg8::StaticOrder S; S.init(M, IN_B, G, bx);
                    pg8::EpiG1<4> E{Qb, Kb, Vb, Zb, ss, rope, KS};
                    pg8::gemm_phase<pg8::EpiG1<4>, pg8::StaticOrder, true, true>(ldsp + RING_OFF, g, S, E); }
            } else if (kind == 1) {
                if (!isB) { if (MK_EN & 2)
                    for (int U = vcu; U < 2048; U += G) { const int vc = U & 255, i = U >> 8; const int bh = vc >> 1, qb = (vc & 1) * 8 + i;
                        attn_body::attn_unit<0, 8>(bh >> 4, bh & 15, qb, Qb, Kb, Vb, Zb, Gb, sinks_a + (l >> 1) * NH, (char*)lds + RING_OFF); }
                } else { if (MK_EN & 4)
                    for (int U = vcu; U < 2048; U += G) { const int vc = U & 255, i = U >> 8; const int grp = vc >> 3, hh = (vc & 7) >> 1, half = vc & 1;
                        const int s = 2 * (i >> 1) + half, qb = (i & 1) ? 15 - s : s;
                        attn_body::attn_unit<1, 8>(grp >> 2, (grp & 3) * 4 + hh, qb, Qb, Kb, Vb, Zb, Gb, KS, (char*)lds + RING_OFF); }
                }
            } else {
                const bf16_t* W2t = (const bf16_t*)(ws + WS_W2T + l * W2T_STRIDE);
                if (MK_EN & 8) {
                pg8::Gemm g{Gb, W2t, M, DM, DM}; pg8::StaticOrder S; S.init(M, DM, G, bx);
                pg8::EpiG2 E{l == 0 ? xin : H, H, Hb, ss, l < DEPTH - 1 ? 1 : 0};
                pg8::gemm_phase<pg8::EpiG2, pg8::StaticOrder, true, true>(ldsp + RING_OFF, g, S, E); }
            }
        }
        if (p + 1 < hi) { XcdBarrier b2 = bar; GAS unsigned* bg = (GAS unsigned*)bar.bar; asm volatile("" : "+s"(bg), "+s"(b2.x)); b2.bar = (unsigned*)bg; xcd_barrier(b2); }
    }
#undef xin
#undef norm_g
#undef w_in_a
#undef sinks_a
#undef w_in_b
#undef w_out
#undef final_g
#undef H
#undef rope
#undef ss
#undef KS
#undef Hb
#undef Qb
#undef Zb
#undef Gb
#undef Kb
#undef Vb
}

#ifndef MK_FAST_MASK
#define MK_FAST_MASK 0x3fff
#endif
#ifndef MK_ONE_LAUNCH
#define MK_ONE_LAUNCH 1
#endif
extern "C" void kernel_launch(void* const* d_in, const int* in_sizes, int n_in, void* d_out, int out_size, void* d_ws, size_t ws_size, hipStream_t stream) {
    static int grid = 0;
    if (grid == 0) {
        if (n_in != 7 || in_sizes[0] != M * DM || out_size != M * DM || ws_size < WS_END) { fprintf(stderr, "kernel_launch: unexpected shapes (n_in %d, in0 %d, out %d, ws %zu)\n", n_in, n_in > 0 ? in_sizes[0] : -1, out_size, ws_size); grid = -1; return; }
        int dev = 0, cus = 0, per_cu = 0;
        if (hipGetDevice(&dev) != hipSuccess || hipDeviceGetAttribute(&cus, hipDeviceAttributeMultiprocessorCount, dev) != hipSuccess) { grid = -1; return; }
        if (hipFuncSetAttribute((const void*)mk_fwd, hipFuncAttributeMaxDynamicSharedMemorySize, LDS_BYTES) != hipSuccess) { fprintf(stderr, "kernel_launch: hipFuncSetAttribute failed\n"); grid = -1; return; }
        if (hipOccupancyMaxActiveBlocksPerMultiprocessor(&per_cu, (const void*)mk_fwd, NWAVES * 64, LDS_BYTES) != hipSuccess || per_cu < 1) fprintf(stderr, "kernel_launch: occupancy query reports %d blocks per CU\n", per_cu);
        (void)hipGetLastError();
        grid = cus;
    }
    if (grid < 0) return;
    const float* x = (const float*)d_in[0]; const float* norm_g = (const float*)d_in[1]; const float* w_in_a = (const float*)d_in[2]; const float* sinks_a = (const float*)d_in[3];
    const float* w_in_b = (const float*)d_in[4]; const float* w_out = (const float*)d_in[5]; const float* final_g = (const float*)d_in[6];
    unsigned char* ws = (unsigned char*)d_ws; float* H = (float*)d_out;
    (void)hipMemsetAsync(ws + WS_CTL, 0, CTL_ZERO_BYTES, stream);
    Args a{};
    for (int i = 0; i < 7; ++i) a.in[i] = (const float*)d_in[i];
    a.out = H; a.ws = ws;
    if (MK_ONE_LAUNCH && MK_FAST_MASK == 0x3fff) { a.ph_lo = 0; a.ph_hi = NPH; hipLaunchKernelGGL(mk_fwd, dim3(grid), dim3(NWAVES * 64), LDS_BYTES, stream, a); return; }
    float2* rope = (float2*)(ws + WS_ROPE); float* ss = (float*)(ws + WS_SS); float* KS = (float*)(ws + WS_KS);
    bf16_t* Hb = (bf16_t*)(ws + WS_HB); bf16_t* Qb = (bf16_t*)(ws + WS_Q); bf16_t* Zb = (bf16_t*)(ws + WS_Z); bf16_t* Gb = (bf16_t*)(ws + WS_G); bf16_t* Kb = (bf16_t*)(ws + WS_K); bf16_t* Vb = (bf16_t*)(ws + WS_V);
    for (int p = 0; p < NPH; ++p) {
        if ((MK_FAST_MASK >> p) & 1) { a.ph_lo = p; a.ph_hi = p + 1; hipLaunchKernelGGL(mk_fwd, dim3(grid), dim3(NWAVES * 64), LDS_BYTES, stream, a); continue; }
        if (p == 0) {
            k_prep_rope<<<SEQ * 32 / 256, 256, 0, stream>>>(rope);
            for (int l = 0; l < DEPTH; ++l) { const bool isB = l & 1; const int IN = isB ? IN_B : IN_A, KVW = isB ? 256 : 128;
                const float* Win = (isB ? w_in_b : w_in_a) + (size_t)(l >> 1) * DM * IN;
                k_prep_w1<<<(unsigned)(((size_t)IN * DM + 255) / 256), 256, 0, stream>>>(Win, norm_g + l * DM, (bf16_t*)(ws + WS_W1T + l * W1T_STRIDE), IN, KVW);
                k_prep_w2<<<DM * DM / 256, 256, 0, stream>>>(w_out + (size_t)l * DM * DM, (bf16_t*)(ws + WS_W2T + l * W2T_STRIDE)); }
            k_prep_x<<<M / 4, 256, 0, stream>>>(x, Hb, ss);
        } else if (p == NPH - 1) { k_final<<<M / 4, 256, 0, stream>>>(H, final_g);
        } else { const int l = (p - 1) / 3, kind = (p - 1) % 3; const bool isB = l & 1;
            const bf16_t* W1t = (const bf16_t*)(ws + WS_W1T + l * W1T_STRIDE); const bf16_t* W2t = (const bf16_t*)(ws + WS_W2T + l * W2T_STRIDE);
            if (kind == 0) { if (!isB) k_gemm1_naive<2><<<(M / 16) * (IN_A / 64) / 4, 256, 0, stream>>>(Hb, W1t, ss, rope, Qb, Kb, Vb, Zb);
                             else { k_gemm1_naive<4><<<(M / 16) * (IN_B / 64) / 4, 256, 0, stream>>>(Hb, W1t, ss, rope, Qb, Kb, Vb, Zb); k_ksum_naive<<<BATCH * NBLK, 256, 0, stream>>>(Kb, KS); } }
            else if (kind == 1) { if (!isB) k_attn_swa_naive<<<M * NH / 4, 256, 0, stream>>>(Qb, Kb, Vb, Zb, sinks_a + (l >> 1) * NH, Gb); else k_attn_moba_naive<<<M * NH / 4, 256, 0, stream>>>(Qb, Kb, Vb, Zb, KS, Gb); }
            else k_gemm2_naive<<<(M / 16) * 16 / 4, 256, 0, stream>>>(Gb, W2t, l == 0 ? x : H, H, Hb, ss);
        }
    }
}
```

```cpp
#define MK_FAST_MASK 0x3fff
#define MK_ONE_LAUNCH 1
#include <hip/hip_runtime.h>
#include <cstdint>
#include <cstdio>

typedef unsigned short bf16_t;
typedef short bf16x8 __attribute__((ext_vector_type(8)));
typedef float f32x4 __attribute__((ext_vector_type(4)));
typedef unsigned u32x4 __attribute__((ext_vector_type(4)));

constexpr int BATCH = 8, SEQ = 4096, DM = 1024, DEPTH = 4, HD = 64, NH = 16;
constexpr int M = BATCH * SEQ;
constexpr int IN_A = 2304, IN_B = 2560;
constexpr int WINDOW = 128, MBLK = 256, NBLK = SEQ / MBLK;
constexpr float EPS = 1e-5f;
constexpr float LOG2E = 1.4426950408889634f;
constexpr float C2 = 0.125f * LOG2E;

constexpr size_t MiB = 1u << 20;
constexpr size_t WS_CTL = 0, WS_ROPE = 1 * MiB, WS_W1T = 2 * MiB, WS_W2T = 22 * MiB, WS_SS = 30 * MiB, WS_KS = 32 * MiB;
constexpr size_t WS_HB = 64 * MiB, WS_Q = 128 * MiB, WS_Z = 192 * MiB, WS_G = 256 * MiB, WS_K = 320 * MiB, WS_V = 336 * MiB, WS_END = 352 * MiB;
constexpr size_t W1T_STRIDE = 5 * MiB, W2T_STRIDE = 2 * MiB;

__device__ __forceinline__ unsigned f2bf(float f) { unsigned u = __builtin_bit_cast(unsigned, f); return (u + 0x7fffu + ((u >> 16) & 1u)) >> 16; }
__device__ __forceinline__ float bf2f(unsigned h) { return __builtin_bit_cast(float, h << 16); }
__host__ __device__ __forceinline__ int dmap(int cc) { return (((cc >> 2) & 1) << 5) | ((cc >> 5) << 4) | (((cc >> 3) & 3) << 2) | (cc & 3); }
__host__ __device__ __forceinline__ int dinv(int d) { return (((d >> 4) & 1) << 5) | (((d >> 2) & 3) << 3) | ((d >> 5) << 2) | (d & 3); }
__device__ __forceinline__ float wave_sum(float v) {
#pragma unroll
    for (int o = 1; o < 64; o <<= 1) v += __shfl_xor(v, o);
    return v;
}
__device__ __forceinline__ float wave_max(float v) {
#pragma unroll
    for (int o = 1; o < 64; o <<= 1) v = fmaxf(v, __shfl_xor(v, o));
    return v;
}

__global__ void k_prep_rope(float2* tab) {
    const int idx = blockIdx.x * blockDim.x + threadIdx.x; if (idx >= SEQ * 32) return;
    const int pos = idx >> 5, i = idx & 31;
    const float inv = (float)pow(10000.0, -(double)i / 32.0);
    const float ang = (float)pos * inv;
    tab[idx] = make_float2((float)cos((double)ang), (float)sin((double)ang));
}
__global__ void k_prep_w1(const float* __restrict__ Win, const float* __restrict__ g, bf16_t* __restrict__ W1t, int IN, int KVW) {
    const size_t idx = (size_t)blockIdx.x * blockDim.x + threadIdx.x; if (idx >= (size_t)IN * DM) return;
    const int cp = (int)(idx / DM), k = (int)(idx % DM);
    int col = cp;
    if (cp < 1024 + KVW) col = (cp & ~63) + dmap(cp & 63);
    W1t[idx] = (bf16_t)f2bf(g[k] * Win[(size_t)k * IN + col]);
}
__global__ void k_prep_w2(const float* __restrict__ Wout, bf16_t* __restrict__ W2t) {
    const size_t idx = (size_t)blockIdx.x * blockDim.x + threadIdx.x; if (idx >= (size_t)DM * DM) return;
    const int n = (int)(idx / DM), k = (int)(idx % DM);
    W2t[idx] = (bf16_t)f2bf(Wout[(size_t)k * DM + n]);
}
__global__ void k_prep_x(const float* __restrict__ x, bf16_t* __restrict__ Hb, float* __restrict__ ss) {
    const int row = (blockIdx.x * blockDim.x + threadIdx.x) >> 6, lane = threadIdx.x & 63; if (row >= M) return;
    const f32x4* xr = (const f32x4*)(x + (size_t)row * DM) + lane; float s = 0.f;
    unsigned long long* o8 = (unsigned long long*)(Hb + (size_t)row * DM) + lane;
#pragma unroll
    for (int j = 0; j < 4; ++j) { const f32x4 v = xr[64 * j]; s += (v.x * v.x + v.y * v.y) + (v.z * v.z + v.w * v.w);
        o8[64 * j] = (unsigned long long)(f2bf(v.x) | (f2bf(v.y) << 16)) | ((unsigned long long)(f2bf(v.z) | (f2bf(v.w) << 16)) << 32); }
    s = wave_sum(s);
    if (lane < 16) ss[(size_t)row * 16 + lane] = lane == 0 ? s : 0.f;
}

template <int KVH>
__global__ __launch_bounds__(256) void k_gemm1_naive(const bf16_t* __restrict__ Hb, const bf16_t* __restrict__ W1t, const float* __restrict__ ss, const float2* __restrict__ rope,
                                                     bf16_t* __restrict__ Q, bf16_t* __restrict__ K, bf16_t* __restrict__ V, bf16_t* __restrict__ Z) {
    constexpr int KVW = KVH * 64, IN = 2048 + 2 * KVW, NG = IN / 64;
    const int wave = (int)(((size_t)blockIdx.x * 256 + threadIdx.x) >> 6), lane = threadIdx.x & 63;
    const int rt = wave / NG, cg = wave % NG; if (rt >= M / 16) return;
    const int row0 = rt * 16, lr = lane & 15, lq = lane >> 4;
    const bool rot = cg < 16 + KVH;
    f32x4 acc[4];
#pragma unroll
    for (int nb = 0; nb < 4; ++nb) acc[nb] = (f32x4){0.f, 0.f, 0.f, 0.f};
    const bf16_t* ap = Hb + (size_t)(row0 + lr) * DM + 8 * lq;
    const bf16_t* bp[4];
#pragma unroll
    for (int nb = 0; nb < 4; ++nb) { const int d = 16 * nb + lr; bp[nb] = W1t + (size_t)(cg * 64 + (rot ? dinv(d) : d)) * DM + 8 * lq; }
    for (int k0 = 0; k0 < DM; k0 += 32) {
        const bf16x8 a = *(const bf16x8*)(ap + k0);
#pragma unroll
        for (int nb = 0; nb < 4; ++nb) { const bf16x8 b = *(const bf16x8*)(bp[nb] + k0); acc[nb] = __builtin_amdgcn_mfma_f32_16x16x32_bf16(a, b, acc[nb], 0, 0, 0); }
    }
#pragma unroll
    for (int reg = 0; reg < 4; ++reg) {
        const int row = row0 + 4 * lq + reg, pos = row & (SEQ - 1);
        const f32x4* sp = (const f32x4*)(ss + (size_t)row * 16);
        const f32x4 s0 = sp[0], s1 = sp[1], s2 = sp[2], s3 = sp[3];
        const float tot = ((s0.x + s0.y) + (s0.z + s0.w)) + ((s1.x + s1.y) + (s1.z + s1.w)) + ((s2.x + s2.y) + (s2.z + s2.w)) + ((s3.x + s3.y) + (s3.z + s3.w));
        const float rstd = rsqrtf(tot * (1.0f / DM) + EPS);
        if (rot) {
            const bool isq = cg < 16; const float sc = isq ? rstd * C2 : rstd;
            bf16_t* dst = isq ? Q + (size_t)row * DM + cg * 64 : K + (size_t)row * KVW + (cg - 16) * 64;
#pragma unroll
            for (int nb = 0; nb < 2; ++nb) { const int i = 16 * nb + lr; const float2 cs = rope[pos * 32 + i];
                const float x1 = acc[nb][reg] * sc, x2 = acc[nb + 2][reg] * sc;
                dst[i] = (bf16_t)f2bf(x1 * cs.x - x2 * cs.y); dst[i + 32] = (bf16_t)f2bf(x2 * cs.x + x1 * cs.y); }
        } else {
            const bool isv = cg < 16 + 2 * KVH;
            bf16_t* dst = isv ? V + (size_t)row * KVW + (cg - 16 - KVH) * 64 : Z + (size_t)row * DM + (cg - 16 - 2 * KVH) * 64;
#pragma unroll
            for (int nb = 0; nb < 4; ++nb) dst[16 * nb + lr] = (bf16_t)f2bf(acc[nb][reg] * rstd);
        }
    }
}
__global__ void k_ksum_naive(const bf16_t* __restrict__ K, float* __restrict__ KS) {
    const int bb = blockIdx.x, c = threadIdx.x;
    float s = 0.f;
    for (int r = 0; r < MBLK; ++r) s += bf2f(K[((size_t)bb * MBLK + r) * 256 + c]);
    KS[((size_t)bb * 2 + 0) * 256 + c] = s; KS[((size_t)bb * 2 + 1) * 256 + c] = 0.f;
}

__global__ __launch_bounds__(256) void k_attn_swa_naive(const bf16_t* __restrict__ Q, const bf16_t* __restrict__ K, const bf16_t* __restrict__ V, const bf16_t* __restrict__ Z,
                                                        const float* __restrict__ sinks, bf16_t* __restrict__ G) {
    __shared__ float sh[4][64 + 128];
    const int w = threadIdx.x >> 6, lane = threadIdx.x & 63;
    const int gw = blockIdx.x * 4 + w, row = gw >> 4, h = gw & 15, t = row & (SEQ - 1), kvh = h >> 3;
    float* qs = sh[w]; float* ps = sh[w] + 64;
    qs[lane] = bf2f(Q[(size_t)row * DM + h * 64 + lane]);
    __syncthreads();
    float s[2];
#pragma unroll
    for (int r = 0; r < 2; ++r) { const int kk = lane + 64 * r; float a = -INFINITY;
        if (kk <= t) { const u32x4* kp = (const u32x4*)(K + (size_t)(row - kk) * 128 + kvh * 64); a = 0.f;
#pragma unroll
            for (int c = 0; c < 8; ++c) { const u32x4 v = kp[c];
                a += qs[8 * c + 0] * bf2f(v.x & 0xffff) + qs[8 * c + 1] * bf2f(v.x >> 16) + qs[8 * c + 2] * bf2f(v.y & 0xffff) + qs[8 * c + 3] * bf2f(v.y >> 16)
                   + qs[8 * c + 4] * bf2f(v.z & 0xffff) + qs[8 * c + 5] * bf2f(v.z >> 16) + qs[8 * c + 6] * bf2f(v.w & 0xffff) + qs[8 * c + 7] * bf2f(v.w >> 16); } }
        s[r] = a; }
    const float sinkl = sinks[h] * LOG2E;
    const float m = fmaxf(wave_max(fmaxf(s[0], s[1])), sinkl);
    const float p0 = exp2f(s[0] - m), p1 = exp2f(s[1] - m);
    const float l = wave_sum(p0 + p1) + exp2f(sinkl - m);
    ps[lane] = p0; ps[lane + 64] = p1;
    __syncthreads();
    const int nk = t + 1 < WINDOW ? t + 1 : WINDOW; float o = 0.f;
    for (int kk = 0; kk < nk; ++kk) o += ps[kk] * bf2f(V[(size_t)(row - kk) * 128 + kvh * 64 + lane]);
    o /= l;
    const float z = bf2f(Z[(size_t)row * DM + h * 64 + lane]);
    G[(size_t)row * DM + h * 64 + lane] = (bf16_t)f2bf(o * z / (1.f + __expf(-z)));
}
__global__ __launch_bounds__(256) void k_attn_moba_naive(const bf16_t* __restrict__ Q, const bf16_t* __restrict__ K, const bf16_t* __restrict__ V, const bf16_t* __restrict__ Z,
                                                         const float* __restrict__ KS, bf16_t* __restrict__ G) {
    __shared__ float sh[4][64 + 1024];
    const int w = threadIdx.x >> 6, lane = threadIdx.x & 63;
    const int gw = blockIdx.x * 4 + w, row = gw >> 4, h = gw & 15, t = row & (SEQ - 1), b = row >> 12, kvh = h >> 2, qblk = t >> 8;
    float* qs = sh[w]; float* ps = sh[w] + 64;
    qs[lane] = bf2f(Q[(size_t)row * DM + h * 64 + lane]);
    __syncthreads();
    float gate = -INFINITY;
    if (lane < qblk) { const float* k0 = KS + ((size_t)(b * NBLK + lane) * 2) * 256 + kvh * 64; const float* k1 = k0 + 256; float a = 0.f;
        for (int d = 0; d < 64; ++d) a += qs[d] * ((k0[d] + k1[d]) * (1.0f / MBLK));
        gate = a; }
    unsigned chosen = 0; const int nsel = qblk < 3 ? qblk : 3;
    for (int si = 0; si < nsel; ++si) { float best = -INFINITY; int bi = -1;
        for (int j = 0; j < qblk; ++j) { const float gj = __shfl(gate, j); if (!((chosen >> j) & 1u) && (bi < 0 || gj > best)) { best = gj; bi = j; } }
        chosen |= 1u << bi; }
    chosen |= 1u << qblk;
    float mx = -INFINITY; int nslot = 0; int blks[4] = {0, 0, 0, 0};
    for (int j = 0; j <= qblk; ++j) { if (!((chosen >> j) & 1u)) continue;
        if (nslot == 0) blks[0] = j; else if (nslot == 1) blks[1] = j; else if (nslot == 2) blks[2] = j; else blks[3] = j;
#pragma unroll
        for (int r = 0; r < 4; ++r) { const int key = j * 256 + r * 64 + lane; float a = -INFINITY;
            if (key <= t) { const u32x4* kp = (const u32x4*)(K + ((size_t)b * SEQ + key) * 256 + kvh * 64); a = 0.f;
#pragma unroll
                for (int c = 0; c < 8; ++c) { const u32x4 v = kp[c];
                    a += qs[8 * c + 0] * bf2f(v.x & 0xffff) + qs[8 * c + 1] * bf2f(v.x >> 16) + qs[8 * c + 2] * bf2f(v.y & 0xffff) + qs[8 * c + 3] * bf2f(v.y >> 16)
                       + qs[8 * c + 4] * bf2f(v.z & 0xffff) + qs[8 * c + 5] * bf2f(v.z >> 16) + qs[8 * c + 6] * bf2f(v.w & 0xffff) + qs[8 * c + 7] * bf2f(v.w >> 16); } }
            ps[nslot * 256 + r * 64 + lane] = a; mx = fmaxf(mx, a); }
        ++nslot; }
    mx = wave_max(mx);
    float l = 0.f;
    for (int i = lane; i < nslot * 256; i += 64) { const float p = exp2f(ps[i] - mx); ps[i] = p; l += p; }
    l = wave_sum(l);
    __syncthreads();
    float o = 0.f;
    for (int sl = 0; sl < nslot; ++sl) { const int j = sl == 0 ? blks[0] : sl == 1 ? blks[1] : sl == 2 ? blks[2] : blks[3];
        const bf16_t* vp = V + ((size_t)b * SEQ + j * 256) * 256 + kvh * 64 + lane; const float* pp = ps + sl * 256;
        const int nk = (j == qblk) ? (t - j * 256 + 1) : 256;
        for (int kk = 0; kk < nk; ++kk) o += pp[kk] * bf2f(vp[(size_t)kk * 256]); }
    o /= l;
    const float z = bf2f(Z[(size_t)row * DM + h * 64 + lane]);
    G[(size_t)row * DM + h * 64 + lane] = (bf16_t)f2bf(o * z / (1.f + __expf(-z)));
}

__global__ __launch_bounds__(256) void k_gemm2_naive(const bf16_t* __restrict__ Gb, const bf16_t* __restrict__ W2t, const float* hold, float* H, bf16_t* __restrict__ Hb, float* __restrict__ ss) {
    const int wave = (int)(((size_t)blockIdx.x * 256 + threadIdx.x) >> 6), lane = threadIdx.x & 63;
    const int rt = wave >> 4, cg = wave & 15; if (rt >= M / 16) return;
    const int row0 = rt * 16, lr = lane & 15, lq = lane >> 4;
    f32x4 acc[4];
#pragma unroll
    for (int nb = 0; nb < 4; ++nb) acc[nb] = (f32x4){0.f, 0.f, 0.f, 0.f};
    const bf16_t* ap = Gb + (size_t)(row0 + lr) * DM + 8 * lq;
    const bf16_t* bp = W2t + (size_t)(cg * 64 + lr) * DM + 8 * lq;
    for (int k0 = 0; k0 < DM; k0 += 32) {
        const bf16x8 a = *(const bf16x8*)(ap + k0);
#pragma unroll
        for (int nb = 0; nb < 4; ++nb) { const bf16x8 b = *(const bf16x8*)(bp + (size_t)nb * 16 * DM + k0); acc[nb] = __builtin_amdgcn_mfma_f32_16x16x32_bf16(a, b, acc[nb], 0, 0, 0); }
    }
#pragma unroll
    for (int reg = 0; reg < 4; ++reg) {
        const int row = row0 + 4 * lq + reg; float s = 0.f;
#pragma unroll
        for (int nb = 0; nb < 4; ++nb) { const size_t off = (size_t)row * DM + cg * 64 + 16 * nb + lr; const float hn = hold[off] + acc[nb][reg]; H[off] = hn; Hb[off] = (bf16_t)f2bf(hn); s += hn * hn; }
        s += __shfl_xor(s, 1); s += __shfl_xor(s, 2); s += __shfl_xor(s, 4); s += __shfl_xor(s, 8);
        if (lr == 0) ss[(size_t)row * 16 + cg] = s;
    }
}
__global__ void k_final(float* H, const float* __restrict__ fg) {
    const int row = (blockIdx.x * blockDim.x + threadIdx.x) >> 6, lane = threadIdx.x & 63; if (row >= M) return;
    f32x4* hr = (f32x4*)(H + (size_t)row * DM) + lane; const f32x4* gr = (const f32x4*)fg + lane;
    f32x4 v[4]; float s = 0.f;
#pragma unroll
    for (int j = 0; j < 4; ++j) { v[j] = hr[64 * j]; s += (v[j].x * v[j].x + v[j].y * v[j].y) + (v[j].z * v[j].z + v[j].w * v[j].w); }
    const float rstd = rsqrtf(wave_sum(s) * (1.0f / DM) + EPS);
#pragma unroll
    for (int j = 0; j < 4; ++j) hr[64 * j] = v[j] * rstd * gr[64 * j];
}


namespace pg8 {
#define PG8_LAS __attribute__((address_space(3)))
typedef unsigned short bf16_t;
typedef short bf16x8 __attribute__((ext_vector_type(8)));
typedef float f32x4 __attribute__((ext_vector_type(4)));
typedef unsigned u32x4 __attribute__((ext_vector_type(4)));
constexpr int BM = 256, BK = 64, HALF = 128, HTB = HALF * BK * 2  , STAGE_BYTES = 8 * HTB, NXCD = 8, WGM = 8;

__host__ __device__ __forceinline__ int lds_byte(int r, int c) { const int st = (r >> 4) * 2 + (c >> 5), rr = r & 15, cc = c & 31, ob = rr * 64 + cc * 2; return st * 1024 + (ob ^ (((ob >> 9) & 1) << 5)); }
__host__ __device__ __forceinline__ void stage_rc(int b, int& R, int& C) { const int st = b / 1024, sb = b % 1024, swz = sb ^ (((sb >> 9) & 1) << 5); R = (st >> 1) * 16 + swz / 64; C = (st & 1) * 32 + (swz % 64) / 2; }
__host__ __device__ __forceinline__ int perm32(int rho) { const int n = rho >> 4, i = rho & 15; return 8 * (i >> 2) + 4 * n + (i & 3); }

struct Unit { int pm, pn; };
struct Gemm { const bf16_t* A; const bf16_t* Bt; int M, N, K; };

struct StaticOrder {
    int nM, nN, nwg, G, c;
    __host__ __device__ void init(int M, int N, int G_, int c_) { nM = M / BM; nN = N / BM; nwg = nM * nN; G = G_; c = c_; }
    __host__ __device__ bool next(int i, Unit& u) const {
        const long L = (long)i * G + c; if (L >= nwg) return false;
        int wgid = (int)L; { const int q = nwg / NXCD, r = nwg % NXCD, xcd = wgid % NXCD, off = wgid / NXCD; wgid = (xcd < r ? xcd * (q + 1) : r * (q + 1) + (xcd - r) * q) + off; }
        const int nig = WGM * nN, gid = wgid / nig, fm = gid * WGM, gsz = (nM - fm) < WGM ? (nM - fm) : WGM;
        u.pm = fm + ((wgid % nig) % gsz); u.pn = (wgid % nig) / gsz; return true;
    }
    __device__ __forceinline__ void a_ready(const Unit&) const {}
    __device__ __forceinline__ void done(const Unit&) const {}
};

__device__ __forceinline__ unsigned cvt_pk_bf16(float lo, float hi) { unsigned r; asm volatile("v_cvt_pk_bf16_f32 %0, %1, %2" : "=v"(r) : "v"(lo), "v"(hi)); return r; }
typedef unsigned u32x2 __attribute__((ext_vector_type(2)));

template <int KVH> struct EpiG1 {
    static constexpr bool PERM = true, AFTER_DRAIN = false;
    bf16_t *Q, *K, *V, *Z; const float* ss; const float* rope; float* KS;
    __device__ __forceinline__ float rstd_of(int row) const {
        const f32x4* sp = (const f32x4*)(ss + (size_t)row * 16);
        const f32x4 s0 = sp[0], s1 = sp[1], s2 = sp[2], s3 = sp[3];
        const float tot = ((s0[0] + s0[1]) + (s0[2] + s0[3])) + ((s1[0] + s1[1]) + (s1[2] + s1[3])) + ((s2[0] + s2[1]) + (s2[2] + s2[3])) + ((s3[0] + s3[1]) + (s3[2] + s3[3]));
        return __builtin_amdgcn_rsqf(tot * (1.0f / 1024.0f) + 1e-5f);
    }
    __device__ __forceinline__ void operator()(const f32x4 (&acc)[2][2][4][2], const Unit& u, int wr, int wc, int fr, int fq) const {
        constexpr int KVW = KVH * 64; constexpr float C2 = 0.125f * 1.4426950408889634f;
        const int pn = u.pn, wcl = wc & 1, hp = wc >> 1;
        const int row0 = u.pm * BM + wr * 64 + fr;
        if (pn < 4 || (pn == 4 && KVH == 4)) {
            const bool isq = pn < 4;
            f32x4 ks[2][2];
#pragma unroll
            for (int bj = 0; bj < 2; ++bj) { ks[bj][0] = (f32x4){0.f, 0.f, 0.f, 0.f}; ks[bj][1] = (f32x4){0.f, 0.f, 0.f, 0.f}; }
#pragma unroll
            for (int ai = 0; ai < 2; ++ai)
#pragma unroll
                for (int m = 0; m < 4; ++m) {
                    const int row = row0 + ai * HALF + m * 16, pos = row & 4095;
                    const float rs = rstd_of(row), sc = isq ? rs * C2 : rs;
                    const f32x4* rp = (const f32x4*)(rope + ((size_t)pos * 32 + 16 * wcl + 4 * fq) * 2);
                    const f32x4 t0 = rp[0], t1 = rp[1];
                    const f32x4 cc = (f32x4){t0[0], t0[2], t1[0], t1[2]}, sn = (f32x4){t0[1], t0[3], t1[1], t1[3]};
#pragma unroll
                    for (int bj = 0; bj < 2; ++bj) {
                        const f32x4 x1 = acc[ai][bj][m][0] * sc, x2 = acc[ai][bj][m][1] * sc;
                        const f32x4 o1 = x1 * cc - x2 * sn, o2 = x2 * cc + x1 * sn;
                        bf16_t* dst = isq ? Q + (size_t)row * 1024 + (4 * pn + 2 * bj + hp) * 64 + 16 * wcl + 4 * fq : K + (size_t)row * KVW + (2 * bj + hp) * 64 + 16 * wcl + 4 * fq;
                        u32x2 w1, w2; w1.x = cvt_pk_bf16(o1[0], o1[1]); w1.y = cvt_pk_bf16(o1[2], o1[3]); w2.x = cvt_pk_bf16(o2[0], o2[1]); w2.y = cvt_pk_bf16(o2[2], o2[3]);
                        *(u32x2*)dst = w1; *(u32x2*)(dst + 32) = w2;
                        if (!isq) { ks[bj][0] += o1; ks[bj][1] += o2; }
                    }
                }
            if (!isq) {
#pragma unroll
                for (int bj = 0; bj < 2; ++bj)
#pragma unroll
                    for (int n = 0; n < 2; ++n) {
                        f32x4 v = ks[bj][n];
#pragma unroll
                        for (int j = 0; j < 4; ++j) { float s = v[j]; s += __shfl_xor(s, 1); s += __shfl_xor(s, 2); s += __shfl_xor(s, 4); s += __shfl_xor(s, 8); v[j] = s; }
                        if (fr == 0) *(f32x4*)(KS + ((size_t)(u.pm * 2 + wr)) * 256 + (2 * bj + hp) * 64 + 32 * n + 16 * wcl + 4 * fq) = v;
                    }
            }
        } else if (pn == 4) {
#pragma unroll
            for (int ai = 0; ai < 2; ++ai)
#pragma unroll
                for (int m = 0; m < 4; ++m) {
                    const int row = row0 + ai * HALF + m * 16, pos = row & 4095;
                    const float rs = rstd_of(row);
                    const f32x4* rp = (const f32x4*)(rope + ((size_t)pos * 32 + 16 * wcl + 4 * fq) * 2);
                    const f32x4 t0 = rp[0], t1 = rp[1];
                    const f32x4 cc = (f32x4){t0[0], t0[2], t1[0], t1[2]}, sn = (f32x4){t0[1], t0[3], t1[1], t1[3]};
                    { const f32x4 x1 = acc[ai][0][m][0] * rs, x2 = acc[ai][0][m][1] * rs;
                      const f32x4 o1 = x1 * cc - x2 * sn, o2 = x2 * cc + x1 * sn;
                      bf16_t* dst = K + (size_t)row * KVW + hp * 64 + 16 * wcl + 4 * fq;
                      u32x2 w1, w2; w1.x = cvt_pk_bf16(o1[0], o1[1]); w1.y = cvt_pk_bf16(o1[2], o1[3]); w2.x = cvt_pk_bf16(o2[0], o2[1]); w2.y = cvt_pk_bf16(o2[2], o2[3]);
                      *(u32x2*)dst = w1; *(u32x2*)(dst + 32) = w2; }
                    { const f32x4 v0 = acc[ai][1][m][0] * rs, v1 = acc[ai][1][m][1] * rs;
                      u32x4 w; w.x = cvt_pk_bf16(v0[0], v0[1]); w.y = cvt_pk_bf16(v0[2], v0[3]); w.z = cvt_pk_bf16(v1[0], v1[1]); w.w = cvt_pk_bf16(v1[2], v1[3]);
                      *(u32x4*)(V + (size_t)row * KVW + 32 * wc + 8 * fq) = w; }
                }
        } else {
            const bool isv = (KVH == 4 && pn == 5);
            const int zt = pn - (KVH == 4 ? 6 : 5);
#pragma unroll
            for (int ai = 0; ai < 2; ++ai)
#pragma unroll
                for (int m = 0; m < 4; ++m) {
                    const int row = row0 + ai * HALF + m * 16;
                    const float rs = rstd_of(row);
                    bf16_t* dst = isv ? V + (size_t)row * KVW + 32 * wc + 8 * fq : Z + (size_t)row * 1024 + zt * 256 + 32 * wc + 8 * fq;
#pragma unroll
                    for (int bj = 0; bj < 2; ++bj) {
                        const f32x4 v0 = acc[ai][bj][m][0] * rs, v1 = acc[ai][bj][m][1] * rs;
                        u32x4 w; w.x = cvt_pk_bf16(v0[0], v0[1]); w.y = cvt_pk_bf16(v0[2], v0[3]); w.z = cvt_pk_bf16(v1[0], v1[1]); w.w = cvt_pk_bf16(v1[2], v1[3]);
                        *(u32x4*)(dst + bj * HALF) = w;
                    }
                }
        }
    }
};
template <bool IN_F32, bool OUT_F32> struct EpiG2 {
    static constexpr bool PERM = true, AFTER_DRAIN = false;
    const float* xin; float* H; bf16_t* Hb; float* ss;
    __device__ __forceinline__ void operator()(const f32x4 (&acc)[2][2][4][2], const Unit& u, int wr, int wc, int fr, int fq) const {
        const int row0 = u.pm * BM + wr * 64 + fr, col0 = u.pn * BM + 32 * wc + 8 * fq;
#pragma unroll
        for (int ai = 0; ai < 2; ++ai) {
            f32x4 r0[4][2], r1[4][2]; u32x4 rb[4][2];
#pragma unroll
            for (int m = 0; m < 4; ++m)
#pragma unroll
                for (int bj = 0; bj < 2; ++bj) { const size_t off = (size_t)(row0 + ai * HALF + m * 16) * 1024 + col0 + bj * HALF;
                    if (IN_F32) { r0[m][bj] = *(const f32x4*)(xin + off); r1[m][bj] = *(const f32x4*)(xin + off + 4); } else rb[m][bj] = *(const u32x4*)(Hb + off); }
#pragma unroll
            for (int m = 0; m < 4; ++m) {
                const int row = row0 + ai * HALF + m * 16; float s = 0.f;
#pragma unroll
                for (int bj = 0; bj < 2; ++bj) {
                    const size_t off = (size_t)row * 1024 + col0 + bj * HALF;
                    f32x4 h0, h1;
                    if (IN_F32) { h0 = r0[m][bj]; h1 = r1[m][bj]; }
                    else { const u32x4 w = rb[m][bj]; h0 = (f32x4){__uint_as_float(w.x << 16), __uint_as_float(w.x & 0xffff0000u), __uint_as_float(w.y << 16), __uint_as_float(w.y & 0xffff0000u)};
                           h1 = (f32x4){__uint_as_float(w.z << 16), __uint_as_float(w.z & 0xffff0000u), __uint_as_float(w.w << 16), __uint_as_float(w.w & 0xffff0000u)}; }
                    const f32x4 v0 = h0 + acc[ai][bj][m][0], v1 = h1 + acc[ai][bj][m][1];
                    s += ((v0[0] * v0[0] + v0[1] * v0[1]) + (v0[2] * v0[2] + v0[3] * v0[3])) + ((v1[0] * v1[0] + v1[1] * v1[1]) + (v1[2] * v1[2] + v1[3] * v1[3]));
                    if (OUT_F32) { *(f32x4*)(H + off) = v0; *(f32x4*)(H + off + 4) = v1; }
                    else { u32x4 w; w.x = cvt_pk_bf16(v0[0], v0[1]); w.y = cvt_pk_bf16(v0[2], v0[3]); w.z = cvt_pk_bf16(v1[0], v1[1]); w.w = cvt_pk_bf16(v1[2], v1[3]); *(u32x4*)(Hb + off) = w; }
                }
                s += __shfl_xor(s, 16); s += __shfl_xor(s, 32);
                if (fq == 0) ss[(size_t)row * 16 + 4 * u.pn + wc] = s;
            }
        }
    }
};
template <class Epi, class Sched, bool ALIGN_EPI = false, bool SP2 = false>
__device__ __forceinline__ void gemm_phase(PG8_LAS unsigned char* lds, const Gemm g, const Sched& S, const Epi& E) {
    int tid_ = threadIdx.x; asm volatile("" : "+v"(tid_));
    const int tid = tid_, wid = __builtin_amdgcn_readfirstlane(tid >> 6), lane = tid & 63, wr = wid >> 2, wc = wid & 3, fr = lane & 15, fq = lane >> 4;
    const int K = g.K, nt = K / BK;
    unsigned voffA[2], voffB[2];
#pragma unroll
    for (int i = 0; i < 2; ++i) { int R, C; stage_rc(tid * 16 + i * 8192, R, C); const int Rb = Epi::PERM ? ((R & ~31) + perm32(R & 31)) : R;
        voffA[i] = (unsigned)(R * K + C) * 2u; voffB[i] = (unsigned)(Rb * K + C) * 2u; }
    const size_t kstep = (size_t)(BK * 2);
    const size_t hstep = (size_t)HALF * K * 2;
    const size_t tstep = 2 * hstep;
    const unsigned ldsw = (unsigned)wid * 1024u;
    const int aoff = lds_byte(wr * 64 + fr, fq * 8), boff = lds_byte(wc * 32 + fr, fq * 8);
#define PG8_SA(b, h) (((b) * 2 + (h)) * HTB)
#define PG8_SB(b, h) ((4 + (b) * 2 + (h)) * HTB)
#define PG8_STAGE(bufoff, gbase, voff) do { _Pragma("unroll") for (int _i = 0; _i < 2; ++_i) \
        __builtin_amdgcn_global_load_lds((const unsigned*)((const char*)(gbase) + (voff)[_i]), (PG8_LAS unsigned*)(lds + (bufoff) + ldsw + _i * 8192), 16, 0, 0); } while (0)
#define PG8_LDA(dst, b, h) do { _Pragma("unroll") for (int m = 0; m < 4; ++m) _Pragma("unroll") for (int k = 0; k < 2; ++k) dst[m][k] = *(const PG8_LAS bf16x8*)(lds + PG8_SA(b, h) + aoff + m * 2048 + k * 1024); } while (0)
#define PG8_LDB(dst, b, h) do { _Pragma("unroll") for (int n = 0; n < 2; ++n) _Pragma("unroll") for (int k = 0; k < 2; ++k) dst[n][k] = *(const PG8_LAS bf16x8*)(lds + PG8_SB(b, h) + boff + n * 2048 + k * 1024); } while (0)
#define PG8_MMA(ai, bj, At, Bt) do { __builtin_amdgcn_s_setprio(1); _Pragma("unroll") for (int m = 0; m < 4; ++m) _Pragma("unroll") for (int n = 0; n < 2; ++n) _Pragma("unroll") for (int k = 0; k < 2; ++k) \
        acc[ai][bj][m][n] = __builtin_amdgcn_mfma_f32_16x16x32_bf16(Bt[n][k], At[m][k], acc[ai][bj][m][n], 0, 0, 0); __builtin_amdgcn_s_setprio(0); } while (0)
#define PG8_WAIT_V(n) asm volatile("s_waitcnt vmcnt(" #n ")" ::: "memory")
#define PG8_WAIT_L(n) asm volatile("s_waitcnt lgkmcnt(" #n ")" ::: "memory")
#define PG8_BAR __builtin_amdgcn_s_barrier()
#define PG8_SCHED __builtin_amdgcn_sched_barrier(0)
    Unit cur, nxt; int ui = 0;
    if (!S.next(0, cur)) return;
    f32x4 acc[2][2][4][2];
#pragma unroll
    for (int a = 0; a < 2; ++a)
#pragma unroll
        for (int b = 0; b < 2; ++b)
#pragma unroll
            for (int m = 0; m < 4; ++m)
#pragma unroll
                for (int n = 0; n < 2; ++n) acc[a][b][m][n] = (f32x4){0.f, 0.f, 0.f, 0.f};
    bf16x8 At[4][2], B0[2][2], B1[2][2];
    const char* cA = (const char*)g.A + (size_t)cur.pm * tstep; const char* cB = (const char*)g.Bt + (size_t)cur.pn * tstep;
    S.a_ready(cur);
    if constexpr (SP2) {
        PG8_STAGE(PG8_SB(0, 0), cB, voffB); PG8_STAGE(PG8_SB(0, 1), cB + hstep, voffB); PG8_STAGE(PG8_SA(0, 0), cA, voffA); PG8_STAGE(PG8_SA(0, 1), cA + hstep, voffA);
        if (wr == 1) PG8_BAR;
        PG8_WAIT_V(2); PG8_BAR;
        PG8_STAGE(PG8_SB(1, 0), cB + kstep, voffB); PG8_STAGE(PG8_SA(1, 0), cA + kstep, voffA); PG8_STAGE(PG8_SB(1, 1), cB + hstep + kstep, voffB);
        PG8_WAIT_V(6); PG8_BAR;
    } else {
        PG8_STAGE(PG8_SB(0, 0), cB, voffB); PG8_STAGE(PG8_SA(0, 0), cA, voffA); PG8_STAGE(PG8_SB(0, 1), cB + hstep, voffB); PG8_STAGE(PG8_SA(0, 1), cA + hstep, voffA);
        if (wr == 1) PG8_BAR;
        PG8_WAIT_V(4); PG8_BAR;
        PG8_STAGE(PG8_SB(1, 0), cB + kstep, voffB); PG8_STAGE(PG8_SA(1, 0), cA + kstep, voffA); PG8_STAGE(PG8_SB(1, 1), cB + hstep + kstep, voffB);
        PG8_WAIT_V(6); PG8_BAR;
    }
    for (;;) {
        const bool has_next = S.next(ui + 1, nxt);
        const char* nA = has_next ? (const char*)g.A + (size_t)nxt.pm * tstep : cA; const char* nB = has_next ? (const char*)g.Bt + (size_t)nxt.pn * tstep : cB;
        for (int t = 0; t < nt; t += 2) {
            const bool last = (t == nt - 2);
            const char* a1 = cA + (size_t)(t + 1) * kstep;
            const char* a2 = last ? nA : cA + (size_t)(t + 2) * kstep; const char* b2 = last ? nB : cB + (size_t)(t + 2) * kstep;
            const char* a3 = a2 + kstep; const char* b3 = b2 + kstep;
            if (last && has_next) S.a_ready(nxt);
            if constexpr (SP2) {
            PG8_LDB(B0, 0, 0); PG8_LDB(B1, 0, 1); PG8_SCHED; PG8_LDA(At, 0, 0); PG8_STAGE(PG8_SA(1, 1), a1 + hstep, voffA);
            PG8_WAIT_V(8); PG8_WAIT_L(0); PG8_BAR; PG8_MMA(0, 0, At, B0); PG8_MMA(0, 1, At, B1); PG8_BAR; PG8_SCHED;
            PG8_LDA(At, 0, 1); PG8_STAGE(PG8_SB(0, 0), b2, voffB); PG8_STAGE(PG8_SB(0, 1), b2 + hstep, voffB); PG8_STAGE(PG8_SA(0, 0), a2, voffA);
            PG8_WAIT_V(8); PG8_WAIT_L(0); PG8_BAR; PG8_MMA(1, 0, At, B0); PG8_MMA(1, 1, At, B1); PG8_BAR; PG8_SCHED;
            PG8_LDB(B0, 1, 0); PG8_LDB(B1, 1, 1); PG8_SCHED; PG8_LDA(At, 1, 0); PG8_STAGE(PG8_SA(0, 1), a2 + hstep, voffA);
            PG8_WAIT_V(8); PG8_WAIT_L(0); PG8_BAR; PG8_MMA(0, 0, At, B0); PG8_MMA(0, 1, At, B1); PG8_BAR; PG8_SCHED;
            PG8_LDA(At, 1, 1); PG8_STAGE(PG8_SB(1, 0), b3, voffB); PG8_STAGE(PG8_SB(1, 1), b3 + hstep, voffB); PG8_STAGE(PG8_SA(1, 0), a3, voffA);
            PG8_WAIT_V(8); PG8_WAIT_L(0); PG8_BAR; PG8_MMA(1, 0, At, B0); PG8_MMA(1, 1, At, B1); PG8_BAR; PG8_SCHED;
            } else {
            PG8_LDB(B0, 0, 0); PG8_SCHED; PG8_LDA(At, 0, 0); PG8_STAGE(PG8_SA(1, 1), a1 + hstep, voffA);
            PG8_WAIT_L(8); PG8_BAR; PG8_WAIT_L(0); PG8_MMA(0, 0, At, B0); PG8_BAR; PG8_SCHED;
            PG8_LDB(B1, 0, 1); PG8_STAGE(PG8_SB(0, 0), b2, voffB);
            PG8_BAR; PG8_WAIT_L(0); PG8_MMA(0, 1, At, B1); PG8_BAR;
            PG8_LDA(At, 0, 1); PG8_STAGE(PG8_SA(0, 0), a2, voffA);
            PG8_BAR; PG8_WAIT_L(0); PG8_MMA(1, 0, At, B0); PG8_BAR; PG8_SCHED;
            PG8_STAGE(PG8_SB(0, 1), b2 + hstep, voffB);
            PG8_WAIT_V(6); PG8_BAR; PG8_MMA(1, 1, At, B1); PG8_BAR;
            PG8_LDB(B0, 1, 0); PG8_SCHED; PG8_LDA(At, 1, 0); PG8_STAGE(PG8_SA(0, 1), a2 + hstep, voffA);
            PG8_WAIT_L(8); PG8_BAR; PG8_WAIT_L(0); PG8_MMA(0, 0, At, B0); PG8_BAR; PG8_SCHED;
            PG8_LDB(B1, 1, 1); PG8_STAGE(PG8_SB(1, 0), b3, voffB);
            PG8_BAR; PG8_WAIT_L(0); PG8_MMA(0, 1, At, B1); PG8_BAR;
            PG8_LDA(At, 1, 1); PG8_STAGE(PG8_SA(1, 0), a3, voffA);
            PG8_BAR; PG8_WAIT_L(0); PG8_MMA(1, 0, At, B0); PG8_BAR; PG8_SCHED;
            PG8_STAGE(PG8_SB(1, 1), b3 + hstep, voffB);
            PG8_WAIT_V(6); PG8_BAR; PG8_MMA(1, 1, At, B1); PG8_BAR;
            }
        }
        if constexpr (ALIGN_EPI) { if (wr == 0) PG8_BAR; }
        if constexpr (!Epi::AFTER_DRAIN) { E(acc, cur, wr, wc, fr, fq); S.done(cur); }
        if (!has_next) break;
#pragma unroll
        for (int a = 0; a < 2; ++a)
#pragma unroll
            for (int b = 0; b < 2; ++b)
#pragma unroll
                for (int m = 0; m < 4; ++m)
#pragma unroll
                    for (int n = 0; n < 2; ++n) acc[a][b][m][n] = (f32x4){0.f, 0.f, 0.f, 0.f};
        cur = nxt; cA = nA; cB = nB; ++ui;
        if constexpr (ALIGN_EPI) { if (wr == 1) PG8_BAR; }
    }
    PG8_WAIT_V(0);
    if constexpr (!ALIGN_EPI) { if (wr == 0) PG8_BAR; }
    PG8_BAR;
    if constexpr (Epi::AFTER_DRAIN) { E.fused(acc, cur, wr, wc, fr, fq, lds, wid, lane); S.done(cur); }
#undef PG8_SA
#undef PG8_SB
#undef PG8_STAGE
#undef PG8_LDA
#undef PG8_LDB
#undef PG8_MMA
#undef PG8_WAIT_V
#undef PG8_WAIT_L
#undef PG8_BAR
#undef PG8_SCHED
}
}

namespace attn_body {
using bf16=unsigned short;
using bf16x8=__attribute__((ext_vector_type(8)))short;
using s16x4=__attribute__((ext_vector_type(4)))short;
using f32x16=__attribute__((ext_vector_type(16)))float;
using u32x4=__attribute__((ext_vector_type(4)))unsigned;
constexpr int ASEQ=4096,D=64,ADM=1024;
constexpr int NW=8,QBLK=32,QB=QBLK*NW,KVBLK=64;
__device__ __forceinline__ int crow(int r,int hi){return (r&3)+8*(r>>2)+4*hi;}
#define SBAR() __builtin_amdgcn_sched_barrier(0)
__device__ __forceinline__ void cmask(f32x16&p0,f32x16&p1,int jb,int qrel,int hi){
  const float NEG=-INFINITY; int kb=qrel-(64*jb+4*hi); asm volatile("":"+v"(kb));
  #pragma unroll
  for(int r=0;r<16;++r){const int c=(r&3)+8*(r>>2); if(c>kb)p0[r]=NEG; if(c+32>kb)p1[r]=NEG;}
}
__device__ __forceinline__ void wmask(f32x16&p0,f32x16&p1,int delta,int hi){
  const float NEG=-INFINITY; int d0=delta-4*hi; asm volatile("":"+v"(d0));
  #pragma unroll
  for(int r=0;r<16;++r){const int dd=d0-((r&3)+8*(r>>2)); if((unsigned)dd>=128u)p0[r]=NEG; if((unsigned)(dd-32)>=128u)p1[r]=NEG;}
}

constexpr int NSLOT=3, SLOTB=8192;
constexpr int LDS_K=0, LDS_V=NSLOT*SLOTB, LDS_WS=2*NSLOT*SLOTB, LDS_OST=LDS_WS+NW*64*4, LDS_KM=LDS_OST+NW*8192, LDS_BYTES=LDS_KM+4096;
__device__ __forceinline__ void glds16(const void*sbase,unsigned voff,unsigned lds_dst){unsigned keep;
  asm volatile("s_nop 4\n\ts_mov_b32 %0, m0\n\ts_mov_b32 m0, %2\n\ts_nop 0\n\tglobal_load_lds_dwordx4 %1, %3\n\ts_mov_b32 m0, %0":"=&s"(keep):"v"(voff),"s"(lds_dst),"s"(sbase):"memory");}
__device__ __forceinline__ float max3f(float a,float b,float c){float r;asm("v_max3_f32 %0, %1, %2, %3":"=v"(r):"v"(a),"v"(b),"v"(c));return r;}
__device__ __forceinline__ float max2f(float a,float b){float r;asm("v_max_f32_e32 %0, %1, %2":"=v"(r):"v"(a),"v"(b));return r;}
__device__ __forceinline__ float fadd_s(float a,float b){float r;asm("v_add_f32_e32 %0, %1, %2":"=v"(r):"v"(a),"v"(b));return r;}
__device__ __forceinline__ float fsub_s(float a,float b){float r;asm("v_sub_f32_e32 %0, %1, %2":"=v"(r):"v"(a),"v"(b));return r;}
typedef float f32x2_t __attribute__((ext_vector_type(2))); typedef __bf16 bf16x2_t __attribute__((ext_vector_type(2)));
__device__ __forceinline__ unsigned cvtpk_s(float lo,float hi){f32x2_t v={lo,hi};bf16x2_t b=__builtin_convertvector(v,bf16x2_t);return __builtin_bit_cast(unsigned,b);}
#define WAIT_BAR(N) asm volatile("s_waitcnt vmcnt(" #N ") lgkmcnt(0)\n\ts_barrier":::"memory")

__device__ __forceinline__ void qkt(f32x16&p0,f32x16&p1,const char*Kslot,const bf16x8*qr,const f32x16&negm,int r32,int hi){
  const char*kb=Kslot+hi*1024+r32*16;
  #pragma unroll
  for(int d0=0;d0<4;++d0){
    const bf16x8 b0=*reinterpret_cast<const bf16x8*>(kb+d0*2048);
    const bf16x8 b1=*reinterpret_cast<const bf16x8*>(kb+d0*2048+512);
    if(d0==0){p0=__builtin_amdgcn_mfma_f32_32x32x16_bf16(b0,qr[0],negm,0,0,0);p1=__builtin_amdgcn_mfma_f32_32x32x16_bf16(b1,qr[0],negm,0,0,0);}
    else{p0=__builtin_amdgcn_mfma_f32_32x32x16_bf16(b0,qr[d0],p0,0,0,0);p1=__builtin_amdgcn_mfma_f32_32x32x16_bf16(b1,qr[d0],p1,0,0,0);}}
}
typedef __attribute__((address_space(3))) const char* lds_cptr;
typedef short v4i16_t __attribute__((ext_vector_type(4)));
__device__ __forceinline__ void kload8(bf16x8*kf,lds_cptr kp){
  kf[0]=*(const __attribute__((address_space(3))) bf16x8*)(kp);      kf[1]=*(const __attribute__((address_space(3))) bf16x8*)(kp+512);
  kf[2]=*(const __attribute__((address_space(3))) bf16x8*)(kp+2048); kf[3]=*(const __attribute__((address_space(3))) bf16x8*)(kp+2560);
  kf[4]=*(const __attribute__((address_space(3))) bf16x8*)(kp+4096); kf[5]=*(const __attribute__((address_space(3))) bf16x8*)(kp+4608);
  kf[6]=*(const __attribute__((address_space(3))) bf16x8*)(kp+6144); kf[7]=*(const __attribute__((address_space(3))) bf16x8*)(kp+6656);
}
__device__ __forceinline__ void kload2(bf16x8*kf,lds_cptr kp,int j){ kf[2*j]=*(const __attribute__((address_space(3))) bf16x8*)(kp+j*2048); kf[2*j+1]=*(const __attribute__((address_space(3))) bf16x8*)(kp+j*2048+512); }
__device__ __forceinline__ s16x4 vtr(lds_cptr p){ return __builtin_bit_cast(s16x4,__builtin_amdgcn_ds_read_tr16_b64_v4i16((__attribute__((address_space(3))) v4i16_t*)p)); }
__device__ __forceinline__ float rowmax(const f32x16&p0,const f32x16&p1){
  float a=max3f(p0[0],p0[1],p1[0]),b=max3f(p0[2],p0[3],p1[1]);a=max3f(a,p1[2],p1[3]);
  #pragma unroll
  for(int r=4;r<16;r+=4){a=max3f(a,p0[r],p0[r+1]);b=max3f(b,p0[r+2],p0[r+3]);a=max3f(a,p1[r],p1[r+1]);b=max3f(b,p1[r+2],p1[r+3]);}
  const float m=max2f(a,b);
  auto rr=__builtin_amdgcn_permlane32_swap(__float_as_uint(m),__float_as_uint(m),false,false);
  return max2f(__uint_as_float(rr[0]),__uint_as_float(rr[1]));
}
__device__ __forceinline__ void pv(f32x16*o,int vb,bf16x8 pa0,bf16x8 pa1,bf16x8 pa2,bf16x8 pa3){
  #pragma unroll
  for(int d0=0;d0<2;++d0){s16x4 lo[4],hi[4];
    #pragma unroll
    for(int ks=0;ks<4;++ks){
      asm volatile("ds_read_b64_tr_b16 %0,%1 offset:%c2":"=&v"(lo[ks]):"v"(vb),"i"(d0*4096+ks*1024):"memory");
      asm volatile("ds_read_b64_tr_b16 %0,%1 offset:%c2":"=&v"(hi[ks]):"v"(vb),"i"(d0*4096+ks*1024+512):"memory");}
    asm volatile("s_waitcnt lgkmcnt(0)":::"memory");SBAR();
    #define PK(k) (bf16x8){lo[k][0],lo[k][1],lo[k][2],lo[k][3],hi[k][0],hi[k][1],hi[k][2],hi[k][3]}
    o[d0]=__builtin_amdgcn_mfma_f32_32x32x16_bf16(pa0,PK(0),o[d0],0,0,0);
    o[d0]=__builtin_amdgcn_mfma_f32_32x32x16_bf16(pa1,PK(1),o[d0],0,0,0);
    o[d0]=__builtin_amdgcn_mfma_f32_32x32x16_bf16(pa2,PK(2),o[d0],0,0,0);
    o[d0]=__builtin_amdgcn_mfma_f32_32x32x16_bf16(pa3,PK(3),o[d0],0,0,0);
    #undef PK
  }
}

template<int MODE,int THRL> __device__ __forceinline__ void attn_unit(int b,int h,int qb,const bf16*Q,const bf16*__restrict__ K,const bf16*__restrict__ V,const bf16*__restrict__ Z,bf16*G,const float*__restrict__ aux,char*shm){
  constexpr int KVW=MODE?256:128;
  const int kvh=MODE?(h>>2):(h>>3);
  int tid_=threadIdx.x; asm volatile("":"+v"(tid_));
  const int tid=tid_,lane=tid&63,r32=lane&31,hi=lane>>5; const int wid=__builtin_amdgcn_readfirstlane(tid>>6);
  const long rowbase=(long)b*ASEQ; const int q0=qb*QB;
  const bf16*Qw=Q+(rowbase+q0+wid*QBLK)*ADM+h*D;
  const bf16*Kh=K+rowbase*KVW+kvh*D,*Vh=V+rowbase*KVW+kvh*D;
  const unsigned lds0=(unsigned)(uintptr_t)shm;
  float*wsf=(float*)(shm+LDS_WS)+wid*64;
  const int NT=MODE?(4*qb+4):(qb?6:4);
  const int ktA=MODE?(4*qb):(qb?4*qb-2:0);
  #define KT(s) (MODE?(((s)<4)?(ktA+(s)):((s)-4)):(ktA+(s)))
  if(MODE){ float*km=(float*)(shm+LDS_KM); const float*ks=aux+((size_t)(b*16)*2)*256+kvh*64;
    for(int idx=tid;idx<qb*64;idx+=512){const int j=idx>>6,d=idx&63; km[idx]=(ks[(size_t)(2*j)*256+d]+ks[(size_t)(2*j+1)*256+d])*(1.0f/256.0f);} }
  const unsigned kvoff=(unsigned)(lane*KVW+wid*8)*2u;
  const unsigned vvoff=(unsigned)((16*(wid&3)+(lane>>2))*KVW+(wid>>2)*32+(lane&3)*8)*2u;
  const unsigned kdst=lds0+LDS_K+wid*1024, vdst=lds0+LDS_V+wid*1024;
  #define DMA_K(s,slot) glds16(Kh+(long)KT(s)*KVBLK*KVW,kvoff,(unsigned)__builtin_amdgcn_readfirstlane(kdst+(slot)))
  #define DMA_V(s,slot) glds16(Vh+(long)KT(s)*KVBLK*KVW,vvoff,(unsigned)__builtin_amdgcn_readfirstlane(vdst+(slot)))
  const int vb0=(int)(lds0+LDS_V)+((lane>>4)&1)*32+(lane&3)*8+(4*hi+((lane&15)>>2))*64;
  const char*Kbase=shm+LDS_K; bf16x8 kf[8];
  const lds_cptr shm3=(lds_cptr)shm; const lds_cptr kp0=shm3+LDS_K+hi*1024+r32*16; const lds_cptr vp0=shm3+LDS_V+((lane>>4)&1)*32+(lane&3)*8+(4*hi+((lane&15)>>2))*64;
  DMA_K(0,0);DMA_V(0,0);DMA_K(1,SLOTB);
  bf16x8 qr[4];
  #pragma unroll
  for(int d0=0;d0<4;++d0)qr[d0]=*reinterpret_cast<const bf16x8*>(&Qw[(long)r32*ADM+d0*16+hi*8]);
  float mhat=0.f,l_reg=0.f;f32x16 o[2];o[0]=f32x16{};o[1]=f32x16{};
  const f32x16 zc=f32x16{};
  const int qrel=wid*QBLK+r32;
  #define AMASK(P0,P1,s) do{ if(MODE){ if((s)<4)cmask(P0,P1,(s),qrel,hi); } else { wmask(P0,P1,q0+qrel-64*KT(s),hi); } }while(0)
  bool resc=false; unsigned selmask=0u; unsigned pm_=0xffffffffu;
  #define PMOF(s) ((MODE&&(s)>=4)?((((selmask>>((((s)-4)>>2)&31))&1u)!=0u)?0xffffffffu:0u):0xffffffffu)
  #define RESC() do{ if(resc){ asm volatile("s_waitcnt lgkmcnt(0)":::"memory"); \
      _Pragma("unroll") for(int d_=0;d_<2;++d_) _Pragma("unroll") for(int r=0;r<16;++r)o[d_][r]*=wsf[crow(r,hi)]; } }while(0)
  #define REFUPD(C0,C1,rm,LOWOK) do{ resc=false; \
      const float gr_=rm-mhat; \
      if(__builtin_expect(__any((gr_>(float)THRL)||((LOWOK)&&(rm<-60.f)&&(rm>-INFINITY))),0)){ \
        const float dl=((LOWOK)&&(rm<-60.f)&&(rm>-INFINITY))?gr_:__builtin_fmaxf(gr_,0.f); mhat+=dl; \
        const float f=__builtin_amdgcn_exp2f(-dl); l_reg*=f; if(hi==0)wsf[r32]=f; resc=true; } \
      if(__builtin_expect(__any(mhat!=0.f),0)){ _Pragma("unroll") for(int r=0;r<16;++r){C0[r]-=mhat;C1[r]-=mhat;} } }while(0)
  f32x16 pA0,pA1,pB0,pB1;
  int sl_prev=0,sl_cur=0,sl_next=SLOTB;
  #define ROT() do{sl_prev=sl_cur;sl_cur=sl_next;sl_next=(sl_next==(NSLOT-1)*SLOTB)?0:sl_next+SLOTB;}while(0)
  DMA_K(2,2*SLOTB);
  WAIT_BAR(3);
  SBAR();
  if(MODE){
    const float*km=(const float*)(shm+LDS_KM)+8*hi; float qf[32];
    #pragma unroll
    for(int d0=0;d0<4;++d0){
      #pragma unroll
      for(int e=0;e<8;++e)qf[d0*8+e]=__uint_as_float(((unsigned)(unsigned short)qr[d0][e])<<16);}
    float v1=-INFINITY,v2=-INFINITY,v3=-INFINITY; unsigned b1=0u,b2=0u,b3=0u;
    for(int j=0;j<qb;++j){ const float*kp=km+j*64; float g=0.f;
      #pragma unroll
      for(int d0=0;d0<4;++d0){
        #pragma unroll
        for(int e=0;e<8;++e)g+=qf[d0*8+e]*kp[16*d0+e];}
      g+=__shfl_xor(g,32);
      const unsigned bj=1u<<j; const bool c1=g>v1,c2=g>v2,c3=g>v3;
      v3=c2?v2:(c3?g:v3); b3=c2?b2:(c3?bj:b3);
      v2=c1?v1:(c2?g:v2); b2=c1?b1:(c2?bj:b2);
      v1=c1?g:v1;         b1=c1?bj:b1; }
    selmask=b1|b2|b3; asm volatile("":"+v"(selmask)); }
  SBAR();
  qkt(pA0,pA1,Kbase,qr,zc,r32,hi);asm volatile("s_nop 15\n\ts_nop 7":"+v"(pA0),"+v"(pA1));AMASK(pA0,pA1,0);
  { const float rm0=rowmax(pA0,pA1); REFUPD(pA0,pA1,rm0,true); }
  _Pragma("unroll") for(int r=0;r<16;++r)pA0[r]=__builtin_amdgcn_exp2f(pA0[r]);
  _Pragma("unroll") for(int r=0;r<16;++r)pA1[r]=__builtin_amdgcn_exp2f(pA1[r]);
  WAIT_BAR(0);
  DMA_K(3,0);DMA_V(1,SLOTB);
  ROT();
  kload8(kf,kp0+sl_cur);
  WAIT_BAR(2);
  s16x4 vlo[8],vhi[8]; u32x4 pw0,pw1,pw2,pw3;
  #define PKW(P,B) (MODE?(cvtpk_s(P[B],P[B+1])&pm_):cvtpk_s(P[B],P[B+1]))
  #define PAF(k) __builtin_bit_cast(bf16x8,pw##k)
  #define VFR(i) (bf16x8){vlo[i][0],vlo[i][1],vlo[i][2],vlo[i][3],vhi[i][0],vhi[i][1],vhi[i][2],vhi[i][3]}
  #define PIN(x) asm volatile("":"+v"(x))
  #define MX3(a,b,c) __builtin_fmaxf(__builtin_fmaxf((a),(b)),(c))
  #define GAPA(MF,A0,A1,A2,A3,W0,W1,PW) do{ MF; sacc+=A0; sacc+=A1; sacc+=A2; sacc+=A3; PIN(sacc); W0; W1; PIN(PW); SBAR(); }while(0)
  #define EX(v) __builtin_amdgcn_exp2f(v)
  #define GAPB(MF,X,B) do{ MF; X[B]=EX(X[B]); X[B+1]=EX(X[B+1]); X[B+2]=EX(X[B+2]); X[B+3]=EX(X[B+3]); PIN(X); SBAR(); }while(0)
  #define VRD(i) do{ vlo[i]=vtr(vp_+(((i)>>2)*4096+((i)&3)*1024)); vhi[i]=vtr(vp_+(((i)>>2)*4096+((i)&3)*1024+512)); }while(0)
  #define KRD(G,j) do{ if(G){ kload2(kf,kp0+sl_next,j); SBAR(); } }while(0)
  #define STEP(C0,C1,P0,P1,t,GK,GV,GL) do{ SBAR(); \
    const lds_cptr vp_=vp0+sl_prev; \
    VRD(0); SBAR(); float sacc=(P0[0]+P0[1]); \
    GAPA(C0=__builtin_amdgcn_mfma_f32_32x32x16_bf16(kf[0],qr[0],zc,0,0,0), P0[2],P0[3],P0[4],P0[5],     pw0[0]=PKW(P0,0), pw0[1]=PKW(P0,2), pw0); \
    VRD(4); SBAR(); GAPA(C1=__builtin_amdgcn_mfma_f32_32x32x16_bf16(kf[1],qr[0],zc,0,0,0), P0[6],P0[7],P0[8],P0[9],     pw0[2]=PKW(P0,4), pw0[3]=PKW(P0,6), pw0); \
    VRD(1); SBAR(); GAPA(C0=__builtin_amdgcn_mfma_f32_32x32x16_bf16(kf[2],qr[1],C0,0,0,0),   P0[10],P0[11],P0[12],P0[13], pw1[0]=PKW(P0,8), pw1[1]=PKW(P0,10), pw1); \
    VRD(5); SBAR(); GAPA(C1=__builtin_amdgcn_mfma_f32_32x32x16_bf16(kf[3],qr[1],C1,0,0,0),   P0[14],P0[15],P1[0],P1[1],   pw1[2]=PKW(P0,12),pw1[3]=PKW(P0,14), pw1); \
    VRD(2); SBAR(); GAPA(C0=__builtin_amdgcn_mfma_f32_32x32x16_bf16(kf[4],qr[2],C0,0,0,0),   P1[2],P1[3],P1[4],P1[5],     pw2[0]=PKW(P1,0), pw2[1]=PKW(P1,2), pw2); \
    VRD(6); SBAR(); GAPA(C1=__builtin_amdgcn_mfma_f32_32x32x16_bf16(kf[5],qr[2],C1,0,0,0),   P1[6],P1[7],P1[8],P1[9],     pw2[2]=PKW(P1,4), pw2[3]=PKW(P1,6), pw2); \
    VRD(3); SBAR(); GAPA(C0=__builtin_amdgcn_mfma_f32_32x32x16_bf16(kf[6],qr[3],C0,0,0,0),   P1[10],P1[11],P1[12],P1[13], pw3[0]=PKW(P1,8), pw3[1]=PKW(P1,10), pw3); \
    VRD(7); SBAR(); GAPA(C1=__builtin_amdgcn_mfma_f32_32x32x16_bf16(kf[7],qr[3],C1,0,0,0),   P1[14],P1[15],0.f,0.f,       pw3[2]=PKW(P1,12),pw3[3]=PKW(P1,14), pw3); \
    l_reg+=(MODE?(pm_?sacc:0.f):sacc); \
    if(GK){DMA_K((t)+3,sl_cur);} if(GV){DMA_V((t)+1,sl_next);} \
    AMASK(C0,C1,t); \
    { float a=MX3(C0[0],C0[1],C1[0]),b=MX3(C0[2],C0[3],C1[1]); a=MX3(a,C1[2],C1[3]); \
      _Pragma("unroll") for(int r=4;r<16;r+=4){a=MX3(a,C0[r],C0[r+1]);b=MX3(b,C0[r+2],C0[r+3]);a=MX3(a,C1[r],C1[r+1]);b=MX3(b,C1[r+2],C1[r+3]);} \
      float rm=__builtin_fmaxf(a,b); { auto rr=__builtin_amdgcn_permlane32_swap(__float_as_uint(rm),__float_as_uint(rm),false,false); rm=__builtin_fmaxf(__uint_as_float(rr[0]),__uint_as_float(rr[1])); } \
      pm_=PMOF(t); if(MODE){ rm=pm_?rm:-INFINITY; } \
      REFUPD(C0,C1,rm,false); } \
    SBAR(); \
    GAPB(o[0]=__builtin_amdgcn_mfma_f32_32x32x16_bf16(PAF(0),VFR(0),o[0],0,0,0), C0,0); \
    GAPB(o[1]=__builtin_amdgcn_mfma_f32_32x32x16_bf16(PAF(0),VFR(4),o[1],0,0,0), C0,4); \
    KRD(GL,0); GAPB(o[0]=__builtin_amdgcn_mfma_f32_32x32x16_bf16(PAF(1),VFR(1),o[0],0,0,0), C0,8); \
    KRD(GL,1); GAPB(o[1]=__builtin_amdgcn_mfma_f32_32x32x16_bf16(PAF(1),VFR(5),o[1],0,0,0), C0,12); \
    KRD(GL,2); GAPB(o[0]=__builtin_amdgcn_mfma_f32_32x32x16_bf16(PAF(2),VFR(2),o[0],0,0,0), C1,0); \
    KRD(GL,3); GAPB(o[1]=__builtin_amdgcn_mfma_f32_32x32x16_bf16(PAF(2),VFR(6),o[1],0,0,0), C1,4); \
    GAPB(o[0]=__builtin_amdgcn_mfma_f32_32x32x16_bf16(PAF(3),VFR(3),o[0],0,0,0), C1,8); \
    GAPB(o[1]=__builtin_amdgcn_mfma_f32_32x32x16_bf16(PAF(3),VFR(7),o[1],0,0,0), C1,12); \
    }while(0)
  int t=1;
  for(;t+5<NT;t+=2){
    STEP(pB0,pB1,pA0,pA1,t,true,true,true);     WAIT_BAR(2); RESC(); ROT();
    STEP(pA0,pA1,pB0,pB1,t+1,true,true,true);   WAIT_BAR(2); RESC(); ROT();
  }
  #define ENDW(tt) do{ if((tt)+3<NT){WAIT_BAR(2);} else if((tt)+2<NT){WAIT_BAR(1);} else {WAIT_BAR(0);} }while(0)
  for(;t+1<NT;t+=2){
    STEP(pB0,pB1,pA0,pA1,t,(t+3<NT),(t+1<NT),(t+1<NT));       ENDW(t);   RESC(); ROT();
    STEP(pA0,pA1,pB0,pB1,t+1,(t+4<NT),(t+2<NT),(t+2<NT));     ENDW(t+1); RESC(); ROT();
  }
  STEP(pB0,pB1,pA0,pA1,NT-1,false,false,false); RESC();
  { float sacc=pB0[0]+pB0[1]; _Pragma("unroll") for(int r=2;r<16;++r)sacc+=pB0[r]; _Pragma("unroll") for(int r=0;r<16;++r)sacc+=pB1[r]; l_reg+=(MODE?(pm_?sacc:0.f):sacc);
    pw0=(u32x4){PKW(pB0,0),PKW(pB0,2),PKW(pB0,4),PKW(pB0,6)};pw1=(u32x4){PKW(pB0,8),PKW(pB0,10),PKW(pB0,12),PKW(pB0,14)};pw2=(u32x4){PKW(pB1,0),PKW(pB1,2),PKW(pB1,4),PKW(pB1,6)};pw3=(u32x4){PKW(pB1,8),PKW(pB1,10),PKW(pB1,12),PKW(pB1,14)};
    SBAR(); pv(o,vb0+sl_cur,PAF(0),PAF(1),PAF(2),PAF(3)); }
  #undef PKW
  #undef PAF
  #undef VFR
  #undef PIN
  #undef MX3
  #undef GAPA
  #undef GAPB
  #undef EX
  #undef VRD
  #undef KRD
  #undef STEP
  #undef ENDW
  {auto rr=__builtin_amdgcn_permlane32_swap(__float_as_uint(l_reg),__float_as_uint(l_reg),false,false);l_reg=__uint_as_float(rr[0])+__uint_as_float(rr[1]);}
  if(!MODE)l_reg+=__builtin_amdgcn_exp2f(aux[h]*1.4426950408889634f-mhat);
  long grow0=rowbase+q0+wid*QBLK; asm volatile("":"+v"(grow0));
  u32x4 zv[4];
  #pragma unroll
  for(int i=0;i<4;++i){const int row=i*8+(lane>>3),ch=lane&7; zv[i]=*(const u32x4*)(Z+(grow0+row)*ADM+h*D+ch*8);}
  if(hi==0)wsf[32+r32]=l_reg;asm volatile("s_waitcnt lgkmcnt(0)":::"memory");
  float rli[16];
  #pragma unroll
  for(int r=0;r<16;++r)rli[r]=__builtin_amdgcn_rcpf(wsf[32+crow(r,hi)]);
  { float*stg=(float*)(shm+LDS_OST)+wid*2048;
    #pragma unroll
    for(int r=0;r<16;++r){const int orow=crow(r,hi);
      #pragma unroll
      for(int d0=0;d0<2;++d0)stg[orow*64+d0*32+r32]=o[d0][r]*rli[r];}
    asm volatile("s_waitcnt lgkmcnt(0)":::"memory");
    #pragma unroll
    for(int i=0;i<4;++i){const int row=i*8+(lane>>3),ch=lane&7; const f32x4 a0=*(const f32x4*)(stg+row*64+ch*8),a1=*(const f32x4*)(stg+row*64+ch*8+4);
      float zf[8]; zf[0]=__uint_as_float(zv[i].x<<16);zf[1]=__uint_as_float(zv[i].x&0xffff0000u);zf[2]=__uint_as_float(zv[i].y<<16);zf[3]=__uint_as_float(zv[i].y&0xffff0000u);
      zf[4]=__uint_as_float(zv[i].z<<16);zf[5]=__uint_as_float(zv[i].z&0xffff0000u);zf[6]=__uint_as_float(zv[i].w<<16);zf[7]=__uint_as_float(zv[i].w&0xffff0000u);
      float gv[8];
      #pragma unroll
      for(int e=0;e<8;++e){const float ov=e<4?a0[e]:a1[e-4]; gv[e]=ov*zf[e]*__builtin_amdgcn_rcpf(1.0f+__builtin_amdgcn_exp2f(-1.4426950408889634f*zf[e]));}
      u32x4 w; w.x=cvtpk_s(gv[0],gv[1]);w.y=cvtpk_s(gv[2],gv[3]);w.z=cvtpk_s(gv[4],gv[5]);w.w=cvtpk_s(gv[6],gv[7]);
      *(u32x4*)(G+(grow0+row)*ADM+h*D+ch*8)=w;} }
  asm volatile("s_waitcnt lgkmcnt(0)\n\ts_barrier":::"memory");
  #undef DMA_K
  #undef DMA_V
  #undef KT
  #undef AMASK
  #undef PMOF
  #undef REFUPD
  #undef RESC
  #undef ROT
}
constexpr int ATTN_LDS_BYTES=LDS_BYTES;
#undef SBAR
#undef WAIT_BAR
}

#define GAS __attribute__((address_space(1)))
#define LAS __attribute__((address_space(3)))
typedef unsigned short bf16;
typedef unsigned v4u __attribute__((ext_vector_type(4)));
typedef float f32x4 __attribute__((ext_vector_type(4)));
typedef short bf16x8 __attribute__((ext_vector_type(8)));
typedef GAS unsigned gu32;
typedef GAS unsigned long long gu64;
#define RLX_AGENT __ATOMIC_RELAXED, __HIP_MEMORY_SCOPE_AGENT
#define LDS_WAIT() asm volatile("s_waitcnt lgkmcnt(0)" ::: "memory")
#define VM_WAIT() asm volatile("s_waitcnt vmcnt(0)" ::: "memory")
__device__ __forceinline__ unsigned long long rt() { return __builtin_amdgcn_s_memrealtime(); }
__device__ __forceinline__ unsigned pk2(float lo, float hi) { return f2bf(lo) | (f2bf(hi) << 16); }

#define XB_TMO      128
#define XB_XCNT(j)  (256  + 64 * (j))
#define XB_XSUB(j)  (1280 + 64 * (j))
#define XB_XGEN(j)  (2304 + 64 * (j))
#define XB_TOP      3328
#define XB_TOPGEN   3392
#define XCD_BAR_WORDS 3456
#define XB_SPIN_CAP (1u << 18)

__device__ __forceinline__ unsigned xb_ld(unsigned* p)              { return __hip_atomic_load(p, __ATOMIC_RELAXED, __HIP_MEMORY_SCOPE_AGENT); }
__device__ __forceinline__ unsigned xb_add(unsigned* p, unsigned v) { return __hip_atomic_fetch_add(p, v, __ATOMIC_RELAXED, __HIP_MEMORY_SCOPE_AGENT); }
__device__ __forceinline__ unsigned xb_xcc_id() { return (unsigned)__builtin_amdgcn_s_getreg((3 << 11) | 20) & 0xFu; }
#define XB_SPIN(cond, bar) do { unsigned _sp = 0; while (cond) { __builtin_amdgcn_s_sleep(1); \
    if ((++_sp & 255u) == 0u) { if (xb_ld(&(bar)[XB_TMO])) break; if (_sp > XB_SPIN_CAP) { atomicAdd(&(bar)[XB_TMO], 1u); break; } } } } while (0)

struct XcdBarrier {
    unsigned* bar; unsigned x;
    volatile LAS unsigned* st;
};

__device__ __forceinline__ XcdBarrier xcd_barrier_post(unsigned* bar, volatile LAS unsigned* st) {
    XcdBarrier b; b.bar = bar; b.x = xb_xcc_id(); b.st = st;
    if (threadIdx.x == 0) (void)xb_add(&bar[XB_XCNT(b.x)], 1u);
    return b;
}
__device__ __forceinline__ void xcd_barrier_complete(unsigned* bar, unsigned x, unsigned& nloc, unsigned& nx) {
    const unsigned G = gridDim.x * gridDim.y * gridDim.z;
    unsigned sum, cnt, mine, sp = 0u;
    for (;;) {
        sum = 0u; cnt = 0u; mine = 0u;
#pragma unroll
        for (unsigned j = 0; j < 16; ++j) { const unsigned c = xb_ld(&bar[XB_XCNT(j)]); sum += c; cnt += (c > 0u) ? 1u : 0u; mine = (j == x) ? c : mine; }
        if (sum == G) break;
        __builtin_amdgcn_s_sleep(1);
        if ((++sp & 255u) == 0u) { if (xb_ld(&bar[XB_TMO])) break; if (sp > XB_SPIN_CAP) { atomicAdd(&bar[XB_TMO], 1u); break; } }
    }
    nloc = mine > 0u ? mine : 1u; nx = cnt > 0u ? cnt : 1u;
}

__device__ __forceinline__ void xcd_barrier(const XcdBarrier& b) {
    asm volatile("s_waitcnt vmcnt(0)" ::: "memory");
    __syncthreads();
    if (threadIdx.x == 0) {
        unsigned* bar = b.bar;
        __builtin_amdgcn_s_waitcnt(0);
        unsigned nloc = b.st[0], nx = b.st[1];
        if (nloc == 0u) { xcd_barrier_complete(bar, b.x, nloc, nx); b.st[0] = nloc; b.st[1] = nx; }
        const unsigned old = xb_add(&bar[XB_XSUB(b.x)], 1u);
        const unsigned gen = old / nloc;
        if (old + 1u == (gen + 1u) * nloc) {
            __builtin_amdgcn_fence(__ATOMIC_RELEASE, "agent");
            asm volatile("s_waitcnt vmcnt(0)" ::: "memory");
            const unsigned og = xb_add(&bar[XB_TOP], 1u);
            const unsigned tg = og / nx;
            if (og + 1u == (tg + 1u) * nx) xb_add(&bar[XB_TOPGEN], 1u);
            else XB_SPIN(xb_ld(&bar[XB_TOPGEN]) == tg, bar);
            __builtin_amdgcn_fence(__ATOMIC_ACQUIRE, "agent");
            xb_add(&bar[XB_XGEN(b.x)], 1u);
            asm volatile("s_waitcnt vmcnt(0)" ::: "memory");
        } else {
            XB_SPIN(xb_ld(&bar[XB_XGEN(b.x)]) == gen, bar);
            __builtin_amdgcn_fence(__ATOMIC_ACQUIRE, "agent");
            asm volatile("s_waitcnt vmcnt(0)" ::: "memory");
        }
    }
    __syncthreads();
}

constexpr int NWAVES = 8;
#ifndef MK_EN
#define MK_EN 15
#endif
constexpr int NPH = 14;
constexpr int RING_OFF = 0, RING_BYTES = 131072;
constexpr int LDS_BYTES = 147456;
constexpr int LDSCTL_OFF = LDS_BYTES - 512, MISC_OFF = LDSCTL_OFF + 320;
constexpr int CW_TMO = 0, CW_BAR = 4096;
constexpr size_t CTL_ZERO_BYTES = 64 * 1024;
static_assert((CW_BAR + XCD_BAR_WORDS) * 4 <= (int)CTL_ZERO_BYTES, "barrier words inside the memset region");
static_assert(attn_body::ATTN_LDS_BYTES <= RING_BYTES, "attention LDS");

__constant__ const unsigned ROPE_INV_BITS[32] = {0x3f800000u, 0x3f3ff911u, 0x3f0ff59au, 0x3ed7e89bu, 0x3ea1e89bu, 0x3e72d424u, 0x3e361887u, 0x3e088d77u, 0x3dcccccdu, 0x3d99940eu, 0x3d6655c3u, 0x3d2cba15u, 0x3d0186e2u, 0x3cc24350u, 0x3c91ad39u, 0x3c5a7bf1u,
    0x3c23d70au, 0x3bf5b9b0u, 0x3bb8449cu, 0x3b8a2e77u, 0x3b4f3e37u, 0x3b1b690du, 0x3ae91528u, 0x3aaec98eu, 0x3a83126fu, 0x3a44948cu, 0x3a136a16u, 0x39dd1726u, 0x39a5cb5fu, 0x3978a814u, 0x393a7753u, 0x390bd472u};
struct Args { const float* in[7]; float* out; unsigned char* ws; int ph_lo, ph_hi; };

__device__ __forceinline__ void p0_w_item(const float* __restrict__ W, int ldw, int k0, int n0, bool perm, const float* __restrict__ g, bf16_t* __restrict__ Wt, LAS float* scr, int lane) {
#pragma unroll
    for (int kb = 0; kb < 64; kb += 32) { float wv[32];
#pragma unroll
        for (int kk = 0; kk < 32; ++kk) wv[kk] = W[(size_t)(k0 + kb + kk) * ldw + n0 + lane];
#pragma unroll
        for (int kk = 0; kk < 32; ++kk) { const float gv = g ? g[k0 + kb + kk] : 1.0f; scr[(kb + kk) * 65 + lane] = wv[kk] * gv; } }
    LDS_WAIT(); asm volatile("" ::: "memory");
    const int c = lane & 7;
#pragma unroll
    for (int j = 0; j < 8; ++j) { const int n = (lane >> 3) + 8 * j; const int sc = perm ? dmap(n) : n; const LAS float* s = scr + (8 * c) * 65 + sc;
        v4u o; o.x = pk2(s[0 * 65], s[1 * 65]); o.y = pk2(s[2 * 65], s[3 * 65]); o.z = pk2(s[4 * 65], s[5 * 65]); o.w = pk2(s[6 * 65], s[7 * 65]);
        *(GAS v4u*)(Wt + (size_t)(n0 + n) * 1024 + k0 + 8 * c) = o; }
    LDS_WAIT(); asm volatile("" ::: "memory");
}

__global__ void __launch_bounds__(NWAVES * 64, 2) mk_fwd(Args args) {
    extern __shared__ __attribute__((aligned(16))) unsigned char lds[];
    LAS unsigned char* ldsp = (LAS unsigned char*)lds;
    volatile LAS unsigned* MISC = (volatile LAS unsigned*)(ldsp + MISC_OFF);
    const int tid0 = threadIdx.x;
    gu32* ctl = (gu32*)(args.ws + WS_CTL);
    for (int u = tid0; u < (LDS_BYTES - LDSCTL_OFF) / 4; u += NWAVES * 64) ((LAS unsigned*)(ldsp + LDSCTL_OFF))[u] = 0u;
    __syncthreads();
    const int lo = args.ph_lo, hi = args.ph_hi;
    XcdBarrier bar; bar.bar = (unsigned*)(ctl + CW_BAR); bar.x = 0; bar.st = nullptr;
    if (hi - lo > 1) bar = xcd_barrier_post((unsigned*)(ctl + CW_BAR), MISC + 8);

#ifndef MK_DUP
#define MK_DUP (-1)
#endif
    for (int pk = lo; pk < hi + (MK_DUP >= 0 ? 1 : 0); ++pk) {
        const int p = (MK_DUP >= 0 && pk > MK_DUP) ? pk - 1 : pk;
        int tid = threadIdx.x, G = gridDim.x, bx = blockIdx.x; asm volatile("" : "+v"(tid), "+s"(G), "+s"(bx));
        const int lane = tid & 63, wave = __builtin_amdgcn_readfirstlane(tid >> 6);
        const int vcu = (G % 8 == 0) ? (bx % 8) * (G / 8) + bx / 8 : bx;
        const int gw = vcu * NWAVES + wave, NGW = G * NWAVES;
        GAS unsigned char* wsg = (GAS unsigned char*)args.ws; asm volatile("" : "+s"(wsg)); unsigned char* ws = (unsigned char*)wsg;
#define xin (args.in[0])
#define norm_g (args.in[1])
#define w_in_a (args.in[2])
#define sinks_a (args.in[3])
#define w_in_b (args.in[4])
#define w_out (args.in[5])
#define final_g (args.in[6])
#define H (args.out)
#define rope ((float*)(ws + WS_ROPE))
#define ss ((float*)(ws + WS_SS))
#define KS ((float*)(ws + WS_KS))
#define Hb ((bf16_t*)(ws + WS_HB))
#define Qb ((bf16_t*)(ws + WS_Q))
#define Zb ((bf16_t*)(ws + WS_Z))
#define Gb ((bf16_t*)(ws + WS_G))
#define Kb ((bf16_t*)(ws + WS_K))
#define Vb ((bf16_t*)(ws + WS_V))
        if (p == 0) {
            for (int idx = bx * (NWAVES * 64) + tid; idx < SEQ * 32; idx += G * NWAVES * 64) {
                const int pos = idx >> 5, i = idx & 31;
                const float ang = (float)pos * __uint_as_float(ROPE_INV_BITS[i]);
                float sn, cs; sincosf(ang, &sn, &cs);
                rope[2 * idx] = cs; rope[2 * idx + 1] = sn;
            }
            LAS float* scr = (LAS float*)(ldsp + RING_OFF + wave * 16640);
            constexpr int I_A = (IN_A / 64) * 16, I_B = (IN_B / 64) * 16, I_O = 256, I_L2 = I_A + I_O + I_B + I_O, NITEMS = 2 * I_L2;
            for (int it = gw; it < NITEMS; it += NGW) {
                const int l2 = it / I_L2; int r = it % I_L2; int l; bool isw2 = false; int IN = IN_A;
                if (r < I_A) { l = 2 * l2; }
                else if (r < I_A + I_O) { r -= I_A; l = 2 * l2; isw2 = true; }
                else if (r < I_A + I_O + I_B) { r -= I_A + I_O; l = 2 * l2 + 1; IN = IN_B; }
                else { r -= I_A + I_O + I_B; l = 2 * l2 + 1; isw2 = true; }
                const int cg = r >> 4, kg = r & 15;
                if (isw2) p0_w_item(w_out + (size_t)l * DM * DM, DM, kg * 64, cg * 64, false, nullptr, (bf16_t*)(ws + WS_W2T + l * W2T_STRIDE), scr, lane);
                else { const float* Win = (l & 1) ? w_in_b + (size_t)l2 * DM * IN_B : w_in_a + (size_t)l2 * DM * IN_A; const int kvw = (l & 1) ? 256 : 128;
                       p0_w_item(Win, IN, kg * 64, cg * 64, cg * 64 < 1024 + kvw, norm_g + l * DM, (bf16_t*)(ws + WS_W1T + l * W1T_STRIDE), scr, lane); }
            }
            for (int row = gw; row < M; row += 2 * NGW) {
                const int row2 = row + NGW; const bool two = row2 < M;
                const f32x4* xr = (const f32x4*)(xin + (size_t)row * DM) + lane; const f32x4* xr2 = (const f32x4*)(xin + (size_t)(two ? row2 : row) * DM) + lane;
                f32x4 va[4], vb[4];
#pragma unroll
                for (int j = 0; j < 4; ++j) { va[j] = xr[64 * j]; vb[j] = xr2[64 * j]; }
                float s = 0.f, s2 = 0.f;
                unsigned long long* o8 = (unsigned long long*)(Hb + (size_t)row * DM) + lane; unsigned long long* o82 = (unsigned long long*)(Hb + (size_t)row2 * DM) + lane;
#pragma unroll
                for (int j = 0; j < 4; ++j) { const f32x4 v = va[j]; s += (v[0] * v[0] + v[1] * v[1]) + (v[2] * v[2] + v[3] * v[3]);
                    o8[64 * j] = (unsigned long long)pk2(v[0], v[1]) | ((unsigned long long)pk2(v[2], v[3]) << 32);
                    const f32x4 w = vb[j]; s2 += (w[0] * w[0] + w[1] * w[1]) + (w[2] * w[2] + w[3] * w[3]);
                    if (two) o82[64 * j] = (unsigned long long)pk2(w[0], w[1]) | ((unsigned long long)pk2(w[2], w[3]) << 32); }
                s = wave_sum(s); s2 = wave_sum(s2);
                if (lane < 16) { ss[(size_t)row * 16 + lane] = lane == 0 ? s : 0.f; if (two) ss[(size_t)row2 * 16 + lane] = lane == 0 ? s2 : 0.f; }
            }
        } else if (p == NPH - 1) {
            for (int row = gw; row < M; row += NGW) {
                f32x4* hr = (f32x4*)(H + (size_t)row * DM) + lane; const f32x4* gr = (const f32x4*)final_g + lane;
                f32x4 v[4]; float s = 0.f;
#pragma unroll
                for (int j = 0; j < 4; ++j) { v[j] = hr[64 * j]; s += (v[j][0] * v[j][0] + v[j][1] * v[j][1]) + (v[j][2] * v[j][2] + v[j][3] * v[j][3]); }
                const float rstd = __builtin_amdgcn_rsqf(wave_sum(s) * (1.0f / DM) + EPS);
#pragma unroll
                for (int j = 0; j < 4; ++j) hr[64 * j] = v[j] * rstd * gr[64 * j];
            }
        } else {
            const int l = (p - 1) / 3, kind = (p - 1) % 3; const bool isB = l & 1;
            if (kind == 0) {
                const bf16_t* W1t = (const bf16_t*)(ws + WS_W1T + l * W1T_STRIDE);
                if (!(MK_EN & 1)) {} else if (!isB) { pg8::Gemm g{Hb, W1t, M, IN_A, DM}; pg8::StaticOrder S; S.init(M, IN_A, G, bx);
                    pg8::EpiG1<2> E{Qb, Kb, Vb, Zb, ss, rope, KS};
                    pg8::gemm_phase<pg8::EpiG1<2>, pg8::StaticOrder, true, true>(ldsp + RING_OFF, g, S, E);
                } else { pg8::Gemm g{Hb, W1t, M, IN_B, DM}; pg8::StaticOrder S; S.init(M, IN_B, G, bx);
                    pg8::EpiG1<4> E{Qb, Kb, Vb, Zb, ss, rope, KS};
                    pg8::gemm_phase<pg8::EpiG1<4>, pg8::StaticOrder, true, true>(ldsp + RING_OFF, g, S, E); }
            } else if (kind == 1) {
                if (!isB) { if (MK_EN & 2)
                    for (int U = vcu; U < 2048; U += G) { const int vc = U & 255, i = U >> 8; const int bh = vc >> 1, qb = (vc & 1) * 8 + i;
                        attn_body::attn_unit<0, 8>(bh >> 4, bh & 15, qb, Qb, Kb, Vb, Zb, Gb, sinks_a + (l >> 1) * NH, (char*)lds + RING_OFF); }
                } else { if (MK_EN & 4)
                    for (int U = vcu; U < 2048; U += G) { const int vc = U & 255, i = U >> 8; const int grp = vc >> 3, hh = (vc & 7) >> 1, half = vc & 1;
                        const int s = 2 * (i >> 1) + half, qb = (i & 1) ? 15 - s : s;
                        attn_body::attn_unit<1, 8>(grp >> 2, (grp & 3) * 4 + hh, qb, Qb, Kb, Vb, Zb, Gb, KS, (char*)lds + RING_OFF); }
                }
            } else {
                const bf16_t* W2t = (const bf16_t*)(ws + WS_W2T + l * W2T_STRIDE);
                if (MK_EN & 8) {
                pg8::Gemm g{Gb, W2t, M, DM, DM}; pg8::StaticOrder S; S.init(M, DM, G, bx);
                if (l == 0) { pg8::EpiG2<true, false> E{xin, H, Hb, ss}; pg8::gemm_phase<pg8::EpiG2<true, false>, pg8::StaticOrder, true, true>(ldsp + RING_OFF, g, S, E); }
                else if (l < DEPTH - 1) { pg8::EpiG2<false, false> E{xin, H, Hb, ss}; pg8::gemm_phase<pg8::EpiG2<false, false>, pg8::StaticOrder, true, true>(ldsp + RING_OFF, g, S, E); }
                else { pg8::EpiG2<false, true> E{xin, H, Hb, ss}; pg8::gemm_phase<pg8::EpiG2<false, true>, pg8::StaticOrder, true, true>(ldsp + RING_OFF, g, S, E); } }
            }
        }
        if (pk + 1 < hi + (MK_DUP >= 0 ? 1 : 0)) { XcdBarrier b2 = bar; GAS unsigned* bg = (GAS unsigned*)bar.bar; asm volatile("" : "+s"(bg), "+s"(b2.x)); b2.bar = (unsigned*)bg; xcd_barrier(b2); }
    }
#undef xin
#undef norm_g
#undef w_in_a
#undef sinks_a
#undef w_in_b
#undef w_out
#undef final_g
#undef H
#undef rope
#undef ss
#undef KS
#undef Hb
#undef Qb
#undef Zb
#undef Gb
#undef Kb
#undef Vb
}

#ifndef MK_FAST_MASK
#define MK_FAST_MASK 0x3fff
#endif
#ifndef MK_ONE_LAUNCH
#define MK_ONE_LAUNCH 1
#endif
extern "C" void kernel_launch(void* const* d_in, const int* in_sizes, int n_in, void* d_out, int out_size, void* d_ws, size_t ws_size, hipStream_t stream) {
    static int grid = 0;
    if (grid == 0) {
        if (n_in != 7 || in_sizes[0] != M * DM || out_size != M * DM || ws_size < WS_END) { fprintf(stderr, "kernel_launch: unexpected shapes (n_in %d, in0 %d, out %d, ws %zu)\n", n_in, n_in > 0 ? in_sizes[0] : -1, out_size, ws_size); grid = -1; return; }
        int dev = 0, cus = 0, per_cu = 0;
        if (hipGetDevice(&dev) != hipSuccess || hipDeviceGetAttribute(&cus, hipDeviceAttributeMultiprocessorCount, dev) != hipSuccess) { grid = -1; return; }
        if (hipFuncSetAttribute((const void*)mk_fwd, hipFuncAttributeMaxDynamicSharedMemorySize, LDS_BYTES) != hipSuccess) { fprintf(stderr, "kernel_launch: hipFuncSetAttribute failed\n"); grid = -1; return; }
        if (hipOccupancyMaxActiveBlocksPerMultiprocessor(&per_cu, (const void*)mk_fwd, NWAVES * 64, LDS_BYTES) != hipSuccess || per_cu < 1) fprintf(stderr, "kernel_launch: occupancy query reports %d blocks per CU\n", per_cu);
        (void)hipGetLastError();
        grid = cus;
    }
    if (grid < 0) return;
    const float* x = (const float*)d_in[0]; const float* norm_g = (const float*)d_in[1]; const float* w_in_a = (const float*)d_in[2]; const float* sinks_a = (const float*)d_in[3];
    const float* w_in_b = (const float*)d_in[4]; const float* w_out = (const float*)d_in[5]; const float* final_g = (const float*)d_in[6];
    unsigned char* ws = (unsigned char*)d_ws; float* H = (float*)d_out;
    (void)hipMemsetAsync(ws + WS_CTL, 0, CTL_ZERO_BYTES, stream);
    Args a{};
    for (int i = 0; i < 7; ++i) a.in[i] = (const float*)d_in[i];
    a.out = H; a.ws = ws;
    if (MK_ONE_LAUNCH && MK_FAST_MASK == 0x3fff) { a.ph_lo = 0; a.ph_hi = NPH; hipLaunchKernelGGL(mk_fwd, dim3(grid), dim3(NWAVES * 64), LDS_BYTES, stream, a); return; }
    float2* rope = (float2*)(ws + WS_ROPE); float* ss = (float*)(ws + WS_SS); float* KS = (float*)(ws + WS_KS);
    bf16_t* Hb = (bf16_t*)(ws + WS_HB); bf16_t* Qb = (bf16_t*)(ws + WS_Q); bf16_t* Zb = (bf16_t*)(ws + WS_Z); bf16_t* Gb = (bf16_t*)(ws + WS_G); bf16_t* Kb = (bf16_t*)(ws + WS_K); bf16_t* Vb = (bf16_t*)(ws + WS_V);
    for (int p = 0; p < NPH; ++p) {
        if ((MK_FAST_MASK >> p) & 1) { a.ph_lo = p; a.ph_hi = p + 1; hipLaunchKernelGGL(mk_fwd, dim3(grid), dim3(NWAVES * 64), LDS_BYTES, stream, a); continue; }
        if (p == 0) {
            k_prep_rope<<<SEQ * 32 / 256, 256, 0, stream>>>(rope);
            for (int l = 0; l < DEPTH; ++l) { const bool isB = l & 1; const int IN = isB ? IN_B : IN_A, KVW = isB ? 256 : 128;
                const float* Win = (isB ? w_in_b : w_in_a) + (size_t)(l >> 1) * DM * IN;
                k_prep_w1<<<(unsigned)(((size_t)IN * DM + 255) / 256), 256, 0, stream>>>(Win, norm_g + l * DM, (bf16_t*)(ws + WS_W1T + l * W1T_STRIDE), IN, KVW);
                k_prep_w2<<<DM * DM / 256, 256, 0, stream>>>(w_out + (size_t)l * DM * DM, (bf16_t*)(ws + WS_W2T + l * W2T_STRIDE)); }
            k_prep_x<<<M / 4, 256, 0, stream>>>(x, Hb, ss);
        } else if (p == NPH - 1) { k_final<<<M / 4, 256, 0, stream>>>(H, final_g);
        } else { const int l = (p - 1) / 3, kind = (p - 1) % 3; const bool isB = l & 1;
            const bf16_t* W1t = (const bf16_t*)(ws + WS_W1T + l * W1T_STRIDE); const bf16_t* W2t = (const bf16_t*)(ws + WS_W2T + l * W2T_STRIDE);
            if (kind == 0) { if (!isB) k_gemm1_naive<2><<<(M / 16) * (IN_A / 64) / 4, 256, 0, stream>>>(Hb, W1t, ss, rope, Qb, Kb, Vb, Zb);
                             else { k_gemm1_naive<4><<<(M / 16) * (IN_B / 64) / 4, 256, 0, stream>>>(Hb, W1t, ss, rope, Qb, Kb, Vb, Zb); k_ksum_naive<<<BATCH * NBLK, 256, 0, stream>>>(Kb, KS); } }
            else if (kind == 1) { if (!isB) k_attn_swa_naive<<<M * NH / 4, 256, 0, stream>>>(Qb, Kb, Vb, Zb, sinks_a + (l >> 1) * NH, Gb); else k_attn_moba_naive<<<M * NH / 4, 256, 0, stream>>>(Qb, Kb, Vb, Zb, KS, Gb); }
            else k_gemm2_naive<<<(M / 16) * 16 / 4, 256, 0, stream>>>(Gb, W2t, l == 0 ? x : H, H, Hb, ss);
        }
    }
}
```

```cpp
#define MK_FAST_MASK 0x3fff
#define MK_ONE_LAUNCH 1
#include <hip/hip_runtime.h>
#include <cstdint>
#include <cstdio>

typedef unsigned short bf16_t;
typedef short bf16x8 __attribute__((ext_vector_type(8)));
typedef float f32x4 __attribute__((ext_vector_type(4)));
typedef unsigned u32x4 __attribute__((ext_vector_type(4)));

constexpr int BATCH = 8, SEQ = 4096, DM = 1024, DEPTH = 4, HD = 64, NH = 16;
constexpr int M = BATCH * SEQ;
constexpr int IN_A = 2304, IN_B = 2560;
constexpr int WINDOW = 128, MBLK = 256, NBLK = SEQ / MBLK;
constexpr float EPS = 1e-5f;
constexpr float LOG2E = 1.4426950408889634f;
constexpr float C2 = 0.125f * LOG2E;

constexpr size_t MiB = 1u << 20;
constexpr size_t WS_CTL = 0, WS_ROPE = 1 * MiB, WS_W1T = 2 * MiB, WS_W2T = 22 * MiB, WS_SS = 30 * MiB, WS_KS = 32 * MiB;
constexpr size_t WS_HB = 64 * MiB, WS_Q = 128 * MiB, WS_Z = 192 * MiB, WS_G = 256 * MiB, WS_K = 320 * MiB, WS_V = 336 * MiB, WS_END = 352 * MiB;
constexpr size_t W1T_STRIDE = 5 * MiB, W2T_STRIDE = 2 * MiB;

__device__ __forceinline__ unsigned f2bf(float f) { unsigned u = __builtin_bit_cast(unsigned, f); return (u + 0x7fffu + ((u >> 16) & 1u)) >> 16; }
__device__ __forceinline__ float bf2f(unsigned h) { return __builtin_bit_cast(float, h << 16); }
__host__ __device__ __forceinline__ int dmap(int cc) { return (((cc >> 2) & 1) << 5) | ((cc >> 5) << 4) | (((cc >> 3) & 3) << 2) | (cc & 3); }
__host__ __device__ __forceinline__ int dinv(int d) { return (((d >> 4) & 1) << 5) | (((d >> 2) & 3) << 3) | ((d >> 5) << 2) | (d & 3); }
__device__ __forceinline__ float wave_sum(float v) {
#pragma unroll
    for (int o = 1; o < 64; o <<= 1) v += __shfl_xor(v, o);
    return v;
}
__device__ __forceinline__ float wave_max(float v) {
#pragma unroll
    for (int o = 1; o < 64; o <<= 1) v = fmaxf(v, __shfl_xor(v, o));
    return v;
}

__global__ void k_prep_rope(float2* tab) {
    const int idx = blockIdx.x * blockDim.x + threadIdx.x; if (idx >= SEQ * 32) return;
    const int pos = idx >> 5, i = idx & 31;
    const float inv = (float)pow(10000.0, -(double)i / 32.0);
    const float ang = (float)pos * inv;
    tab[idx] = make_float2((float)cos((double)ang), (float)sin((double)ang));
}
__global__ void k_prep_w1(const float* __restrict__ Win, const float* __restrict__ g, bf16_t* __restrict__ W1t, int IN, int KVW) {
    const size_t idx = (size_t)blockIdx.x * blockDim.x + threadIdx.x; if (idx >= (size_t)IN * DM) return;
    const int cp = (int)(idx / DM), k = (int)(idx % DM);
    int col = cp;
    if (cp < 1024 + KVW) col = (cp & ~63) + dmap(cp & 63);
    W1t[idx] = (bf16_t)f2bf(g[k] * Win[(size_t)k * IN + col]);
}
__global__ void k_prep_w2(const float* __restrict__ Wout, bf16_t* __restrict__ W2t) {
    const size_t idx = (size_t)blockIdx.x * blockDim.x + threadIdx.x; if (idx >= (size_t)DM * DM) return;
    const int n = (int)(idx / DM), k = (int)(idx % DM);
    W2t[idx] = (bf16_t)f2bf(Wout[(size_t)k * DM + n]);
}
__global__ void k_prep_x(const float* __restrict__ x, bf16_t* __restrict__ Hb, float* __restrict__ ss) {
    const int row = (blockIdx.x * blockDim.x + threadIdx.x) >> 6, lane = threadIdx.x & 63; if (row >= M) return;
    const f32x4* xr = (const f32x4*)(x + (size_t)row * DM) + lane; float s = 0.f;
    unsigned long long* o8 = (unsigned long long*)(Hb + (size_t)row * DM) + lane;
#pragma unroll
    for (int j = 0; j < 4; ++j) { const f32x4 v = xr[64 * j]; s += (v.x * v.x + v.y * v.y) + (v.z * v.z + v.w * v.w);
        o8[64 * j] = (unsigned long long)(f2bf(v.x) | (f2bf(v.y) << 16)) | ((unsigned long long)(f2bf(v.z) | (f2bf(v.w) << 16)) << 32); }
    s = wave_sum(s);
    if (lane < 16) ss[(size_t)row * 16 + lane] = lane == 0 ? s : 0.f;
}

template <int KVH>
__global__ __launch_bounds__(256) void k_gemm1_naive(const bf16_t* __restrict__ Hb, const bf16_t* __restrict__ W1t, const float* __restrict__ ss, const float2* __restrict__ rope,
                                                     bf16_t* __restrict__ Q, bf16_t* __restrict__ K, bf16_t* __restrict__ V, bf16_t* __restrict__ Z) {
    constexpr int KVW = KVH * 64, IN = 2048 + 2 * KVW, NG = IN / 64;
    const int wave = (int)(((size_t)blockIdx.x * 256 + threadIdx.x) >> 6), lane = threadIdx.x & 63;
    const int rt = wave / NG, cg = wave % NG; if (rt >= M / 16) return;
    const int row0 = rt * 16, lr = lane & 15, lq = lane >> 4;
    const bool rot = cg < 16 + KVH;
    f32x4 acc[4];
#pragma unroll
    for (int nb = 0; nb < 4; ++nb) acc[nb] = (f32x4){0.f, 0.f, 0.f, 0.f};
    const bf16_t* ap = Hb + (size_t)(row0 + lr) * DM + 8 * lq;
    const bf16_t* bp[4];
#pragma unroll
    for (int nb = 0; nb < 4; ++nb) { const int d = 16 * nb + lr; bp[nb] = W1t + (size_t)(cg * 64 + (rot ? dinv(d) : d)) * DM + 8 * lq; }
    for (int k0 = 0; k0 < DM; k0 += 32) {
        const bf16x8 a = *(const bf16x8*)(ap + k0);
#pragma unroll
        for (int nb = 0; nb < 4; ++nb) { const bf16x8 b = *(const bf16x8*)(bp[nb] + k0); acc[nb] = __builtin_amdgcn_mfma_f32_16x16x32_bf16(a, b, acc[nb], 0, 0, 0); }
    }
#pragma unroll
    for (int reg = 0; reg < 4; ++reg) {
        const int row = row0 + 4 * lq + reg, pos = row & (SEQ - 1);
        const f32x4* sp = (const f32x4*)(ss + (size_t)row * 16);
        const f32x4 s0 = sp[0], s1 = sp[1], s2 = sp[2], s3 = sp[3];
        const float tot = ((s0.x + s0.y) + (s0.z + s0.w)) + ((s1.x + s1.y) + (s1.z + s1.w)) + ((s2.x + s2.y) + (s2.z + s2.w)) + ((s3.x + s3.y) + (s3.z + s3.w));
        const float rstd = rsqrtf(tot * (1.0f / DM) + EPS);
        if (rot) {
            const bool isq = cg < 16; const float sc = isq ? rstd * C2 : rstd;
            bf16_t* dst = isq ? Q + (size_t)row * DM + cg * 64 : K + (size_t)row * KVW + (cg - 16) * 64;
#pragma unroll
            for (int nb = 0; nb < 2; ++nb) { const int i = 16 * nb + lr; const float2 cs = rope[pos * 32 + i];
                const float x1 = acc[nb][reg] * sc, x2 = acc[nb + 2][reg] * sc;
                dst[i] = (bf16_t)f2bf(x1 * cs.x - x2 * cs.y); dst[i + 32] = (bf16_t)f2bf(x2 * cs.x + x1 * cs.y); }
        } else {
            const bool isv = cg < 16 + 2 * KVH;
            bf16_t* dst = isv ? V + (size_t)row * KVW + (cg - 16 - KVH) * 64 : Z + (size_t)row * DM + (cg - 16 - 2 * KVH) * 64;
#pragma unroll
            for (int nb = 0; nb < 4; ++nb) dst[16 * nb + lr] = (bf16_t)f2bf(acc[nb][reg] * rstd);
        }
    }
}
__global__ void k_ksum_naive(const bf16_t* __restrict__ K, float* __restrict__ KS) {
    const int bb = blockIdx.x, c = threadIdx.x;
    float s = 0.f;
    for (int r = 0; r < MBLK; ++r) s += bf2f(K[((size_t)bb * MBLK + r) * 256 + c]);
    KS[((size_t)bb * 2 + 0) * 256 + c] = s; KS[((size_t)bb * 2 + 1) * 256 + c] = 0.f;
}

__global__ __launch_bounds__(256) void k_attn_swa_naive(const bf16_t* __restrict__ Q, const bf16_t* __restrict__ K, const bf16_t* __restrict__ V, const bf16_t* __restrict__ Z,
                                                        const float* __restrict__ sinks, bf16_t* __restrict__ G) {
    __shared__ float sh[4][64 + 128];
    const int w = threadIdx.x >> 6, lane = threadIdx.x & 63;
    const int gw = blockIdx.x * 4 + w, row = gw >> 4, h = gw & 15, t = row & (SEQ - 1), kvh = h >> 3;
    float* qs = sh[w]; float* ps = sh[w] + 64;
    qs[lane] = bf2f(Q[(size_t)row * DM + h * 64 + lane]);
    __syncthreads();
    float s[2];
#pragma unroll
    for (int r = 0; r < 2; ++r) { const int kk = lane + 64 * r; float a = -INFINITY;
        if (kk <= t) { const u32x4* kp = (const u32x4*)(K + (size_t)(row - kk) * 128 + kvh * 64); a = 0.f;
#pragma unroll
            for (int c = 0; c < 8; ++c) { const u32x4 v = kp[c];
                a += qs[8 * c + 0] * bf2f(v.x & 0xffff) + qs[8 * c + 1] * bf2f(v.x >> 16) + qs[8 * c + 2] * bf2f(v.y & 0xffff) + qs[8 * c + 3] * bf2f(v.y >> 16)
                   + qs[8 * c + 4] * bf2f(v.z & 0xffff) + qs[8 * c + 5] * bf2f(v.z >> 16) + qs[8 * c + 6] * bf2f(v.w & 0xffff) + qs[8 * c + 7] * bf2f(v.w >> 16); } }
        s[r] = a; }
    const float sinkl = sinks[h] * LOG2E;
    const float m = fmaxf(wave_max(fmaxf(s[0], s[1])), sinkl);
    const float p0 = exp2f(s[0] - m), p1 = exp2f(s[1] - m);
    const float l = wave_sum(p0 + p1) + exp2f(sinkl - m);
    ps[lane] = p0; ps[lane + 64] = p1;
    __syncthreads();
    const int nk = t + 1 < WINDOW ? t + 1 : WINDOW; float o = 0.f;
    for (int kk = 0; kk < nk; ++kk) o += ps[kk] * bf2f(V[(size_t)(row - kk) * 128 + kvh * 64 + lane]);
    o /= l;
    const float z = bf2f(Z[(size_t)row * DM + h * 64 + lane]);
    G[(size_t)row * DM + h * 64 + lane] = (bf16_t)f2bf(o * z / (1.f + __expf(-z)));
}
__global__ __launch_bounds__(256) void k_attn_moba_naive(const bf16_t* __restrict__ Q, const bf16_t* __restrict__ K, const bf16_t* __restrict__ V, const bf16_t* __restrict__ Z,
                                                         const float* __restrict__ KS, bf16_t* __restrict__ G) {
    __shared__ float sh[4][64 + 1024];
    const int w = threadIdx.x >> 6, lane = threadIdx.x & 63;
    const int gw = blockIdx.x * 4 + w, row = gw >> 4, h = gw & 15, t = row & (SEQ - 1), b = row >> 12, kvh = h >> 2, qblk = t >> 8;
    float* qs = sh[w]; float* ps = sh[w] + 64;
    qs[lane] = bf2f(Q[(size_t)row * DM + h * 64 + lane]);
    __syncthreads();
    float gate = -INFINITY;
    if (lane < qblk) { const float* k0 = KS + ((size_t)(b * NBLK + lane) * 2) * 256 + kvh * 64; const float* k1 = k0 + 256; float a = 0.f;
        for (int d = 0; d < 64; ++d) a += qs[d] * ((k0[d] + k1[d]) * (1.0f / MBLK));
        gate = a; }
    unsigned chosen = 0; const int nsel = qblk < 3 ? qblk : 3;
    for (int si = 0; si < nsel; ++si) { float best = -INFINITY; int bi = -1;
        for (int j = 0; j < qblk; ++j) { const float gj = __shfl(gate, j); if (!((chosen >> j) & 1u) && (bi < 0 || gj > best)) { best = gj; bi = j; } }
        chosen |= 1u << bi; }
    chosen |= 1u << qblk;
    float mx = -INFINITY; int nslot = 0; int blks[4] = {0, 0, 0, 0};
    for (int j = 0; j <= qblk; ++j) { if (!((chosen >> j) & 1u)) continue;
        if (nslot == 0) blks[0] = j; else if (nslot == 1) blks[1] = j; else if (nslot == 2) blks[2] = j; else blks[3] = j;
#pragma unroll
        for (int r = 0; r < 4; ++r) { const int key = j * 256 + r * 64 + lane; float a = -INFINITY;
            if (key <= t) { const u32x4* kp = (const u32x4*)(K + ((size_t)b * SEQ + key) * 256 + kvh * 64); a = 0.f;
#pragma unroll
                for (int c = 0; c < 8; ++c) { const u32x4 v = kp[c];
                    a += qs[8 * c + 0] * bf2f(v.x & 0xffff) + qs[8 * c + 1] * bf2f(v.x >> 16) + qs[8 * c + 2] * bf2f(v.y & 0xffff) + qs[8 * c + 3] * bf2f(v.y >> 16)
                       + qs[8 * c + 4] * bf2f(v.z & 0xffff) + qs[8 * c + 5] * bf2f(v.z >> 16) + qs[8 * c + 6] * bf2f(v.w & 0xffff) + qs[8 * c + 7] * bf2f(v.w >> 16); } }
            ps[nslot * 256 + r * 64 + lane] = a; mx = fmaxf(mx, a); }
        ++nslot; }
    mx = wave_max(mx);
    float l = 0.f;
    for (int i = lane; i < nslot * 256; i += 64) { const float p = exp2f(ps[i] - mx); ps[i] = p; l += p; }
    l = wave_sum(l);
    __syncthreads();
    float o = 0.f;
    for (int sl = 0; sl < nslot; ++sl) { const int j = sl == 0 ? blks[0] : sl == 1 ? blks[1] : sl == 2 ? blks[2] : blks[3];
        const bf16_t* vp = V + ((size_t)b * SEQ + j * 256) * 256 + kvh * 64 + lane; const float* pp = ps + sl * 256;
        const int nk = (j == qblk) ? (t - j * 256 + 1) : 256;
        for (int kk = 0; kk < nk; ++kk) o += pp[kk] * bf2f(vp[(size_t)kk * 256]); }
    o /= l;
    const float z = bf2f(Z[(size_t)row * DM + h * 64 + lane]);
    G[(size_t)row * DM + h * 64 + lane] = (bf16_t)f2bf(o * z / (1.f + __expf(-z)));
}

__global__ __launch_bounds__(256) void k_gemm2_naive(const bf16_t* __restrict__ Gb, const bf16_t* __restrict__ W2t, const float* hold, float* H, bf16_t* __restrict__ Hb, float* __restrict__ ss) {
    const int wave = (int)(((size_t)blockIdx.x * 256 + threadIdx.x) >> 6), lane = threadIdx.x & 63;
    const int rt = wave >> 4, cg = wave & 15; if (rt >= M / 16) return;
    const int row0 = rt * 16, lr = lane & 15, lq = lane >> 4;
    f32x4 acc[4];
#pragma unroll
    for (int nb = 0; nb < 4; ++nb) acc[nb] = (f32x4){0.f, 0.f, 0.f, 0.f};
    const bf16_t* ap = Gb + (size_t)(row0 + lr) * DM + 8 * lq;
    const bf16_t* bp = W2t + (size_t)(cg * 64 + lr) * DM + 8 * lq;
    for (int k0 = 0; k0 < DM; k0 += 32) {
        const bf16x8 a = *(const bf16x8*)(ap + k0);
#pragma unroll
        for (int nb = 0; nb < 4; ++nb) { const bf16x8 b = *(const bf16x8*)(bp + (size_t)nb * 16 * DM + k0); acc[nb] = __builtin_amdgcn_mfma_f32_16x16x32_bf16(a, b, acc[nb], 0, 0, 0); }
    }
#pragma unroll
    for (int reg = 0; reg < 4; ++reg) {
        const int row = row0 + 4 * lq + reg; float s = 0.f;
#pragma unroll
        for (int nb = 0; nb < 4; ++nb) { const size_t off = (size_t)row * DM + cg * 64 + 16 * nb + lr; const float hn = hold[off] + acc[nb][reg]; H[off] = hn; Hb[off] = (bf16_t)f2bf(hn); s += hn * hn; }
        s += __shfl_xor(s, 1); s += __shfl_xor(s, 2); s += __shfl_xor(s, 4); s += __shfl_xor(s, 8);
        if (lr == 0) ss[(size_t)row * 16 + cg] = s;
    }
}
__global__ void k_final(float* H, const float* __restrict__ fg) {
    const int row = (blockIdx.x * blockDim.x + threadIdx.x) >> 6, lane = threadIdx.x & 63; if (row >= M) return;
    f32x4* hr = (f32x4*)(H + (size_t)row * DM) + lane; const f32x4* gr = (const f32x4*)fg + lane;
    f32x4 v[4]; float s = 0.f;
#pragma unroll
    for (int j = 0; j < 4; ++j) { v[j] = hr[64 * j]; s += (v[j].x * v[j].x + v[j].y * v[j].y) + (v[j].z * v[j].z + v[j].w * v[j].w); }
    const float rstd = rsqrtf(wave_sum(s) * (1.0f / DM) + EPS);
#pragma unroll
    for (int j = 0; j < 4; ++j) hr[64 * j] = v[j] * rstd * gr[64 * j];
}


namespace pg8 {
#define PG8_LAS __attribute__((address_space(3)))
typedef unsigned short bf16_t;
typedef short bf16x8 __attribute__((ext_vector_type(8)));
typedef float f32x4 __attribute__((ext_vector_type(4)));
typedef unsigned u32x4 __attribute__((ext_vector_type(4)));
constexpr int BM = 256, BK = 64, HALF = 128, HTB = HALF * BK * 2  , STAGE_BYTES = 8 * HTB, NXCD = 8, WGM = 8;

__host__ __device__ __forceinline__ int lds_byte(int r, int c) { const int st = (r >> 4) * 2 + (c >> 5), rr = r & 15, cc = c & 31, ob = rr * 64 + cc * 2; return st * 1024 + (ob ^ (((ob >> 9) & 1) << 5)); }
__host__ __device__ __forceinline__ void stage_rc(int b, int& R, int& C) { const int st = b / 1024, sb = b % 1024, swz = sb ^ (((sb >> 9) & 1) << 5); R = (st >> 1) * 16 + swz / 64; C = (st & 1) * 32 + (swz % 64) / 2; }
__host__ __device__ __forceinline__ int perm32(int rho) { const int n = rho >> 4, i = rho & 15; return 8 * (i >> 2) + 4 * n + (i & 3); }

struct Unit { int pm, pn; };
struct Gemm { const bf16_t* A; const bf16_t* Bt; int M, N, K; };

struct StaticOrder {
    int nM, nN, nwg, G, c;
    __host__ __device__ void init(int M, int N, int G_, int c_) { nM = M / BM; nN = N / BM; nwg = nM * nN; G = G_; c = c_; }
    __host__ __device__ bool next(int i, Unit& u) const {
        const long L = (long)i * G + c; if (L >= nwg) return false;
        int wgid = (int)L; { const int q = nwg / NXCD, r = nwg % NXCD, xcd = wgid % NXCD, off = wgid / NXCD; wgid = (xcd < r ? xcd * (q + 1) : r * (q + 1) + (xcd - r) * q) + off; }
        const int nig = WGM * nN, gid = wgid / nig, fm = gid * WGM, gsz = (nM - fm) < WGM ? (nM - fm) : WGM;
        u.pm = fm + ((wgid % nig) % gsz); u.pn = (wgid % nig) / gsz; return true;
    }
    __device__ __forceinline__ void a_ready(const Unit&) const {}
    __device__ __forceinline__ void done(const Unit&) const {}
};

__device__ __forceinline__ unsigned cvt_pk_bf16(float lo, float hi) { unsigned r; asm volatile("v_cvt_pk_bf16_f32 %0, %1, %2" : "=v"(r) : "v"(lo), "v"(hi)); return r; }
typedef unsigned u32x2 __attribute__((ext_vector_type(2)));

template <int KVH> struct EpiG1 {
    static constexpr bool PERM = true, AFTER_DRAIN = false;
    bf16_t *Q, *K, *V, *Z; const float* ss; const float* rope; float* KS;
    __device__ __forceinline__ float rstd_of(int row) const {
        const f32x4* sp = (const f32x4*)(ss + (size_t)row * 16);
        const f32x4 s0 = sp[0], s1 = sp[1], s2 = sp[2], s3 = sp[3];
        const float tot = ((s0[0] + s0[1]) + (s0[2] + s0[3])) + ((s1[0] + s1[1]) + (s1[2] + s1[3])) + ((s2[0] + s2[1]) + (s2[2] + s2[3])) + ((s3[0] + s3[1]) + (s3[2] + s3[3]));
        return __builtin_amdgcn_rsqf(tot * (1.0f / 1024.0f) + 1e-5f);
    }
    __device__ __forceinline__ void operator()(const f32x4 (&acc)[2][2][4][2], const Unit& u, int wr, int wc, int fr, int fq) const {
        constexpr int KVW = KVH * 64; constexpr float C2 = 0.125f * 1.4426950408889634f;
        const int pn = u.pn, wcl = wc & 1, hp = wc >> 1;
        const int row0 = u.pm * BM + wr * 64 + fr;
        if (pn < 4 || (pn == 4 && KVH == 4)) {
            const bool isq = pn < 4;
            f32x4 ks[2][2];
#pragma unroll
            for (int bj = 0; bj < 2; ++bj) { ks[bj][0] = (f32x4){0.f, 0.f, 0.f, 0.f}; ks[bj][1] = (f32x4){0.f, 0.f, 0.f, 0.f}; }
#pragma unroll
            for (int ai = 0; ai < 2; ++ai)
#pragma unroll
                for (int m = 0; m < 4; ++m) {
                    const int row = row0 + ai * HALF + m * 16, pos = row & 4095;
                    const float rs = rstd_of(row), sc = isq ? rs * C2 : rs;
                    const f32x4* rp = (const f32x4*)(rope + ((size_t)pos * 32 + 16 * wcl + 4 * fq) * 2);
                    const f32x4 t0 = rp[0], t1 = rp[1];
                    const f32x4 cc = (f32x4){t0[0], t0[2], t1[0], t1[2]}, sn = (f32x4){t0[1], t0[3], t1[1], t1[3]};
#pragma unroll
                    for (int bj = 0; bj < 2; ++bj) {
                        const f32x4 x1 = acc[ai][bj][m][0] * sc, x2 = acc[ai][bj][m][1] * sc;
                        const f32x4 o1 = x1 * cc - x2 * sn, o2 = x2 * cc + x1 * sn;
                        bf16_t* dst = isq ? Q + (size_t)row * 1024 + (4 * pn + 2 * bj + hp) * 64 + 16 * wcl + 4 * fq : K + (size_t)row * KVW + (2 * bj + hp) * 64 + 16 * wcl + 4 * fq;
                        u32x2 w1, w2; w1.x = cvt_pk_bf16(o1[0], o1[1]); w1.y = cvt_pk_bf16(o1[2], o1[3]); w2.x = cvt_pk_bf16(o2[0], o2[1]); w2.y = cvt_pk_bf16(o2[2], o2[3]);
                        *(u32x2*)dst = w1; *(u32x2*)(dst + 32) = w2;
                        if (!isq) { ks[bj][0] += o1; ks[bj][1] += o2; }
                    }
                }
            if (!isq) {
#pragma unroll
                for (int bj = 0; bj < 2; ++bj)
#pragma unroll
                    for (int n = 0; n < 2; ++n) {
                        f32x4 v = ks[bj][n];
#pragma unroll
                        for (int j = 0; j < 4; ++j) { float s = v[j]; s += __shfl_xor(s, 1); s += __shfl_xor(s, 2); s += __shfl_xor(s, 4); s += __shfl_xor(s, 8); v[j] = s; }
                        if (fr == 0) *(f32x4*)(KS + ((size_t)(u.pm * 2 + wr)) * 256 + (2 * bj + hp) * 64 + 32 * n + 16 * wcl + 4 * fq) = v;
                    }
            }
        } else if (pn == 4) {
#pragma unroll
            for (int ai = 0; ai < 2; ++ai)
#pragma unroll
                for (int m = 0; m < 4; ++m) {
                    const int row = row0 + ai * HALF + m * 16, pos = row & 4095;
                    const float rs = rstd_of(row);
                    const f32x4* rp = (const f32x4*)(rope + ((size_t)pos * 32 + 16 * wcl + 4 * fq) * 2);
                    const f32x4 t0 = rp[0], t1 = rp[1];
                    const f32x4 cc = (f32x4){t0[0], t0[2], t1[0], t1[2]}, sn = (f32x4){t0[1], t0[3], t1[1], t1[3]};
                    { const f32x4 x1 = acc[ai][0][m][0] * rs, x2 = acc[ai][0][m][1] * rs;
                      const f32x4 o1 = x1 * cc - x2 * sn, o2 = x2 * cc + x1 * sn;
                      bf16_t* dst = K + (size_t)row * KVW + hp * 64 + 16 * wcl + 4 * fq;
                      u32x2 w1, w2; w1.x = cvt_pk_bf16(o1[0], o1[1]); w1.y = cvt_pk_bf16(o1[2], o1[3]); w2.x = cvt_pk_bf16(o2[0], o2[1]); w2.y = cvt_pk_bf16(o2[2], o2[3]);
                      *(u32x2*)dst = w1; *(u32x2*)(dst + 32) = w2; }
                    { const f32x4 v0 = acc[ai][1][m][0] * rs, v1 = acc[ai][1][m][1] * rs;
                      u32x4 w; w.x = cvt_pk_bf16(v0[0], v0[1]); w.y = cvt_pk_bf16(v0[2], v0[3]); w.z = cvt_pk_bf16(v1[0], v1[1]); w.w = cvt_pk_bf16(v1[2], v1[3]);
                      *(u32x4*)(V + (size_t)row * KVW + 32 * wc + 8 * fq) = w; }
                }
        } else {
            const bool isv = (KVH == 4 && pn == 5);
            const int zt = pn - (KVH == 4 ? 6 : 5);
#pragma unroll
            for (int ai = 0; ai < 2; ++ai)
#pragma unroll
                for (int m = 0; m < 4; ++m) {
                    const int row = row0 + ai * HALF + m * 16;
                    const float rs = rstd_of(row);
                    bf16_t* dst = isv ? V + (size_t)row * KVW + 32 * wc + 8 * fq : Z + (size_t)row * 1024 + zt * 256 + 32 * wc + 8 * fq;
#pragma unroll
                    for (int bj = 0; bj < 2; ++bj) {
                        const f32x4 v0 = acc[ai][bj][m][0] * rs, v1 = acc[ai][bj][m][1] * rs;
                        u32x4 w; w.x = cvt_pk_bf16(v0[0], v0[1]); w.y = cvt_pk_bf16(v0[2], v0[3]); w.z = cvt_pk_bf16(v1[0], v1[1]); w.w = cvt_pk_bf16(v1[2], v1[3]);
                        *(u32x4*)(dst + bj * HALF) = w;
                    }
                }
        }
    }
};
template <bool IN_F32, bool OUT_F32> struct EpiG2 {
    static constexpr bool PERM = true, AFTER_DRAIN = false;
    const float* xin; float* H; bf16_t* Hb; float* ss;
    __device__ __forceinline__ void operator()(const f32x4 (&acc)[2][2][4][2], const Unit& u, int wr, int wc, int fr, int fq) const {
        const int row0 = u.pm * BM + wr * 64 + fr, col0 = u.pn * BM + 32 * wc + 8 * fq;
#pragma unroll
        for (int ai = 0; ai < 2; ++ai) {
            f32x4 r0[4][2], r1[4][2]; u32x4 rb[4][2];
#pragma unroll
            for (int m = 0; m < 4; ++m)
#pragma unroll
                for (int bj = 0; bj < 2; ++bj) { const size_t off = (size_t)(row0 + ai * HALF + m * 16) * 1024 + col0 + bj * HALF;
                    if (IN_F32) { r0[m][bj] = *(const f32x4*)(xin + off); r1[m][bj] = *(const f32x4*)(xin + off + 4); } else rb[m][bj] = *(const u32x4*)(Hb + off); }
#pragma unroll
            for (int m = 0; m < 4; ++m) {
                const int row = row0 + ai * HALF + m * 16; float s = 0.f;
#pragma unroll
                for (int bj = 0; bj < 2; ++bj) {
                    const size_t off = (size_t)row * 1024 + col0 + bj * HALF;
                    f32x4 h0, h1;
                    if (IN_F32) { h0 = r0[m][bj]; h1 = r1[m][bj]; }
                    else { const u32x4 w = rb[m][bj]; h0 = (f32x4){__uint_as_float(w.x << 16), __uint_as_float(w.x & 0xffff0000u), __uint_as_float(w.y << 16), __uint_as_float(w.y & 0xffff0000u)};
                           h1 = (f32x4){__uint_as_float(w.z << 16), __uint_as_float(w.z & 0xffff0000u), __uint_as_float(w.w << 16), __uint_as_float(w.w & 0xffff0000u)}; }
                    const f32x4 v0 = h0 + acc[ai][bj][m][0], v1 = h1 + acc[ai][bj][m][1];
                    s += ((v0[0] * v0[0] + v0[1] * v0[1]) + (v0[2] * v0[2] + v0[3] * v0[3])) + ((v1[0] * v1[0] + v1[1] * v1[1]) + (v1[2] * v1[2] + v1[3] * v1[3]));
                    if (OUT_F32) { *(f32x4*)(H + off) = v0; *(f32x4*)(H + off + 4) = v1; }
                    else { u32x4 w; w.x = cvt_pk_bf16(v0[0], v0[1]); w.y = cvt_pk_bf16(v0[2], v0[3]); w.z = cvt_pk_bf16(v1[0], v1[1]); w.w = cvt_pk_bf16(v1[2], v1[3]); *(u32x4*)(Hb + off) = w; }
                }
                s += __shfl_xor(s, 16); s += __shfl_xor(s, 32);
                if (fq == 0) ss[(size_t)row * 16 + 4 * u.pn + wc] = s;
            }
        }
    }
};
template <class Epi, class Sched, bool ALIGN_EPI = false, bool SP2 = false>
__device__ __forceinline__ void gemm_phase(PG8_LAS unsigned char* lds, const Gemm g, const Sched& S, const Epi& E) {
    int tid_ = threadIdx.x; asm volatile("" : "+v"(tid_));
    const int tid = tid_, wid = __builtin_amdgcn_readfirstlane(tid >> 6), lane = tid & 63, wr = wid >> 2, wc = wid & 3, fr = lane & 15, fq = lane >> 4;
    const int K = g.K, nt = K / BK;
    unsigned voffA[2], voffB[2];
#pragma unroll
    for (int i = 0; i < 2; ++i) { int R, C; stage_rc(tid * 16 + i * 8192, R, C); const int Rb = Epi::PERM ? ((R & ~31) + perm32(R & 31)) : R;
        voffA[i] = (unsigned)(R * K + C) * 2u; voffB[i] = (unsigned)(Rb * K + C) * 2u; }
    const size_t kstep = (size_t)(BK * 2);
    const size_t hstep = (size_t)HALF * K * 2;
    const size_t tstep = 2 * hstep;
    const unsigned ldsw = (unsigned)wid * 1024u;
    const int aoff = lds_byte(wr * 64 + fr, fq * 8), boff = lds_byte(wc * 32 + fr, fq * 8);
#define PG8_SA(b, h) (((b) * 2 + (h)) * HTB)
#define PG8_SB(b, h) ((4 + (b) * 2 + (h)) * HTB)
#define PG8_STAGE(bufoff, gbase, voff) do { _Pragma("unroll") for (int _i = 0; _i < 2; ++_i) \
        __builtin_amdgcn_global_load_lds((const unsigned*)((const char*)(gbase) + (voff)[_i]), (PG8_LAS unsigned*)(lds + (bufoff) + ldsw + _i * 8192), 16, 0, 0); } while (0)
#define PG8_LDA(dst, b, h) do { _Pragma("unroll") for (int m = 0; m < 4; ++m) _Pragma("unroll") for (int k = 0; k < 2; ++k) dst[m][k] = *(const PG8_LAS bf16x8*)(lds + PG8_SA(b, h) + aoff + m * 2048 + k * 1024); } while (0)
#define PG8_LDB(dst, b, h) do { _Pragma("unroll") for (int n = 0; n < 2; ++n) _Pragma("unroll") for (int k = 0; k < 2; ++k) dst[n][k] = *(const PG8_LAS bf16x8*)(lds + PG8_SB(b, h) + boff + n * 2048 + k * 1024); } while (0)
#define PG8_MMA(ai, bj, At, Bt) do { __builtin_amdgcn_s_setprio(1); _Pragma("unroll") for (int m = 0; m < 4; ++m) _Pragma("unroll") for (int n = 0; n < 2; ++n) _Pragma("unroll") for (int k = 0; k < 2; ++k) \
        acc[ai][bj][m][n] = __builtin_amdgcn_mfma_f32_16x16x32_bf16(Bt[n][k], At[m][k], acc[ai][bj][m][n], 0, 0, 0); __builtin_amdgcn_s_setprio(0); } while (0)
#define PG8_WAIT_V(n) asm volatile("s_waitcnt vmcnt(" #n ")" ::: "memory")
#define PG8_WAIT_L(n) asm volatile("s_waitcnt lgkmcnt(" #n ")" ::: "memory")
#define PG8_BAR __builtin_amdgcn_s_barrier()
#define PG8_SCHED __builtin_amdgcn_sched_barrier(0)
    Unit cur, nxt; int ui = 0;
    if (!S.next(0, cur)) return;
    f32x4 acc[2][2][4][2];
#pragma unroll
    for (int a = 0; a < 2; ++a)
#pragma unroll
        for (int b = 0; b < 2; ++b)
#pragma unroll
            for (int m = 0; m < 4; ++m)
#pragma unroll
                for (int n = 0; n < 2; ++n) acc[a][b][m][n] = (f32x4){0.f, 0.f, 0.f, 0.f};
    bf16x8 At[4][2], B0[2][2], B1[2][2];
    const char* cA = (const char*)g.A + (size_t)cur.pm * tstep; const char* cB = (const char*)g.Bt + (size_t)cur.pn * tstep;
    S.a_ready(cur);
    if constexpr (SP2) {
        PG8_STAGE(PG8_SB(0, 0), cB, voffB); PG8_STAGE(PG8_SB(0, 1), cB + hstep, voffB); PG8_STAGE(PG8_SA(0, 0), cA, voffA); PG8_STAGE(PG8_SA(0, 1), cA + hstep, voffA);
        if (wr == 1) PG8_BAR;
        PG8_WAIT_V(2); PG8_BAR;
        PG8_STAGE(PG8_SB(1, 0), cB + kstep, voffB); PG8_STAGE(PG8_SA(1, 0), cA + kstep, voffA); PG8_STAGE(PG8_SB(1, 1), cB + hstep + kstep, voffB);
        PG8_WAIT_V(6); PG8_BAR;
    } else {
        PG8_STAGE(PG8_SB(0, 0), cB, voffB); PG8_STAGE(PG8_SA(0, 0), cA, voffA); PG8_STAGE(PG8_SB(0, 1), cB + hstep, voffB); PG8_STAGE(PG8_SA(0, 1), cA + hstep, voffA);
        if (wr == 1) PG8_BAR;
        PG8_WAIT_V(4); PG8_BAR;
        PG8_STAGE(PG8_SB(1, 0), cB + kstep, voffB); PG8_STAGE(PG8_SA(1, 0), cA + kstep, voffA); PG8_STAGE(PG8_SB(1, 1), cB + hstep + kstep, voffB);
        PG8_WAIT_V(6); PG8_BAR;
    }
    for (;;) {
        const bool has_next = S.next(ui + 1, nxt);
        const char* nA = has_next ? (const char*)g.A + (size_t)nxt.pm * tstep : cA; const char* nB = has_next ? (const char*)g.Bt + (size_t)nxt.pn * tstep : cB;
        for (int t = 0; t < nt; t += 2) {
            const bool last = (t == nt - 2);
            const char* a1 = cA + (size_t)(t + 1) * kstep;
            const char* a2 = last ? nA : cA + (size_t)(t + 2) * kstep; const char* b2 = last ? nB : cB + (size_t)(t + 2) * kstep;
            const char* a3 = a2 + kstep; const char* b3 = b2 + kstep;
            if (last && has_next) S.a_ready(nxt);
            if constexpr (SP2) {
            PG8_LDB(B0, 0, 0); PG8_LDB(B1, 0, 1); PG8_SCHED; PG8_LDA(At, 0, 0); PG8_STAGE(PG8_SA(1, 1), a1 + hstep, voffA);
            PG8_WAIT_V(8); PG8_WAIT_L(0); PG8_BAR; PG8_MMA(0, 0, At, B0); PG8_MMA(0, 1, At, B1); PG8_BAR; PG8_SCHED;
            PG8_LDA(At, 0, 1); PG8_STAGE(PG8_SB(0, 0), b2, voffB); PG8_STAGE(PG8_SB(0, 1), b2 + hstep, voffB); PG8_STAGE(PG8_SA(0, 0), a2, voffA);
            PG8_WAIT_V(8); PG8_WAIT_L(0); PG8_BAR; PG8_MMA(1, 0, At, B0); PG8_MMA(1, 1, At, B1); PG8_BAR; PG8_SCHED;
            PG8_LDB(B0, 1, 0); PG8_LDB(B1, 1, 1); PG8_SCHED; PG8_LDA(At, 1, 0); PG8_STAGE(PG8_SA(0, 1), a2 + hstep, voffA);
            PG8_WAIT_V(8); PG8_WAIT_L(0); PG8_BAR; PG8_MMA(0, 0, At, B0); PG8_MMA(0, 1, At, B1); PG8_BAR; PG8_SCHED;
            PG8_LDA(At, 1, 1); PG8_STAGE(PG8_SB(1, 0), b3, voffB); PG8_STAGE(PG8_SB(1, 1), b3 + hstep, voffB); PG8_STAGE(PG8_SA(1, 0), a3, voffA);
            PG8_WAIT_V(8); PG8_WAIT_L(0); PG8_BAR; PG8_MMA(1, 0, At, B0); PG8_MMA(1, 1, At, B1); PG8_BAR; PG8_SCHED;
            } else {
            PG8_LDB(B0, 0, 0); PG8_SCHED; PG8_LDA(At, 0, 0); PG8_STAGE(PG8_SA(1, 1), a1 + hstep, voffA);
            PG8_WAIT_L(8); PG8_BAR; PG8_WAIT_L(0); PG8_MMA(0, 0, At, B0); PG8_BAR; PG8_SCHED;
            PG8_LDB(B1, 0, 1); PG8_STAGE(PG8_SB(0, 0), b2, voffB);
            PG8_BAR; PG8_WAIT_L(0); PG8_MMA(0, 1, At, B1); PG8_BAR;
            PG8_LDA(At, 0, 1); PG8_STAGE(PG8_SA(0, 0), a2, voffA);
            PG8_BAR; PG8_WAIT_L(0); PG8_MMA(1, 0, At, B0); PG8_BAR; PG8_SCHED;
            PG8_STAGE(PG8_SB(0, 1), b2 + hstep, voffB);
            PG8_WAIT_V(6); PG8_BAR; PG8_MMA(1, 1, At, B1); PG8_BAR;
            PG8_LDB(B0, 1, 0); PG8_SCHED; PG8_LDA(At, 1, 0); PG8_STAGE(PG8_SA(0, 1), a2 + hstep, voffA);
            PG8_WAIT_L(8); PG8_BAR; PG8_WAIT_L(0); PG8_MMA(0, 0, At, B0); PG8_BAR; PG8_SCHED;
            PG8_LDB(B1, 1, 1); PG8_STAGE(PG8_SB(1, 0), b3, voffB);
            PG8_BAR; PG8_WAIT_L(0); PG8_MMA(0, 1, At, B1); PG8_BAR;
            PG8_LDA(At, 1, 1); PG8_STAGE(PG8_SA(1, 0), a3, voffA);
            PG8_BAR; PG8_WAIT_L(0); PG8_MMA(1, 0, At, B0); PG8_BAR; PG8_SCHED;
            PG8_STAGE(PG8_SB(1, 1), b3 + hstep, voffB);
            PG8_WAIT_V(6); PG8_BAR; PG8_MMA(1, 1, At, B1); PG8_BAR;
            }
        }
        if constexpr (ALIGN_EPI) { if (wr == 0) PG8_BAR; }
        if constexpr (!Epi::AFTER_DRAIN) { E(acc, cur, wr, wc, fr, fq); S.done(cur); }
        if (!has_next) break;
#pragma unroll
        for (int a = 0; a < 2; ++a)
#pragma unroll
            for (int b = 0; b < 2; ++b)
#pragma unroll
                for (int m = 0; m < 4; ++m)
#pragma unroll
                    for (int n = 0; n < 2; ++n) acc[a][b][m][n] = (f32x4){0.f, 0.f, 0.f, 0.f};
        cur = nxt; cA = nA; cB = nB; ++ui;
        if constexpr (ALIGN_EPI) { if (wr == 1) PG8_BAR; }
    }
    PG8_WAIT_V(0);
    if constexpr (!ALIGN_EPI) { if (wr == 0) PG8_BAR; }
    PG8_BAR;
    if constexpr (Epi::AFTER_DRAIN) { E.fused(acc, cur, wr, wc, fr, fq, lds, wid, lane); S.done(cur); }
#undef PG8_SA
#undef PG8_SB
#undef PG8_STAGE
#undef PG8_LDA
#undef PG8_LDB
#undef PG8_MMA
#undef PG8_WAIT_V
#undef PG8_WAIT_L
#undef PG8_BAR
#undef PG8_SCHED
}
}

namespace attn_body {
using bf16=unsigned short;
using bf16x8=__attribute__((ext_vector_type(8)))short;
using s16x4=__attribute__((ext_vector_type(4)))short;
using f32x16=__attribute__((ext_vector_type(16)))float;
using u32x4=__attribute__((ext_vector_type(4)))unsigned;
constexpr int ASEQ=4096,D=64,ADM=1024;
constexpr int NW=8,QBLK=32,QB=QBLK*NW,KVBLK=64;
__device__ __forceinline__ int crow(int r,int hi){return (r&3)+8*(r>>2)+4*hi;}
#define SBAR() __builtin_amdgcn_sched_barrier(0)
__device__ __forceinline__ void cmask(f32x16&p0,f32x16&p1,int jb,int qrel,int hi){
  const float NEG=-INFINITY; int kb=qrel-(64*jb+4*hi); asm volatile("":"+v"(kb));
  #pragma unroll
  for(int r=0;r<16;++r){const int c=(r&3)+8*(r>>2); if(c>kb)p0[r]=NEG; if(c+32>kb)p1[r]=NEG;}
}
__device__ __forceinline__ void wmask(f32x16&p0,f32x16&p1,int delta,int hi){
  const float NEG=-INFINITY; int d0=delta-4*hi; asm volatile("":"+v"(d0));
  #pragma unroll
  for(int r=0;r<16;++r){const int dd=d0-((r&3)+8*(r>>2)); if((unsigned)dd>=128u)p0[r]=NEG; if((unsigned)(dd-32)>=128u)p1[r]=NEG;}
}

constexpr int NSLOT=3, SLOTB=8192;
constexpr int LDS_K=0, LDS_V=NSLOT*SLOTB, LDS_WS=2*NSLOT*SLOTB, LDS_OST=LDS_WS+NW*64*4, LDS_KM=LDS_OST+NW*8192, LDS_BYTES=LDS_KM+4096;
__device__ __forceinline__ void glds16(const void*sbase,unsigned voff,unsigned lds_dst){unsigned keep;
  asm volatile("s_nop 4\n\ts_mov_b32 %0, m0\n\ts_mov_b32 m0, %2\n\ts_nop 0\n\tglobal_load_lds_dwordx4 %1, %3\n\ts_mov_b32 m0, %0":"=&s"(keep):"v"(voff),"s"(lds_dst),"s"(sbase):"memory");}
__device__ __forceinline__ float max3f(float a,float b,float c){float r;asm("v_max3_f32 %0, %1, %2, %3":"=v"(r):"v"(a),"v"(b),"v"(c));return r;}
__device__ __forceinline__ float max2f(float a,float b){float r;asm("v_max_f32_e32 %0, %1, %2":"=v"(r):"v"(a),"v"(b));return r;}
__device__ __forceinline__ float fadd_s(float a,float b){float r;asm("v_add_f32_e32 %0, %1, %2":"=v"(r):"v"(a),"v"(b));return r;}
__device__ __forceinline__ float fsub_s(float a,float b){float r;asm("v_sub_f32_e32 %0, %1, %2":"=v"(r):"v"(a),"v"(b));return r;}
typedef float f32x2_t __attribute__((ext_vector_type(2))); typedef __bf16 bf16x2_t __attribute__((ext_vector_type(2)));
__device__ __forceinline__ unsigned cvtpk_s(float lo,float hi){f32x2_t v={lo,hi};bf16x2_t b=__builtin_convertvector(v,bf16x2_t);return __builtin_bit_cast(unsigned,b);}
#define WAIT_BAR(N) asm volatile("s_waitcnt vmcnt(" #N ") lgkmcnt(0)\n\ts_barrier":::"memory")

__device__ __forceinline__ void qkt(f32x16&p0,f32x16&p1,const char*Kslot,const bf16x8*qr,const f32x16&negm,int r32,int hi){
  const char*kb=Kslot+hi*1024+r32*16;
  #pragma unroll
  for(int d0=0;d0<4;++d0){
    const bf16x8 b0=*reinterpret_cast<const bf16x8*>(kb+d0*2048);
    const bf16x8 b1=*reinterpret_cast<const bf16x8*>(kb+d0*2048+512);
    if(d0==0){p0=__builtin_amdgcn_mfma_f32_32x32x16_bf16(b0,qr[0],negm,0,0,0);p1=__builtin_amdgcn_mfma_f32_32x32x16_bf16(b1,qr[0],negm,0,0,0);}
    else{p0=__builtin_amdgcn_mfma_f32_32x32x16_bf16(b0,qr[d0],p0,0,0,0);p1=__builtin_amdgcn_mfma_f32_32x32x16_bf16(b1,qr[d0],p1,0,0,0);}}
}
typedef __attribute__((address_space(3))) const char* lds_cptr;
typedef short v4i16_t __attribute__((ext_vector_type(4)));
__device__ __forceinline__ void kload8(bf16x8*kf,lds_cptr kp){
  kf[0]=*(const __attribute__((address_space(3))) bf16x8*)(kp);      kf[1]=*(const __attribute__((address_space(3))) bf16x8*)(kp+512);
  kf[2]=*(const __attribute__((address_space(3))) bf16x8*)(kp+2048); kf[3]=*(const __attribute__((address_space(3))) bf16x8*)(kp+2560);
  kf[4]=*(const __attribute__((address_space(3))) bf16x8*)(kp+4096); kf[5]=*(const __attribute__((address_space(3))) bf16x8*)(kp+4608);
  kf[6]=*(const __attribute__((address_space(3))) bf16x8*)(kp+6144); kf[7]=*(const __attribute__((address_space(3))) bf16x8*)(kp+6656);
}
__device__ __forceinline__ void kload2(bf16x8*kf,lds_cptr kp,int j){ kf[2*j]=*(const __attribute__((address_space(3))) bf16x8*)(kp+j*2048); kf[2*j+1]=*(const __attribute__((address_space(3))) bf16x8*)(kp+j*2048+512); }
__device__ __forceinline__ s16x4 vtr(lds_cptr p){ return __builtin_bit_cast(s16x4,__builtin_amdgcn_ds_read_tr16_b64_v4i16((__attribute__((address_space(3))) v4i16_t*)p)); }
__device__ __forceinline__ float rowmax(const f32x16&p0,const f32x16&p1){
  float a=max3f(p0[0],p0[1],p1[0]),b=max3f(p0[2],p0[3],p1[1]);a=max3f(a,p1[2],p1[3]);
  #pragma unroll
  for(int r=4;r<16;r+=4){a=max3f(a,p0[r],p0[r+1]);b=max3f(b,p0[r+2],p0[r+3]);a=max3f(a,p1[r],p1[r+1]);b=max3f(b,p1[r+2],p1[r+3]);}
  const float m=max2f(a,b);
  auto rr=__builtin_amdgcn_permlane32_swap(__float_as_uint(m),__float_as_uint(m),false,false);
  return max2f(__uint_as_float(rr[0]),__uint_as_float(rr[1]));
}
__device__ __forceinline__ void pv(f32x16*o,int vb,bf16x8 pa0,bf16x8 pa1,bf16x8 pa2,bf16x8 pa3){
  #pragma unroll
  for(int d0=0;d0<2;++d0){s16x4 lo[4],hi[4];
    #pragma unroll
    for(int ks=0;ks<4;++ks){
      asm volatile("ds_read_b64_tr_b16 %0,%1 offset:%c2":"=&v"(lo[ks]):"v"(vb),"i"(d0*4096+ks*1024):"memory");
      asm volatile("ds_read_b64_tr_b16 %0,%1 offset:%c2":"=&v"(hi[ks]):"v"(vb),"i"(d0*4096+ks*1024+512):"memory");}
    asm volatile("s_waitcnt lgkmcnt(0)":::"memory");SBAR();
    #define PK(k) (bf16x8){lo[k][0],lo[k][1],lo[k][2],lo[k][3],hi[k][0],hi[k][1],hi[k][2],hi[k][3]}
    o[d0]=__builtin_amdgcn_mfma_f32_32x32x16_bf16(pa0,PK(0),o[d0],0,0,0);
    o[d0]=__builtin_amdgcn_mfma_f32_32x32x16_bf16(pa1,PK(1),o[d0],0,0,0);
    o[d0]=__builtin_amdgcn_mfma_f32_32x32x16_bf16(pa2,PK(2),o[d0],0,0,0);
    o[d0]=__builtin_amdgcn_mfma_f32_32x32x16_bf16(pa3,PK(3),o[d0],0,0,0);
    #undef PK
  }
}

template<int MODE,int THRL> __device__ __forceinline__ void attn_unit(int b,int h,int qb,const bf16*Q,const bf16*__restrict__ K,const bf16*__restrict__ V,const bf16*__restrict__ Z,bf16*G,const float*__restrict__ aux,char*shm){
  constexpr int KVW=MODE?256:128;
  const int kvh=MODE?(h>>2):(h>>3);
  int tid_=threadIdx.x; asm volatile("":"+v"(tid_));
  const int tid=tid_,lane=tid&63,r32=lane&31,hi=lane>>5; const int wid=__builtin_amdgcn_readfirstlane(tid>>6);
  const int hw=MODE?h:h+(wid>>2), wrow=MODE?wid*QBLK:(wid&3)*QBLK;
  const long rowbase=(long)b*ASEQ; const int q0=MODE?qb*QB:qb*128;
  const bf16*Qw=Q+(rowbase+q0+wrow)*ADM+hw*D;
  const bf16*Kh=K+rowbase*KVW+kvh*D,*Vh=V+rowbase*KVW+kvh*D;
  const unsigned lds0=(unsigned)(uintptr_t)shm;
  float*wsf=(float*)(shm+LDS_WS)+wid*64;
  const int NT=MODE?(4*qb+4):4;
  const int ktA=MODE?(4*qb):(qb?2*qb-2:0);
  #define KT(s) (MODE?(((s)<4)?(ktA+(s)):((s)-4)):(ktA+(s)))
  if(MODE){ float*km=(float*)(shm+LDS_KM); const float*ks=aux+((size_t)(b*16)*2)*256+kvh*64;
    for(int idx=tid;idx<qb*64;idx+=512){const int j=idx>>6,d=idx&63; km[idx]=(ks[(size_t)(2*j)*256+d]+ks[(size_t)(2*j+1)*256+d])*(1.0f/256.0f);} }
  const unsigned kvoff=(unsigned)(lane*KVW+wid*8)*2u;
  const unsigned vvoff=(unsigned)((16*(wid&3)+(lane>>2))*KVW+(wid>>2)*32+(lane&3)*8)*2u;
  const unsigned kdst=lds0+LDS_K+wid*1024, vdst=lds0+LDS_V+wid*1024;
  #define DMA_K(s,slot) glds16(Kh+(long)KT(s)*KVBLK*KVW,kvoff,(unsigned)__builtin_amdgcn_readfirstlane(kdst+(slot)))
  #define DMA_V(s,slot) glds16(Vh+(long)KT(s)*KVBLK*KVW,vvoff,(unsigned)__builtin_amdgcn_readfirstlane(vdst+(slot)))
  const int vb0=(int)(lds0+LDS_V)+((lane>>4)&1)*32+(lane&3)*8+(4*hi+((lane&15)>>2))*64;
  const char*Kbase=shm+LDS_K; bf16x8 kf[8];
  const lds_cptr shm3=(lds_cptr)shm; const lds_cptr kp0=shm3+LDS_K+hi*1024+r32*16; const lds_cptr vp0=shm3+LDS_V+((lane>>4)&1)*32+(lane&3)*8+(4*hi+((lane&15)>>2))*64;
  DMA_K(0,0);DMA_V(0,0);DMA_K(1,SLOTB);
  bf16x8 qr[4];
  #pragma unroll
  for(int d0=0;d0<4;++d0)qr[d0]=*reinterpret_cast<const bf16x8*>(&Qw[(long)r32*ADM+d0*16+hi*8]);
  float mhat=0.f,l_reg=0.f;f32x16 o[2];o[0]=f32x16{};o[1]=f32x16{};
  const f32x16 zc=f32x16{};
  const int qrel=wrow+r32;
  #define AMASK(P0,P1,s) do{ if(MODE){ if((s)<4)cmask(P0,P1,(s),qrel,hi); } else { wmask(P0,P1,q0+qrel-64*KT(s),hi); } }while(0)
  bool resc=false; unsigned selmask=0u; unsigned pm_=0xffffffffu;
  #define PMOF(s) ((MODE&&(s)>=4)?((((selmask>>((((s)-4)>>2)&31))&1u)!=0u)?0xffffffffu:0u):0xffffffffu)
  #define RESC() do{ if(resc){ asm volatile("s_waitcnt lgkmcnt(0)":::"memory"); \
      _Pragma("unroll") for(int d_=0;d_<2;++d_) _Pragma("unroll") for(int r=0;r<16;++r)o[d_][r]*=wsf[crow(r,hi)]; } }while(0)
  #define REFUPD(C0,C1,rm,LOWOK) do{ resc=false; \
      const float gr_=rm-mhat; \
      if(__builtin_expect(__any((gr_>(float)THRL)||((LOWOK)&&(rm<-60.f)&&(rm>-INFINITY))),0)){ \
        const float dl=((LOWOK)&&(rm<-60.f)&&(rm>-INFINITY))?gr_:__builtin_fmaxf(gr_,0.f); mhat+=dl; \
        const float f=__builtin_amdgcn_exp2f(-dl); l_reg*=f; if(hi==0)wsf[r32]=f; resc=true; } \
      if(__builtin_expect(__any(mhat!=0.f),0)){ _Pragma("unroll") for(int r=0;r<16;++r){C0[r]-=mhat;C1[r]-=mhat;} } }while(0)
  f32x16 pA0,pA1,pB0,pB1;
  int sl_prev=0,sl_cur=0,sl_next=SLOTB;
  #define ROT() do{sl_prev=sl_cur;sl_cur=sl_next;sl_next=(sl_next==(NSLOT-1)*SLOTB)?0:sl_next+SLOTB;}while(0)
  DMA_K(2,2*SLOTB);
  WAIT_BAR(3);
  SBAR();
  if(MODE){
    const float*km=(const float*)(shm+LDS_KM)+8*hi; float qf[32];
    #pragma unroll
    for(int d0=0;d0<4;++d0){
      #pragma unroll
      for(int e=0;e<8;++e)qf[d0*8+e]=__uint_as_float(((unsigned)(unsigned short)qr[d0][e])<<16);}
    float v1=-INFINITY,v2=-INFINITY,v3=-INFINITY; unsigned b1=0u,b2=0u,b3=0u;
    for(int j=0;j<qb;++j){ const float*kp=km+j*64; float g=0.f;
      #pragma unroll
      for(int d0=0;d0<4;++d0){
        #pragma unroll
        for(int e=0;e<8;++e)g+=qf[d0*8+e]*kp[16*d0+e];}
      g+=__shfl_xor(g,32);
      const unsigned bj=1u<<j; const bool c1=g>v1,c2=g>v2,c3=g>v3;
      v3=c2?v2:(c3?g:v3); b3=c2?b2:(c3?bj:b3);
      v2=c1?v1:(c2?g:v2); b2=c1?b1:(c2?bj:b2);
      v1=c1?g:v1;         b1=c1?bj:b1; }
    selmask=b1|b2|b3; asm volatile("":"+v"(selmask)); }
  SBAR();
  qkt(pA0,pA1,Kbase,qr,zc,r32,hi);asm volatile("s_nop 15\n\ts_nop 7":"+v"(pA0),"+v"(pA1));AMASK(pA0,pA1,0);
  { const float rm0=rowmax(pA0,pA1); REFUPD(pA0,pA1,rm0,true); }
  _Pragma("unroll") for(int r=0;r<16;++r)pA0[r]=__builtin_amdgcn_exp2f(pA0[r]);
  _Pragma("unroll") for(int r=0;r<16;++r)pA1[r]=__builtin_amdgcn_exp2f(pA1[r]);
  WAIT_BAR(0);
  DMA_K(3,0);DMA_V(1,SLOTB);
  ROT();
  kload8(kf,kp0+sl_cur);
  WAIT_BAR(2);
  s16x4 vlo[8],vhi[8]; u32x4 pw0,pw1,pw2,pw3;
  #define PKW(P,B) (MODE?(cvtpk_s(P[B],P[B+1])&pm_):cvtpk_s(P[B],P[B+1]))
  #define PAF(k) __builtin_bit_cast(bf16x8,pw##k)
  #define VFR(i) (bf16x8){vlo[i][0],vlo[i][1],vlo[i][2],vlo[i][3],vhi[i][0],vhi[i][1],vhi[i][2],vhi[i][3]}
  #define PIN(x) asm volatile("":"+v"(x))
  #define MX3(a,b,c) __builtin_fmaxf(__builtin_fmaxf((a),(b)),(c))
  #define GAPA(MF,A0,A1,A2,A3,W0,W1,PW) do{ MF; sacc+=A0; sacc+=A1; sacc+=A2; sacc+=A3; PIN(sacc); W0; W1; PIN(PW); SBAR(); }while(0)
  #define EX(v) __builtin_amdgcn_exp2f(v)
  #define GAPB(MF,X,B) do{ MF; X[B]=EX(X[B]); X[B+1]=EX(X[B+1]); X[B+2]=EX(X[B+2]); X[B+3]=EX(X[B+3]); PIN(X); SBAR(); }while(0)
  #define VRD(i) do{ vlo[i]=vtr(vp_+(((i)>>2)*4096+((i)&3)*1024)); vhi[i]=vtr(vp_+(((i)>>2)*4096+((i)&3)*1024+512)); }while(0)
  #define KRD(G,j) do{ if(G){ kload2(kf,kp0+sl_next,j); SBAR(); } }while(0)
  #define STEP(C0,C1,P0,P1,t,GK,GV,GL) do{ SBAR(); \
    const lds_cptr vp_=vp0+sl_prev; \
    VRD(0); SBAR(); float sacc=(P0[0]+P0[1]); \
    GAPA(C0=__builtin_amdgcn_mfma_f32_32x32x16_bf16(kf[0],qr[0],zc,0,0,0), P0[2],P0[3],P0[4],P0[5],     pw0[0]=PKW(P0,0), pw0[1]=PKW(P0,2), pw0); \
    VRD(4); SBAR(); GAPA(C1=__builtin_amdgcn_mfma_f32_32x32x16_bf16(kf[1],qr[0],zc,0,0,0), P0[6],P0[7],P0[8],P0[9],     pw0[2]=PKW(P0,4), pw0[3]=PKW(P0,6), pw0); \
    VRD(1); SBAR(); GAPA(C0=__builtin_amdgcn_mfma_f32_32x32x16_bf16(kf[2],qr[1],C0,0,0,0),   P0[10],P0[11],P0[12],P0[13], pw1[0]=PKW(P0,8), pw1[1]=PKW(P0,10), pw1); \
    VRD(5); SBAR(); GAPA(C1=__builtin_amdgcn_mfma_f32_32x32x16_bf16(kf[3],qr[1],C1,0,0,0),   P0[14],P0[15],P1[0],P1[1],   pw1[2]=PKW(P0,12),pw1[3]=PKW(P0,14), pw1); \
    VRD(2); SBAR(); GAPA(C0=__builtin_amdgcn_mfma_f32_32x32x16_bf16(kf[4],qr[2],C0,0,0,0),   P1[2],P1[3],P1[4],P1[5],     pw2[0]=PKW(P1,0), pw2[1]=PKW(P1,2), pw2); \
    VRD(6); SBAR(); GAPA(C1=__builtin_amdgcn_mfma_f32_32x32x16_bf16(kf[5],qr[2],C1,0,0,0),   P1[6],P1[7],P1[8],P1[9],     pw2[2]=PKW(P1,4), pw2[3]=PKW(P1,6), pw2); \
    VRD(3); SBAR(); GAPA(C0=__builtin_amdgcn_mfma_f32_32x32x16_bf16(kf[6],qr[3],C0,0,0,0),   P1[10],P1[11],P1[12],P1[13], pw3[0]=PKW(P1,8), pw3[1]=PKW(P1,10), pw3); \
    VRD(7); SBAR(); GAPA(C1=__builtin_amdgcn_mfma_f32_32x32x16_bf16(kf[7],qr[3],C1,0,0,0),   P1[14],P1[15],0.f,0.f,       pw3[2]=PKW(P1,12),pw3[3]=PKW(P1,14), pw3); \
    l_reg+=(MODE?(pm_?sacc:0.f):sacc); \
    if(GK){DMA_K((t)+3,sl_cur);} if(GV){DMA_V((t)+1,sl_next);} \
    AMASK(C0,C1,t); \
    { float a=MX3(C0[0],C0[1],C1[0]),b=MX3(C0[2],C0[3],C1[1]); a=MX3(a,C1[2],C1[3]); \
      _Pragma("unroll") for(int r=4;r<16;r+=4){a=MX3(a,C0[r],C0[r+1]);b=MX3(b,C0[r+2],C0[r+3]);a=MX3(a,C1[r],C1[r+1]);b=MX3(b,C1[r+2],C1[r+3]);} \
      float rm=__builtin_fmaxf(a,b); { auto rr=__builtin_amdgcn_permlane32_swap(__float_as_uint(rm),__float_as_uint(rm),false,false); rm=__builtin_fmaxf(__uint_as_float(rr[0]),__uint_as_float(rr[1])); } \
      pm_=PMOF(t); if(MODE){ rm=pm_?rm:-INFINITY; } \
      REFUPD(C0,C1,rm,false); } \
    SBAR(); \
    GAPB(o[0]=__builtin_amdgcn_mfma_f32_32x32x16_bf16(PAF(0),VFR(0),o[0],0,0,0), C0,0); \
    GAPB(o[1]=__builtin_amdgcn_mfma_f32_32x32x16_bf16(PAF(0),VFR(4),o[1],0,0,0), C0,4); \
    KRD(GL,0); GAPB(o[0]=__builtin_amdgcn_mfma_f32_32x32x16_bf16(PAF(1),VFR(1),o[0],0,0,0), C0,8); \
    KRD(GL,1); GAPB(o[1]=__builtin_amdgcn_mfma_f32_32x32x16_bf16(PAF(1),VFR(5),o[1],0,0,0), C0,12); \
    KRD(GL,2); GAPB(o[0]=__builtin_amdgcn_mfma_f32_32x32x16_bf16(PAF(2),VFR(2),o[0],0,0,0), C1,0); \
    KRD(GL,3); GAPB(o[1]=__builtin_amdgcn_mfma_f32_32x32x16_bf16(PAF(2),VFR(6),o[1],0,0,0), C1,4); \
    GAPB(o[0]=__builtin_amdgcn_mfma_f32_32x32x16_bf16(PAF(3),VFR(3),o[0],0,0,0), C1,8); \
    GAPB(o[1]=__builtin_amdgcn_mfma_f32_32x32x16_bf16(PAF(3),VFR(7),o[1],0,0,0), C1,12); \
    }while(0)
  int t=1;
  for(;t+5<NT;t+=2){
    STEP(pB0,pB1,pA0,pA1,t,true,true,true);     WAIT_BAR(2); RESC(); ROT();
    STEP(pA0,pA1,pB0,pB1,t+1,true,true,true);   WAIT_BAR(2); RESC(); ROT();
  }
  #define ENDW(tt) do{ if((tt)+3<NT){WAIT_BAR(2);} else if((tt)+2<NT){WAIT_BAR(1);} else {WAIT_BAR(0);} }while(0)
  for(;t+1<NT;t+=2){
    STEP(pB0,pB1,pA0,pA1,t,(t+3<NT),(t+1<NT),(t+1<NT));       ENDW(t);   RESC(); ROT();
    STEP(pA0,pA1,pB0,pB1,t+1,(t+4<NT),(t+2<NT),(t+2<NT));     ENDW(t+1); RESC(); ROT();
  }
  STEP(pB0,pB1,pA0,pA1,NT-1,false,false,false); RESC();
  { float sacc=pB0[0]+pB0[1]; _Pragma("unroll") for(int r=2;r<16;++r)sacc+=pB0[r]; _Pragma("unroll") for(int r=0;r<16;++r)sacc+=pB1[r]; l_reg+=(MODE?(pm_?sacc:0.f):sacc);
    pw0=(u32x4){PKW(pB0,0),PKW(pB0,2),PKW(pB0,4),PKW(pB0,6)};pw1=(u32x4){PKW(pB0,8),PKW(pB0,10),PKW(pB0,12),PKW(pB0,14)};pw2=(u32x4){PKW(pB1,0),PKW(pB1,2),PKW(pB1,4),PKW(pB1,6)};pw3=(u32x4){PKW(pB1,8),PKW(pB1,10),PKW(pB1,12),PKW(pB1,14)};
    SBAR(); pv(o,vb0+sl_cur,PAF(0),PAF(1),PAF(2),PAF(3)); }
  #undef PKW
  #undef PAF
  #undef VFR
  #undef PIN
  #undef MX3
  #undef GAPA
  #undef GAPB
  #undef EX
  #undef VRD
  #undef KRD
  #undef STEP
  #undef ENDW
  {auto rr=__builtin_amdgcn_permlane32_swap(__float_as_uint(l_reg),__float_as_uint(l_reg),false,false);l_reg=__uint_as_float(rr[0])+__uint_as_float(rr[1]);}
  if(!MODE)l_reg+=__builtin_amdgcn_exp2f(aux[hw]*1.4426950408889634f-mhat);
  long grow0=rowbase+q0+wrow; asm volatile("":"+v"(grow0));
  u32x4 zv[4];
  #pragma unroll
  for(int i=0;i<4;++i){const int row=i*8+(lane>>3),ch=lane&7; zv[i]=*(const u32x4*)(Z+(grow0+row)*ADM+hw*D+ch*8);}
  if(hi==0)wsf[32+r32]=l_reg;asm volatile("s_waitcnt lgkmcnt(0)":::"memory");
  float rli[16];
  #pragma unroll
  for(int r=0;r<16;++r)rli[r]=__builtin_amdgcn_rcpf(wsf[32+crow(r,hi)]);
  { float*stg=(float*)(shm+LDS_OST)+wid*2048;
    #pragma unroll
    for(int r=0;r<16;++r){const int orow=crow(r,hi);
      #pragma unroll
      for(int d0=0;d0<2;++d0)stg[orow*64+d0*32+r32]=o[d0][r]*rli[r];}
    asm volatile("s_waitcnt lgkmcnt(0)":::"memory");
    #pragma unroll
    for(int i=0;i<4;++i){const int row=i*8+(lane>>3),ch=lane&7; const f32x4 a0=*(const f32x4*)(stg+row*64+ch*8),a1=*(const f32x4*)(stg+row*64+ch*8+4);
      float zf[8]; zf[0]=__uint_as_float(zv[i].x<<16);zf[1]=__uint_as_float(zv[i].x&0xffff0000u);zf[2]=__uint_as_float(zv[i].y<<16);zf[3]=__uint_as_float(zv[i].y&0xffff0000u);
      zf[4]=__uint_as_float(zv[i].z<<16);zf[5]=__uint_as_float(zv[i].z&0xffff0000u);zf[6]=__uint_as_float(zv[i].w<<16);zf[7]=__uint_as_float(zv[i].w&0xffff0000u);
      float gv[8];
      #pragma unroll
      for(int e=0;e<8;++e){const float ov=e<4?a0[e]:a1[e-4]; gv[e]=ov*zf[e]*__builtin_amdgcn_rcpf(1.0f+__builtin_amdgcn_exp2f(-1.4426950408889634f*zf[e]));}
      u32x4 w; w.x=cvtpk_s(gv[0],gv[1]);w.y=cvtpk_s(gv[2],gv[3]);w.z=cvtpk_s(gv[4],gv[5]);w.w=cvtpk_s(gv[6],gv[7]);
      *(u32x4*)(G+(grow0+row)*ADM+hw*D+ch*8)=w;} }
  asm volatile("s_waitcnt lgkmcnt(0)\n\ts_barrier":::"memory");
  #undef DMA_K
  #undef DMA_V
  #undef KT
  #undef AMASK
  #undef PMOF
  #undef REFUPD
  #undef RESC
  #undef ROT
}
constexpr int ATTN_LDS_BYTES=LDS_BYTES;
#undef SBAR
#undef WAIT_BAR
}

#define GAS __attribute__((address_space(1)))
#define LAS __attribute__((address_space(3)))
typedef unsigned short bf16;
typedef unsigned v4u __attribute__((ext_vector_type(4)));
typedef float f32x4 __attribute__((ext_vector_type(4)));
typedef short bf16x8 __attribute__((ext_vector_type(8)));
typedef GAS unsigned gu32;
typedef GAS unsigned long long gu64;
#define RLX_AGENT __ATOMIC_RELAXED, __HIP_MEMORY_SCOPE_AGENT
#define LDS_WAIT() asm volatile("s_waitcnt lgkmcnt(0)" ::: "memory")
#define VM_WAIT() asm volatile("s_waitcnt vmcnt(0)" ::: "memory")
__device__ __forceinline__ unsigned long long rt() { return __builtin_amdgcn_s_memrealtime(); }
__device__ __forceinline__ unsigned pk2(float lo, float hi) { return f2bf(lo) | (f2bf(hi) << 16); }

#define XB_TMO      128
#define XB_XCNT(j)  (256  + 64 * (j))
#define XB_XSUB(j)  (1280 + 64 * (j))
#define XB_XGEN(j)  (2304 + 64 * (j))
#define XB_TOP      3328
#define XB_TOPGEN   3392
#define XCD_BAR_WORDS 3456
#define XB_SPIN_CAP (1u << 18)

__device__ __forceinline__ unsigned xb_ld(unsigned* p)              { return __hip_atomic_load(p, __ATOMIC_RELAXED, __HIP_MEMORY_SCOPE_AGENT); }
__device__ __forceinline__ unsigned xb_add(unsigned* p, unsigned v) { return __hip_atomic_fetch_add(p, v, __ATOMIC_RELAXED, __HIP_MEMORY_SCOPE_AGENT); }
__device__ __forceinline__ unsigned xb_xcc_id() { return (unsigned)__builtin_amdgcn_s_getreg((3 << 11) | 20) & 0xFu; }
#define XB_SPIN(cond, bar) do { unsigned _sp = 0; while (cond) { __builtin_amdgcn_s_sleep(1); \
    if ((++_sp & 255u) == 0u) { if (xb_ld(&(bar)[XB_TMO])) break; if (_sp > XB_SPIN_CAP) { atomicAdd(&(bar)[XB_TMO], 1u); break; } } } } while (0)

struct XcdBarrier {
    unsigned* bar; unsigned x;
    volatile LAS unsigned* st;
};

__device__ __forceinline__ XcdBarrier xcd_barrier_post(unsigned* bar, volatile LAS unsigned* st) {
    XcdBarrier b; b.bar = bar; b.x = xb_xcc_id(); b.st = st;
    if (threadIdx.x == 0) (void)xb_add(&bar[XB_XCNT(b.x)], 1u);
    return b;
}
__device__ __forceinline__ void xcd_barrier_complete(unsigned* bar, unsigned x, unsigned& nloc, unsigned& nx) {
    const unsigned G = gridDim.x * gridDim.y * gridDim.z;
    unsigned sum, cnt, mine, sp = 0u;
    for (;;) {
        sum = 0u; cnt = 0u; mine = 0u;
#pragma unroll
        for (unsigned j = 0; j < 16; ++j) { const unsigned c = xb_ld(&bar[XB_XCNT(j)]); sum += c; cnt += (c > 0u) ? 1u : 0u; mine = (j == x) ? c : mine; }
        if (sum == G) break;
        __builtin_amdgcn_s_sleep(1);
        if ((++sp & 255u) == 0u) { if (xb_ld(&bar[XB_TMO])) break; if (sp > XB_SPIN_CAP) { atomicAdd(&bar[XB_TMO], 1u); break; } }
    }
    nloc = mine > 0u ? mine : 1u; nx = cnt > 0u ? cnt : 1u;
}

__device__ __forceinline__ void xcd_barrier(const XcdBarrier& b) {
    asm volatile("s_waitcnt vmcnt(0)" ::: "memory");
    __syncthreads();
    if (threadIdx.x == 0) {
        unsigned* bar = b.bar;
        __builtin_amdgcn_s_waitcnt(0);
        unsigned nloc = b.st[0], nx = b.st[1];
        if (nloc == 0u) { xcd_barrier_complete(bar, b.x, nloc, nx); b.st[0] = nloc; b.st[1] = nx; }
        const unsigned old = xb_add(&bar[XB_XSUB(b.x)], 1u);
        const unsigned gen = old / nloc;
        if (old + 1u == (gen + 1u) * nloc) {
            __builtin_amdgcn_fence(__ATOMIC_RELEASE, "agent");
            asm volatile("s_waitcnt vmcnt(0)" ::: "memory");
            const unsigned og = xb_add(&bar[XB_TOP], 1u);
            const unsigned tg = og / nx;
            if (og + 1u == (tg + 1u) * nx) xb_add(&bar[XB_TOPGEN], 1u);
            else XB_SPIN(xb_ld(&bar[XB_TOPGEN]) == tg, bar);
            __builtin_amdgcn_fence(__ATOMIC_ACQUIRE, "agent");
            xb_add(&bar[XB_XGEN(b.x)], 1u);
            asm volatile("s_waitcnt vmcnt(0)" ::: "memory");
        } else {
            XB_SPIN(xb_ld(&bar[XB_XGEN(b.x)]) == gen, bar);
            __builtin_amdgcn_fence(__ATOMIC_ACQUIRE, "agent");
            asm volatile("s_waitcnt vmcnt(0)" ::: "memory");
        }
    }
    __syncthreads();
}

constexpr int NWAVES = 8;
#ifndef MK_EN
#define MK_EN 15
#endif
constexpr int NPH = 14;
constexpr int RING_OFF = 0, RING_BYTES = 131072;
constexpr int LDS_BYTES = 147456;
constexpr int LDSCTL_OFF = LDS_BYTES - 512, MISC_OFF = LDSCTL_OFF + 320;
constexpr int CW_TMO = 0, CW_BAR = 4096;
constexpr size_t CTL_ZERO_BYTES = 64 * 1024;
static_assert((CW_BAR + XCD_BAR_WORDS) * 4 <= (int)CTL_ZERO_BYTES, "barrier words inside the memset region");
static_assert(attn_body::ATTN_LDS_BYTES <= RING_BYTES, "attention LDS");

__constant__ const unsigned ROPE_INV_BITS[32] = {0x3f800000u, 0x3f3ff911u, 0x3f0ff59au, 0x3ed7e89bu, 0x3ea1e89bu, 0x3e72d424u, 0x3e361887u, 0x3e088d77u, 0x3dcccccdu, 0x3d99940eu, 0x3d6655c3u, 0x3d2cba15u, 0x3d0186e2u, 0x3cc24350u, 0x3c91ad39u, 0x3c5a7bf1u,
    0x3c23d70au, 0x3bf5b9b0u, 0x3bb8449cu, 0x3b8a2e77u, 0x3b4f3e37u, 0x3b1b690du, 0x3ae91528u, 0x3aaec98eu, 0x3a83126fu, 0x3a44948cu, 0x3a136a16u, 0x39dd1726u, 0x39a5cb5fu, 0x3978a814u, 0x393a7753u, 0x390bd472u};
struct Args { const float* in[7]; float* out; unsigned char* ws; int ph_lo, ph_hi; };

__device__ __forceinline__ void p0_w_item(const float* __restrict__ W, int ldw, int k0, int n0, bool perm, const float* __restrict__ g, bf16_t* __restrict__ Wt, LAS float* scr, int lane) {
#pragma unroll
    for (int kb = 0; kb < 64; kb += 32) { float wv[32];
#pragma unroll
        for (int kk = 0; kk < 32; ++kk) wv[kk] = W[(size_t)(k0 + kb + kk) * ldw + n0 + lane];
#pragma unroll
        for (int kk = 0; kk < 32; ++kk) { const float gv = g ? g[k0 + kb + kk] : 1.0f; scr[(kb + kk) * 65 + lane] = wv[kk] * gv; } }
    LDS_WAIT(); asm volatile("" ::: "memory");
    const int c = lane & 7;
#pragma unroll
    for (int j = 0; j < 8; ++j) { const int n = (lane >> 3) + 8 * j; const int sc = perm ? dmap(n) : n; const LAS float* s = scr + (8 * c) * 65 + sc;
        v4u o; o.x = pk2(s[0 * 65], s[1 * 65]); o.y = pk2(s[2 * 65], s[3 * 65]); o.z = pk2(s[4 * 65], s[5 * 65]); o.w = pk2(s[6 * 65], s[7 * 65]);
        *(GAS v4u*)(Wt + (size_t)(n0 + n) * 1024 + k0 + 8 * c) = o; }
    LDS_WAIT(); asm volatile("" ::: "memory");
}

__global__ void __launch_bounds__(NWAVES * 64, 2) mk_fwd(Args args) {
    extern __shared__ __attribute__((aligned(16))) unsigned char lds[];
    LAS unsigned char* ldsp = (LAS unsigned char*)lds;
    volatile LAS unsigned* MISC = (volatile LAS unsigned*)(ldsp + MISC_OFF);
    const int tid0 = threadIdx.x;
    gu32* ctl = (gu32*)(args.ws + WS_CTL);
    for (int u = tid0; u < (LDS_BYTES - LDSCTL_OFF) / 4; u += NWAVES * 64) ((LAS unsigned*)(ldsp + LDSCTL_OFF))[u] = 0u;
    __syncthreads();
    const int lo = args.ph_lo, hi = args.ph_hi;
    XcdBarrier bar; bar.bar = (unsigned*)(ctl + CW_BAR); bar.x = 0; bar.st = nullptr;
    if (hi - lo > 1) bar = xcd_barrier_post((unsigned*)(ctl + CW_BAR), MISC + 8);

#ifndef MK_DUP
#define MK_DUP (-1)
#endif
    for (int pk = lo; pk < hi + (MK_DUP >= 0 ? 1 : 0); ++pk) {
        const int p = (MK_DUP >= 0 && pk > MK_DUP) ? pk - 1 : pk;
        int tid = threadIdx.x, G = gridDim.x, bx = blockIdx.x; asm volatile("" : "+v"(tid), "+s"(G), "+s"(bx));
        const int lane = tid & 63, wave = __builtin_amdgcn_readfirstlane(tid >> 6);
        const int vcu = (G % 8 == 0) ? (bx % 8) * (G / 8) + bx / 8 : bx;
        const int gw = vcu * NWAVES + wave, NGW = G * NWAVES;
        GAS unsigned char* wsg = (GAS unsigned char*)args.ws; asm volatile("" : "+s"(wsg)); unsigned char* ws = (unsigned char*)wsg;
#define xin (args.in[0])
#define norm_g (args.in[1])
#define w_in_a (args.in[2])
#define sinks_a (args.in[3])
#define w_in_b (args.in[4])
#define w_out (args.in[5])
#define final_g (args.in[6])
#define H (args.out)
#define rope ((float*)(ws + WS_ROPE))
#define ss ((float*)(ws + WS_SS))
#define KS ((float*)(ws + WS_KS))
#define Hb ((bf16_t*)(ws + WS_HB))
#define Qb ((bf16_t*)(ws + WS_Q))
#define Zb ((bf16_t*)(ws + WS_Z))
#define Gb ((bf16_t*)(ws + WS_G))
#define Kb ((bf16_t*)(ws + WS_K))
#define Vb ((bf16_t*)(ws + WS_V))
        if (p == 0) {
            for (int idx = bx * (NWAVES * 64) + tid; idx < SEQ * 32; idx += G * NWAVES * 64) {
                const int pos = idx >> 5, i = idx & 31;
                const float ang = (float)pos * __uint_as_float(ROPE_INV_BITS[i]);
                float sn, cs; sincosf(ang, &sn, &cs);
                rope[2 * idx] = cs; rope[2 * idx + 1] = sn;
            }
            LAS float* scr = (LAS float*)(ldsp + RING_OFF + wave * 16640);
            constexpr int I_A = (IN_A / 64) * 16, I_B = (IN_B / 64) * 16, I_O = 256, I_L2 = I_A + I_O + I_B + I_O, NITEMS = 2 * I_L2;
            for (int it = gw; it < NITEMS; it += NGW) {
                const int l2 = it / I_L2; int r = it % I_L2; int l; bool isw2 = false; int IN = IN_A;
                if (r < I_A) { l = 2 * l2; }
                else if (r < I_A + I_O) { r -= I_A; l = 2 * l2; isw2 = true; }
                else if (r < I_A + I_O + I_B) { r -= I_A + I_O; l = 2 * l2 + 1; IN = IN_B; }
                else { r -= I_A + I_O + I_B; l = 2 * l2 + 1; isw2 = true; }
                const int cg = r >> 4, kg = r & 15;
                if (isw2) p0_w_item(w_out + (size_t)l * DM * DM, DM, kg * 64, cg * 64, false, nullptr, (bf16_t*)(ws + WS_W2T + l * W2T_STRIDE), scr, lane);
                else { const float* Win = (l & 1) ? w_in_b + (size_t)l2 * DM * IN_B : w_in_a + (size_t)l2 * DM * IN_A; const int kvw = (l & 1) ? 256 : 128;
                       p0_w_item(Win, IN, kg * 64, cg * 64, cg * 64 < 1024 + kvw, norm_g + l * DM, (bf16_t*)(ws + WS_W1T + l * W1T_STRIDE), scr, lane); }
            }
            for (int row = gw; row < M; row += 2 * NGW) {
                const int row2 = row + NGW; const bool two = row2 < M;
                const f32x4* xr = (const f32x4*)(xin + (size_t)row * DM) + lane; const f32x4* xr2 = (const f32x4*)(xin + (size_t)(two ? row2 : row) * DM) + lane;
                f32x4 va[4], vb[4];
#pragma unroll
                for (int j = 0; j < 4; ++j) { va[j] = xr[64 * j]; vb[j] = xr2[64 * j]; }
                float s = 0.f, s2 = 0.f;
                unsigned long long* o8 = (unsigned long long*)(Hb + (size_t)row * DM) + lane; unsigned long long* o82 = (unsigned long long*)(Hb + (size_t)row2 * DM) + lane;
#pragma unroll
                for (int j = 0; j < 4; ++j) { const f32x4 v = va[j]; s += (v[0] * v[0] + v[1] * v[1]) + (v[2] * v[2] + v[3] * v[3]);
                    o8[64 * j] = (unsigned long long)pk2(v[0], v[1]) | ((unsigned long long)pk2(v[2], v[3]) << 32);
                    const f32x4 w = vb[j]; s2 += (w[0] * w[0] + w[1] * w[1]) + (w[2] * w[2] + w[3] * w[3]);
                    if (two) o82[64 * j] = (unsigned long long)pk2(w[0], w[1]) | ((unsigned long long)pk2(w[2], w[3]) << 32); }
                s = wave_sum(s); s2 = wave_sum(s2);
                if (lane < 16) { ss[(size_t)row * 16 + lane] = lane == 0 ? s : 0.f; if (two) ss[(size_t)row2 * 16 + lane] = lane == 0 ? s2 : 0.f; }
            }
        } else if (p == NPH - 1) {
            for (int row = gw; row < M; row += NGW) {
                f32x4* hr = (f32x4*)(H + (size_t)row * DM) + lane; const f32x4* gr = (const f32x4*)final_g + lane;
                f32x4 v[4]; float s = 0.f;
#pragma unroll
                for (int j = 0; j < 4; ++j) { v[j] = hr[64 * j]; s += (v[j][0] * v[j][0] + v[j][1] * v[j][1]) + (v[j][2] * v[j][2] + v[j][3] * v[j][3]); }
                const float rstd = __builtin_amdgcn_rsqf(wave_sum(s) * (1.0f / DM) + EPS);
#pragma unroll
                for (int j = 0; j < 4; ++j) hr[64 * j] = v[j] * rstd * gr[64 * j];
            }
        } else {
            const int l = (p - 1) / 3, kind = (p - 1) % 3; const bool isB = l & 1;
            if (kind == 0) {
                const bf16_t* W1t = (const bf16_t*)(ws + WS_W1T + l * W1T_STRIDE);
                if (!(MK_EN & 1)) {} else if (!isB) { pg8::Gemm g{Hb, W1t, M, IN_A, DM}; pg8::StaticOrder S; S.init(M, IN_A, G, bx);
                    pg8::EpiG1<2> E{Qb, Kb, Vb, Zb, ss, rope, KS};
                    pg8::gemm_phase<pg8::EpiG1<2>, pg8::StaticOrder, true, true>(ldsp + RING_OFF, g, S, E);
                } else { pg8::Gemm g{Hb, W1t, M, IN_B, DM}; pg8::StaticOrder S; S.init(M, IN_B, G, bx);
                    pg8::EpiG1<4> E{Qb, Kb, Vb, Zb, ss, rope, KS};
                    pg8::gemm_phase<pg8::EpiG1<4>, pg8::StaticOrder, true, true>(ldsp + RING_OFF, g, S, E); }
            } else if (kind == 1) {
                if (!isB) { if (MK_EN & 2)
                    for (int U = vcu; U < 2048; U += G) { const int vc = U & 255, i = U >> 8; const int bp = vc >> 2, qb = (vc & 3) * 8 + i;
                        attn_body::attn_unit<0, 8>(bp >> 3, (bp & 7) * 2, qb, Qb, Kb, Vb, Zb, Gb, sinks_a + (l >> 1) * NH, (char*)lds + RING_OFF); }
                } else { if (MK_EN & 4)
                    for (int U = vcu; U < 2048; U += G) { const int vc = U & 255, i = U >> 8; const int grp = vc >> 3, hh = (vc & 7) >> 1, half = vc & 1;
                        const int s = 2 * (i >> 1) + half, qb = (i & 1) ? 15 - s : s;
                        attn_body::attn_unit<1, 8>(grp >> 2, (grp & 3) * 4 + hh, qb, Qb, Kb, Vb, Zb, Gb, KS, (char*)lds + RING_OFF); }
                }
            } else {
                const bf16_t* W2t = (const bf16_t*)(ws + WS_W2T + l * W2T_STRIDE);
                if (MK_EN & 8) {
                pg8::Gemm g{Gb, W2t, M, DM, DM}; pg8::StaticOrder S; S.init(M, DM, G, bx);
                if (l == 0) { pg8::EpiG2<true, false> E{xin, H, Hb, ss}; pg8::gemm_phase<pg8::EpiG2<true, false>, pg8::StaticOrder, true, true>(ldsp + RING_OFF, g, S, E); }
                else if (l < DEPTH - 1) { pg8::EpiG2<false, false> E{xin, H, Hb, ss}; pg8::gemm_phase<pg8::EpiG2<false, false>, pg8::StaticOrder, true, true>(ldsp + RING_OFF, g, S, E); }
                else { pg8::EpiG2<false, true> E{xin, H, Hb, ss}; pg8::gemm_phase<pg8::EpiG2<false, true>, pg8::StaticOrder, true, true>(ldsp + RING_OFF, g, S, E); } }
            }
        }
        if (pk + 1 < hi + (MK_DUP >= 0 ? 1 : 0)) { XcdBarrier b2 = bar; GAS unsigned* bg = (GAS unsigned*)bar.bar; asm volatile("" : "+s"(bg), "+s"(b2.x)); b2.bar = (unsigned*)bg; xcd_barrier(b2); }
    }
#undef xin
#undef norm_g
#undef w_in_a
#undef sinks_a
#undef w_in_b
#undef w_out
#undef final_g
#undef H
#undef rope
#undef ss
#undef KS
#undef Hb
#undef Qb
#undef Zb
#undef Gb
#undef Kb
#undef Vb
}

#ifndef MK_FAST_MASK
#define MK_FAST_MASK 0x3fff
#endif
#ifndef MK_ONE_LAUNCH
#define MK_ONE_LAUNCH 1
#endif
extern "C" void kernel_launch(void* const* d_in, const int* in_sizes, int n_in, void* d_out, int out_size, void* d_ws, size_t ws_size, hipStream_t stream) {
    static int grid = 0;
    if (grid == 0) {
        if (n_in != 7 || in_sizes[0] != M * DM || out_size != M * DM || ws_size < WS_END) { fprintf(stderr, "kernel_launch: unexpected shapes (n_in %d, in0 %d, out %d, ws %zu)\n", n_in, n_in > 0 ? in_sizes[0] : -1, out_size, ws_size); grid = -1; return; }
        int dev = 0, cus = 0, per_cu = 0;
        if (hipGetDevice(&dev) != hipSuccess || hipDeviceGetAttribute(&cus, hipDeviceAttributeMultiprocessorCount, dev) != hipSuccess) { grid = -1; return; }
        if (hipFuncSetAttribute((const void*)mk_fwd, hipFuncAttributeMaxDynamicSharedMemorySize, LDS_BYTES) != hipSuccess) { fprintf(stderr, "kernel_launch: hipFuncSetAttribute failed\n"); grid = -1; return; }
        if (hipOccupancyMaxActiveBlocksPerMultiprocessor(&per_cu, (const void*)mk_fwd, NWAVES * 64, LDS_BYTES) != hipSuccess || per_cu < 1) fprintf(stderr, "kernel_launch: occupancy query reports %d blocks per CU\n", per_cu);
        (void)hipGetLastError();
        grid = cus;
    }
    if (grid < 0) return;
    const float* x = (const float*)d_in[0]; const float* norm_g = (const float*)d_in[1]; const float* w_in_a = (const float*)d_in[2]; const float* sinks_a = (const float*)d_in[3];
    const float* w_in_b = (const float*)d_in[4]; const float* w_out = (const float*)d_in[5]; const float* final_g = (const float*)d_in[6];
    unsigned char* ws = (unsigned char*)d_ws; float* H = (float*)d_out;
    (void)hipMemsetAsync(ws + WS_CTL, 0, CTL_ZERO_BYTES, stream);
    Args a{};
    for (int i = 0; i < 7; ++i) a.in[i] = (const float*)d_in[i];
    a.out = H; a.ws = ws;
    if (MK_ONE_LAUNCH && MK_FAST_MASK == 0x3fff) { a.ph_lo = 0; a.ph_hi = NPH; hipLaunchKernelGGL(mk_fwd, dim3(grid), dim3(NWAVES * 64), LDS_BYTES, stream, a); return; }
    float2* rope = (float2*)(ws + WS_ROPE); float* ss = (float*)(ws + WS_SS); float* KS = (float*)(ws + WS_KS);
    bf16_t* Hb = (bf16_t*)(ws + WS_HB); bf16_t* Qb = (bf16_t*)(ws + WS_Q); bf16_t* Zb = (bf16_t*)(ws + WS_Z); bf16_t* Gb = (bf16_t*)(ws + WS_G); bf16_t* Kb = (bf16_t*)(ws + WS_K); bf16_t* Vb = (bf16_t*)(ws + WS_V);
    for (int p = 0; p < NPH; ++p) {
        if ((MK_FAST_MASK >> p) & 1) { a.ph_lo = p; a.ph_hi = p + 1; hipLaunchKernelGGL(mk_fwd, dim3(grid), dim3(NWAVES * 64), LDS_BYTES, stream, a); continue; }
        if (p == 0) {
            k_prep_rope<<<SEQ * 32 / 256, 256, 0, stream>>>(rope);
            for (int l = 0; l < DEPTH; ++l) { const bool isB = l & 1; const int IN = isB ? IN_B : IN_A, KVW = isB ? 256 : 128;
                const float* Win = (isB ? w_in_b : w_in_a) + (size_t)(l >> 1) * DM * IN;
                k_prep_w1<<<(unsigned)(((size_t)IN * DM + 255) / 256), 256, 0, stream>>>(Win, norm_g + l * DM, (bf16_t*)(ws + WS_W1T + l * W1T_STRIDE), IN, KVW);
                k_prep_w2<<<DM * DM / 256, 256, 0, stream>>>(w_out + (size_t)l * DM * DM, (bf16_t*)(ws + WS_W2T + l * W2T_STRIDE)); }
            k_prep_x<<<M / 4, 256, 0, stream>>>(x, Hb, ss);
        } else if (p == NPH - 1) { k_final<<<M / 4, 256, 0, stream>>>(H, final_g);
        } else { const int l = (p - 1) / 3, kind = (p - 1) % 3; const bool isB = l & 1;
            const bf16_t* W1t = (const bf16_t*)(ws + WS_W1T + l * W1T_STRIDE); const bf16_t* W2t = (const bf16_t*)(ws + WS_W2T + l * W2T_STRIDE);
            if (kind == 0) { if (!isB) k_gemm1_naive<2><<<(M / 16) * (IN_A / 64) / 4, 256, 0, stream>>>(Hb, W1t, ss, rope, Qb, Kb, Vb, Zb);
                             else { k_gemm1_naive<4><<<(M / 16) * (IN_B / 64) / 4, 256, 0, stream>>>(Hb, W1t, ss, rope, Qb, Kb, Vb, Zb); k_ksum_naive<<<BATCH * NBLK, 256, 0, stream>>>(Kb, KS); } }
            else if (kind == 1) { if (!isB) k_attn_swa_naive<<<M * NH / 4, 256, 0, stream>>>(Qb, Kb, Vb, Zb, sinks_a + (l >> 1) * NH, Gb); else k_attn_moba_naive<<<M * NH / 4, 256, 0, stream>>>(Qb, Kb, Vb, Zb, KS, Gb); }
            else k_gemm2_naive<<<(M / 16) * 16 / 4, 256, 0, stream>>>(Gb, W2t, l == 0 ? x : H, H, Hb, ss);
        }
    }
}
```

```cpp
#define MK_FAST_MASK 0x3fff
#define MK_ONE_LAUNCH 1
#include <hip/hip_runtime.h>
#include <cstdint>
#include <cstdio>

typedef unsigned short bf16_t;
typedef short bf16x8 __attribute__((ext_vector_type(8)));
typedef float f32x4 __attribute__((ext_vector_type(4)));
typedef unsigned u32x4 __attribute__((ext_vector_type(4)));

constexpr int BATCH = 8, SEQ = 4096, DM = 1024, DEPTH = 4, HD = 64, NH = 16;
constexpr int M = BATCH * SEQ;
constexpr int IN_A = 2304, IN_B = 2560;
constexpr int WINDOW = 128, MBLK = 256, NBLK = SEQ / MBLK;
constexpr float EPS = 1e-5f;
constexpr float LOG2E = 1.4426950408889634f;
constexpr float C2 = 0.125f * LOG2E;

constexpr size_t MiB = 1u << 20;
constexpr size_t WS_CTL = 0, WS_ROPE = 1 * MiB, WS_W1T = 2 * MiB, WS_W2T = 22 * MiB, WS_SS = 30 * MiB, WS_KS = 32 * MiB;
constexpr size_t WS_HB = 64 * MiB, WS_Q = 128 * MiB, WS_Z = 192 * MiB, WS_G = 256 * MiB, WS_K = 320 * MiB, WS_V = 336 * MiB, WS_END = 352 * MiB;
constexpr size_t W1T_STRIDE = 5 * MiB, W2T_STRIDE = 2 * MiB;

__device__ __forceinline__ unsigned f2bf(float f) { unsigned u = __builtin_bit_cast(unsigned, f); return (u + 0x7fffu + ((u >> 16) & 1u)) >> 16; }
__device__ __forceinline__ float bf2f(unsigned h) { return __builtin_bit_cast(float, h << 16); }
__host__ __device__ __forceinline__ int dmap(int cc) { return (((cc >> 2) & 1) << 5) | ((cc >> 5) << 4) | (((cc >> 3) & 3) << 2) | (cc & 3); }
__host__ __device__ __forceinline__ int dinv(int d) { return (((d >> 4) & 1) << 5) | (((d >> 2) & 3) << 3) | ((d >> 5) << 2) | (d & 3); }
__device__ __forceinline__ float wave_sum(float v) {
#pragma unroll
    for (int o = 1; o < 64; o <<= 1) v += __shfl_xor(v, o);
    return v;
}
__device__ __forceinline__ float wave_max(float v) {
#pragma unroll
    for (int o = 1; o < 64; o <<= 1) v = fmaxf(v, __shfl_xor(v, o));
    return v;
}

__global__ void k_prep_rope(float2* tab) {
    const int idx = blockIdx.x * blockDim.x + threadIdx.x; if (idx >= SEQ * 32) return;
    const int pos = idx >> 5, i = idx & 31;
    const float inv = (float)pow(10000.0, -(double)i / 32.0);
    const float ang = (float)pos * inv;
    tab[idx] = make_float2((float)cos((double)ang), (float)sin((double)ang));
}
__global__ void k_prep_w1(const float* __restrict__ Win, const float* __restrict__ g, bf16_t* __restrict__ W1t, int IN, int KVW) {
    const size_t idx = (size_t)blockIdx.x * blockDim.x + threadIdx.x; if (idx >= (size_t)IN * DM) return;
    const int cp = (int)(idx / DM), k = (int)(idx % DM);
    int col = cp;
    if (cp < 1024 + KVW) col = (cp & ~63) + dmap(cp & 63);
    W1t[idx] = (bf16_t)f2bf(g[k] * Win[(size_t)k * IN + col]);
}
__global__ void k_prep_w2(const float* __restrict__ Wout, bf16_t* __restrict__ W2t) {
    const size_t idx = (size_t)blockIdx.x * blockDim.x + threadIdx.x; if (idx >= (size_t)DM * DM) return;
    const int n = (int)(idx / DM), k = (int)(idx % DM);
    W2t[idx] = (bf16_t)f2bf(Wout[(size_t)k * DM + n]);
}
__global__ void k_prep_x(const float* __restrict__ x, bf16_t* __restrict__ Hb, float* __restrict__ ss) {
    const int row = (blockIdx.x * blockDim.x + threadIdx.x) >> 6, lane = threadIdx.x & 63; if (row >= M) return;
    const f32x4* xr = (const f32x4*)(x + (size_t)row * DM) + lane; float s = 0.f;
    unsigned long long* o8 = (unsigned long long*)(Hb + (size_t)row * DM) + lane;
#pragma unroll
    for (int j = 0; j < 4; ++j) { const f32x4 v = xr[64 * j]; s += (v.x * v.x + v.y * v.y) + (v.z * v.z + v.w * v.w);
        o8[64 * j] = (unsigned long long)(f2bf(v.x) | (f2bf(v.y) << 16)) | ((unsigned long long)(f2bf(v.z) | (f2bf(v.w) << 16)) << 32); }
    s = wave_sum(s);
    if (lane < 16) ss[(size_t)row * 16 + lane] = lane == 0 ? s : 0.f;
}

template <int KVH>
__global__ __launch_bounds__(256) void k_gemm1_naive(const bf16_t* __restrict__ Hb, const bf16_t* __restrict__ W1t, const float* __restrict__ ss, const float2* __restrict__ rope,
                                                     bf16_t* __restrict__ Q, bf16_t* __restrict__ K, bf16_t* __restrict__ V, bf16_t* __restrict__ Z) {
    constexpr int KVW = KVH * 64, IN = 2048 + 2 * KVW, NG = IN / 64;
    const int wave = (int)(((size_t)blockIdx.x * 256 + threadIdx.x) >> 6), lane = threadIdx.x & 63;
    const int rt = wave / NG, cg = wave % NG; if (rt >= M / 16) return;
    const int row0 = rt * 16, lr = lane & 15, lq = lane >> 4;
    const bool rot = cg < 16 + KVH;
    f32x4 acc[4];
#pragma unroll
    for (int nb = 0; nb < 4; ++nb) acc[nb] = (f32x4){0.f, 0.f, 0.f, 0.f};
    const bf16_t* ap = Hb + (size_t)(row0 + lr) * DM + 8 * lq;
    const bf16_t* bp[4];
#pragma unroll
    for (int nb = 0; nb < 4; ++nb) { const int d = 16 * nb + lr; bp[nb] = W1t + (size_t)(cg * 64 + (rot ? dinv(d) : d)) * DM + 8 * lq; }
    for (int k0 = 0; k0 < DM; k0 += 32) {
        const bf16x8 a = *(const bf16x8*)(ap + k0);
#pragma unroll
        for (int nb = 0; nb < 4; ++nb) { const bf16x8 b = *(const bf16x8*)(bp[nb] + k0); acc[nb] = __builtin_amdgcn_mfma_f32_16x16x32_bf16(a, b, acc[nb], 0, 0, 0); }
    }
#pragma unroll
    for (int reg = 0; reg < 4; ++reg) {
        const int row = row0 + 4 * lq + reg, pos = row & (SEQ - 1);
        const f32x4* sp = (const f32x4*)(ss + (size_t)row * 16);
        const f32x4 s0 = sp[0], s1 = sp[1], s2 = sp[2], s3 = sp[3];
        const float tot = ((s0.x + s0.y) + (s0.z + s0.w)) + ((s1.x + s1.y) + (s1.z + s1.w)) + ((s2.x + s2.y) + (s2.z + s2.w)) + ((s3.x + s3.y) + (s3.z + s3.w));
        const float rstd = rsqrtf(tot * (1.0f / DM) + EPS);
        if (rot) {
            const bool isq = cg < 16; const float sc = isq ? rstd * C2 : rstd;
            bf16_t* dst = isq ? Q + (size_t)row * DM + cg * 64 : K + (size_t)row * KVW + (cg - 16) * 64;
#pragma unroll
            for (int nb = 0; nb < 2; ++nb) { const int i = 16 * nb + lr; const float2 cs = rope[pos * 32 + i];
                const float x1 = acc[nb][reg] * sc, x2 = acc[nb + 2][reg] * sc;
                dst[i] = (bf16_t)f2bf(x1 * cs.x - x2 * cs.y); dst[i + 32] = (bf16_t)f2bf(x2 * cs.x + x1 * cs.y); }
        } else {
            const bool isv = cg < 16 + 2 * KVH;
            bf16_t* dst = isv ? V + (size_t)row * KVW + (cg - 16 - KVH) * 64 : Z + (size_t)row * DM + (cg - 16 - 2 * KVH) * 64;
#pragma unroll
            for (int nb = 0; nb < 4; ++nb) dst[16 * nb + lr] = (bf16_t)f2bf(acc[nb][reg] * rstd);
        }
    }
}
__global__ void k_ksum_naive(const bf16_t* __restrict__ K, float* __restrict__ KS) {
    const int bb = blockIdx.x, c = threadIdx.x;
    float s = 0.f;
    for (int r = 0; r < MBLK; ++r) s += bf2f(K[((size_t)bb * MBLK + r) * 256 + c]);
    KS[((size_t)bb * 2 + 0) * 256 + c] = s; KS[((size_t)bb * 2 + 1) * 256 + c] = 0.f;
}

__global__ __launch_bounds__(256) void k_attn_swa_naive(const bf16_t* __restrict__ Q, const bf16_t* __restrict__ K, const bf16_t* __restrict__ V, const bf16_t* __restrict__ Z,
                                                        const float* __restrict__ sinks, bf16_t* __restrict__ G) {
    __shared__ float sh[4][64 + 128];
    const int w = threadIdx.x >> 6, lane = threadIdx.x & 63;
    const int gw = blockIdx.x * 4 + w, row = gw >> 4, h = gw & 15, t = row & (SEQ - 1), kvh = h >> 3;
    float* qs = sh[w]; float* ps = sh[w] + 64;
    qs[lane] = bf2f(Q[(size_t)row * DM + h * 64 + lane]);
    __syncthreads();
    float s[2];
#pragma unroll
    for (int r = 0; r < 2; ++r) { const int kk = lane + 64 * r; float a = -INFINITY;
        if (kk <= t) { const u32x4* kp = (const u32x4*)(K + (size_t)(row - kk) * 128 + kvh * 64); a = 0.f;
#pragma unroll
            for (int c = 0; c < 8; ++c) { const u32x4 v = kp[c];
                a += qs[8 * c + 0] * bf2f(v.x & 0xffff) + qs[8 * c + 1] * bf2f(v.x >> 16) + qs[8 * c + 2] * bf2f(v.y & 0xffff) + qs[8 * c + 3] * bf2f(v.y >> 16)
                   + qs[8 * c + 4] * bf2f(v.z & 0xffff) + qs[8 * c + 5] * bf2f(v.z >> 16) + qs[8 * c + 6] * bf2f(v.w & 0xffff) + qs[8 * c + 7] * bf2f(v.w >> 16); } }
        s[r] = a; }
    const float sinkl = sinks[h] * LOG2E;
    const float m = fmaxf(wave_max(fmaxf(s[0], s[1])), sinkl);
    const float p0 = exp2f(s[0] - m), p1 = exp2f(s[1] - m);
    const float l = wave_sum(p0 + p1) + exp2f(sinkl - m);
    ps[lane] = p0; ps[lane + 64] = p1;
    __syncthreads();
    const int nk = t + 1 < WINDOW ? t + 1 : WINDOW; float o = 0.f;
    for (int kk = 0; kk < nk; ++kk) o += ps[kk] * bf2f(V[(size_t)(row - kk) * 128 + kvh * 64 + lane]);
    o /= l;
    const float z = bf2f(Z[(size_t)row * DM + h * 64 + lane]);
    G[(size_t)row * DM + h * 64 + lane] = (bf16_t)f2bf(o * z / (1.f + __expf(-z)));
}
__global__ __launch_bounds__(256) void k_attn_moba_naive(const bf16_t* __restrict__ Q, const bf16_t* __restrict__ K, const bf16_t* __restrict__ V, const bf16_t* __restrict__ Z,
                                                         const float* __restrict__ KS, bf16_t* __restrict__ G) {
    __shared__ float sh[4][64 + 1024];
    const int w = threadIdx.x >> 6, lane = threadIdx.x & 63;
    const int gw = blockIdx.x * 4 + w, row = gw >> 4, h = gw & 15, t = row & (SEQ - 1), b = row >> 12, kvh = h >> 2, qblk = t >> 8;
    float* qs = sh[w]; float* ps = sh[w] + 64;
    qs[lane] = bf2f(Q[(size_t)row * DM + h * 64 + lane]);
    __syncthreads();
    float gate = -INFINITY;
    if (lane < qblk) { const float* k0 = KS + ((size_t)(b * NBLK + lane) * 2) * 256 + kvh * 64; const float* k1 = k0 + 256; float a = 0.f;
        for (int d = 0; d < 64; ++d) a += qs[d] * ((k0[d] + k1[d]) * (1.0f / MBLK));
        gate = a; }
    unsigned chosen = 0; const int nsel = qblk < 3 ? qblk : 3;
    for (int si = 0; si < nsel; ++si) { float best = -INFINITY; int bi = -1;
        for (int j = 0; j < qblk; ++j) { const float gj = __shfl(gate, j); if (!((chosen >> j) & 1u) && (bi < 0 || gj > best)) { best = gj; bi = j; } }
        chosen |= 1u << bi; }
    chosen |= 1u << qblk;
    float mx = -INFINITY; int nslot = 0; int blks[4] = {0, 0, 0, 0};
    for (int j = 0; j <= qblk; ++j) { if (!((chosen >> j) & 1u)) continue;
        if (nslot == 0) blks[0] = j; else if (nslot == 1) blks[1] = j; else if (nslot == 2) blks[2] = j; else blks[3] = j;
#pragma unroll
        for (int r = 0; r < 4; ++r) { const int key = j * 256 + r * 64 + lane; float a = -INFINITY;
            if (key <= t) { const u32x4* kp = (const u32x4*)(K + ((size_t)b * SEQ + key) * 256 + kvh * 64); a = 0.f;
#pragma unroll
                for (int c = 0; c < 8; ++c) { const u32x4 v = kp[c];
                    a += qs[8 * c + 0] * bf2f(v.x & 0xffff) + qs[8 * c + 1] * bf2f(v.x >> 16) + qs[8 * c + 2] * bf2f(v.y & 0xffff) + qs[8 * c + 3] * bf2f(v.y >> 16)
                       + qs[8 * c + 4] * bf2f(v.z & 0xffff) + qs[8 * c + 5] * bf2f(v.z >> 16) + qs[8 * c + 6] * bf2f(v.w & 0xffff) + qs[8 * c + 7] * bf2f(v.w >> 16); } }
            ps[nslot * 256 + r * 64 + lane] = a; mx = fmaxf(mx, a); }
        ++nslot; }
    mx = wave_max(mx);
    float l = 0.f;
    for (int i = lane; i < nslot * 256; i += 64) { const float p = exp2f(ps[i] - mx); ps[i] = p; l += p; }
    l = wave_sum(l);
    __syncthreads();
    float o = 0.f;
    for (int sl = 0; sl < nslot; ++sl) { const int j = sl == 0 ? blks[0] : sl == 1 ? blks[1] : sl == 2 ? blks[2] : blks[3];
        const bf16_t* vp = V + ((size_t)b * SEQ + j * 256) * 256 + kvh * 64 + lane; const float* pp = ps + sl * 256;
        const int nk = (j == qblk) ? (t - j * 256 + 1) : 256;
        for (int kk = 0; kk < nk; ++kk) o += pp[kk] * bf2f(vp[(size_t)kk * 256]); }
    o /= l;
    const float z = bf2f(Z[(size_t)row * DM + h * 64 + lane]);
    G[(size_t)row * DM + h * 64 + lane] = (bf16_t)f2bf(o * z / (1.f + __expf(-z)));
}

__global__ __launch_bounds__(256) void k_gemm2_naive(const bf16_t* __restrict__ Gb, const bf16_t* __restrict__ W2t, const float* hold, float* H, bf16_t* __restrict__ Hb, float* __restrict__ ss) {
    const int wave = (int)(((size_t)blockIdx.x * 256 + threadIdx.x) >> 6), lane = threadIdx.x & 63;
    const int rt = wave >> 4, cg = wave & 15; if (rt >= M / 16) return;
    const int row0 = rt * 16, lr = lane & 15, lq = lane >> 4;
    f32x4 acc[4];
#pragma unroll
    for (int nb = 0; nb < 4; ++nb) acc[nb] = (f32x4){0.f, 0.f, 0.f, 0.f};
    const bf16_t* ap = Gb + (size_t)(row0 + lr) * DM + 8 * lq;
    const bf16_t* bp = W2t + (size_t)(cg * 64 + lr) * DM + 8 * lq;
    for (int k0 = 0; k0 < DM; k0 += 32) {
        const bf16x8 a = *(const bf16x8*)(ap + k0);
#pragma unroll
        for (int nb = 0; nb < 4; ++nb) { const bf16x8 b = *(const bf16x8*)(bp + (size_t)nb * 16 * DM + k0); acc[nb] = __builtin_amdgcn_mfma_f32_16x16x32_bf16(a, b, acc[nb], 0, 0, 0); }
    }
#pragma unroll
    for (int reg = 0; reg < 4; ++reg) {
        const int row = row0 + 4 * lq + reg; float s = 0.f;
#pragma unroll
        for (int nb = 0; nb < 4; ++nb) { const size_t off = (size_t)row * DM + cg * 64 + 16 * nb + lr; const float hn = hold[off] + acc[nb][reg]; H[off] = hn; Hb[off] = (bf16_t)f2bf(hn); s += hn * hn; }
        s += __shfl_xor(s, 1); s += __shfl_xor(s, 2); s += __shfl_xor(s, 4); s += __shfl_xor(s, 8);
        if (lr == 0) ss[(size_t)row * 16 + cg] = s;
    }
}
__global__ void k_final(float* H, const float* __restrict__ fg) {
    const int row = (blockIdx.x * blockDim.x + threadIdx.x) >> 6, lane = threadIdx.x & 63; if (row >= M) return;
    f32x4* hr = (f32x4*)(H + (size_t)row * DM) + lane; const f32x4* gr = (const f32x4*)fg + lane;
    f32x4 v[4]; float s = 0.f;
#pragma unroll
    for (int j = 0; j < 4; ++j) { v[j] = hr[64 * j]; s += (v[j].x * v[j].x + v[j].y * v[j].y) + (v[j].z * v[j].z + v[j].w * v[j].w); }
    const float rstd = rsqrtf(wave_sum(s) * (1.0f / DM) + EPS);
#pragma unroll
    for (int j = 0; j < 4; ++j) hr[64 * j] = v[j] * rstd * gr[64 * j];
}


namespace pg8 {
#define PG8_LAS __attribute__((address_space(3)))
typedef unsigned short bf16_t;
typedef short bf16x8 __attribute__((ext_vector_type(8)));
typedef float f32x4 __attribute__((ext_vector_type(4)));
typedef unsigned u32x4 __attribute__((ext_vector_type(4)));
constexpr int BM = 256, BK = 64, HALF = 128, HTB = HALF * BK * 2  , STAGE_BYTES = 8 * HTB, NXCD = 8, WGM = 8;

__host__ __device__ __forceinline__ int lds_byte(int r, int c) { const int st = (r >> 4) * 2 + (c >> 5), rr = r & 15, cc = c & 31, ob = rr * 64 + cc * 2; return st * 1024 + (ob ^ (((ob >> 9) & 1) << 5)); }
__host__ __device__ __forceinline__ void stage_rc(int b, int& R, int& C) { const int st = b / 1024, sb = b % 1024, swz = sb ^ (((sb >> 9) & 1) << 5); R = (st >> 1) * 16 + swz / 64; C = (st & 1) * 32 + (swz % 64) / 2; }
__host__ __device__ __forceinline__ int perm32(int rho) { const int n = rho >> 4, i = rho & 15; return 8 * (i >> 2) + 4 * n + (i & 3); }

struct Unit { int pm, pn; };
struct Gemm { const bf16_t* A; const bf16_t* Bt; int M, N, K; };

struct StaticOrder {
    int nM, nN, nwg, G, c;
    __host__ __device__ void init(int M, int N, int G_, int c_) { nM = M / BM; nN = N / BM; nwg = nM * nN; G = G_; c = c_; }
    __host__ __device__ bool next(int i, Unit& u) const {
        const long L = (long)i * G + c; if (L >= nwg) return false;
        int wgid = (int)L; { const int q = nwg / NXCD, r = nwg % NXCD, xcd = wgid % NXCD, off = wgid / NXCD; wgid = (xcd < r ? xcd * (q + 1) : r * (q + 1) + (xcd - r) * q) + off; }
        const int nig = WGM * nN, gid = wgid / nig, fm = gid * WGM, gsz = (nM - fm) < WGM ? (nM - fm) : WGM;
        u.pm = fm + ((wgid % nig) % gsz); u.pn = (wgid % nig) / gsz; return true;
    }
    __device__ __forceinline__ void a_ready(const Unit&) const {}
    __device__ __forceinline__ void done(const Unit&) const {}
};

__device__ __forceinline__ unsigned cvt_pk_bf16(float lo, float hi) { unsigned r; asm volatile("v_cvt_pk_bf16_f32 %0, %1, %2" : "=v"(r) : "v"(lo), "v"(hi)); return r; }
typedef unsigned u32x2 __attribute__((ext_vector_type(2)));

template <int KVH> struct EpiG1 {
    static constexpr bool PERM = true, AFTER_DRAIN = false;
    bf16_t *Q, *K, *V, *Z; const float* ss; const float* rope; float* KS;
    __device__ __forceinline__ float rstd_of(int row) const {
        const f32x4* sp = (const f32x4*)(ss + (size_t)row * 16);
        const f32x4 s0 = sp[0], s1 = sp[1], s2 = sp[2], s3 = sp[3];
        const float tot = ((s0[0] + s0[1]) + (s0[2] + s0[3])) + ((s1[0] + s1[1]) + (s1[2] + s1[3])) + ((s2[0] + s2[1]) + (s2[2] + s2[3])) + ((s3[0] + s3[1]) + (s3[2] + s3[3]));
        return __builtin_amdgcn_rsqf(tot * (1.0f / 1024.0f) + 1e-5f);
    }
    __device__ __forceinline__ void operator()(const f32x4 (&acc)[2][2][4][2], const Unit& u, int wr, int wc, int fr, int fq) const {
        constexpr int KVW = KVH * 64; constexpr float C2 = 0.125f * 1.4426950408889634f;
        const int pn = u.pn, wcl = wc & 1, hp = wc >> 1;
        const int row0 = u.pm * BM + wr * 64 + fr;
        if (pn < 4 || (pn == 4 && KVH == 4)) {
            const bool isq = pn < 4;
            f32x4 ks[2][2];
#pragma unroll
            for (int bj = 0; bj < 2; ++bj) { ks[bj][0] = (f32x4){0.f, 0.f, 0.f, 0.f}; ks[bj][1] = (f32x4){0.f, 0.f, 0.f, 0.f}; }
#pragma unroll
            for (int ai = 0; ai < 2; ++ai)
#pragma unroll
                for (int m = 0; m < 4; ++m) {
                    const int row = row0 + ai * HALF + m * 16, pos = row & 4095;
                    const float rs = rstd_of(row), sc = isq ? rs * C2 : rs;
                    const f32x4* rp = (const f32x4*)(rope + ((size_t)pos * 32 + 16 * wcl + 4 * fq) * 2);
                    const f32x4 t0 = rp[0], t1 = rp[1];
                    const f32x4 cc = (f32x4){t0[0], t0[2], t1[0], t1[2]}, sn = (f32x4){t0[1], t0[3], t1[1], t1[3]};
#pragma unroll
                    for (int bj = 0; bj < 2; ++bj) {
                        const f32x4 x1 = acc[ai][bj][m][0] * sc, x2 = acc[ai][bj][m][1] * sc;
                        const f32x4 o1 = x1 * cc - x2 * sn, o2 = x2 * cc + x1 * sn;
                        bf16_t* dst = isq ? Q + (size_t)row * 1024 + (4 * pn + 2 * bj + hp) * 64 + 16 * wcl + 4 * fq : K + (size_t)row * KVW + (2 * bj + hp) * 64 + 16 * wcl + 4 * fq;
                        u32x2 w1, w2; w1.x = cvt_pk_bf16(o1[0], o1[1]); w1.y = cvt_pk_bf16(o1[2], o1[3]); w2.x = cvt_pk_bf16(o2[0], o2[1]); w2.y = cvt_pk_bf16(o2[2], o2[3]);
                        *(u32x2*)dst = w1; *(u32x2*)(dst + 32) = w2;
                        if (!isq) { ks[bj][0] += o1; ks[bj][1] += o2; }
                    }
                }
            if (!isq) {
#pragma unroll
                for (int bj = 0; bj < 2; ++bj)
#pragma unroll
                    for (int n = 0; n < 2; ++n) {
                        f32x4 v = ks[bj][n];
#pragma unroll
                        for (int j = 0; j < 4; ++j) { float s = v[j]; s += __shfl_xor(s, 1); s += __shfl_xor(s, 2); s += __shfl_xor(s, 4); s += __shfl_xor(s, 8); v[j] = s; }
                        if (fr == 0) *(f32x4*)(KS + ((size_t)(u.pm * 2 + wr)) * 256 + (2 * bj + hp) * 64 + 32 * n + 16 * wcl + 4 * fq) = v;
                    }
            }
        } else if (pn == 4) {
#pragma unroll
            for (int ai = 0; ai < 2; ++ai)
#pragma unroll
                for (int m = 0; m < 4; ++m) {
                    const int row = row0 + ai * HALF + m * 16, pos = row & 4095;
                    const float rs = rstd_of(row);
                    const f32x4* rp = (const f32x4*)(rope + ((size_t)pos * 32 + 16 * wcl + 4 * fq) * 2);
                    const f32x4 t0 = rp[0], t1 = rp[1];
                    const f32x4 cc = (f32x4){t0[0], t0[2], t1[0], t1[2]}, sn = (f32x4){t0[1], t0[3], t1[1], t1[3]};
                    { const f32x4 x1 = acc[ai][0][m][0] * rs, x2 = acc[ai][0][m][1] * rs;
                      const f32x4 o1 = x1 * cc - x2 * sn, o2 = x2 * cc + x1 * sn;
                      bf16_t* dst = K + (size_t)row * KVW + hp * 64 + 16 * wcl + 4 * fq;
                      u32x2 w1, w2; w1.x = cvt_pk_bf16(o1[0], o1[1]); w1.y = cvt_pk_bf16(o1[2], o1[3]); w2.x = cvt_pk_bf16(o2[0], o2[1]); w2.y = cvt_pk_bf16(o2[2], o2[3]);
                      *(u32x2*)dst = w1; *(u32x2*)(dst + 32) = w2; }
                    { const f32x4 v0 = acc[ai][1][m][0] * rs, v1 = acc[ai][1][m][1] * rs;
                      u32x4 w; w.x = cvt_pk_bf16(v0[0], v0[1]); w.y = cvt_pk_bf16(v0[2], v0[3]); w.z = cvt_pk_bf16(v1[0], v1[1]); w.w = cvt_pk_bf16(v1[2], v1[3]);
                      *(u32x4*)(V + (size_t)row * KVW + 32 * wc + 8 * fq) = w; }
                }
        } else {
            const bool isv = (KVH == 4 && pn == 5);
            const int zt = pn - (KVH == 4 ? 6 : 5);
#pragma unroll
            for (int ai = 0; ai < 2; ++ai)
#pragma unroll
                for (int m = 0; m < 4; ++m) {
                    const int row = row0 + ai * HALF + m * 16;
                    const float rs = rstd_of(row);
                    bf16_t* dst = isv ? V + (size_t)row * KVW + 32 * wc + 8 * fq : Z + (size_t)row * 1024 + zt * 256 + 32 * wc + 8 * fq;
#pragma unroll
                    for (int bj = 0; bj < 2; ++bj) {
                        const f32x4 v0 = acc[ai][bj][m][0] * rs, v1 = acc[ai][bj][m][1] * rs;
                        u32x4 w; w.x = cvt_pk_bf16(v0[0], v0[1]); w.y = cvt_pk_bf16(v0[2], v0[3]); w.z = cvt_pk_bf16(v1[0], v1[1]); w.w = cvt_pk_bf16(v1[2], v1[3]);
                        *(u32x4*)(dst + bj * HALF) = w;
                    }
                }
        }
    }
};
template <bool IN_F32, bool OUT_F32> struct EpiG2 {
    static constexpr bool PERM = true, AFTER_DRAIN = false;
    const float* xin; float* H; bf16_t* Hb; float* ss;
    __device__ __forceinline__ void operator()(const f32x4 (&acc)[2][2][4][2], const Unit& u, int wr, int wc, int fr, int fq) const {
        const int row0 = u.pm * BM + wr * 64 + fr, col0 = u.pn * BM + 32 * wc + 8 * fq;
#pragma unroll
        for (int ai = 0; ai < 2; ++ai) {
            f32x4 r0[4][2], r1[4][2]; u32x4 rb[4][2];
#pragma unroll
            for (int m = 0; m < 4; ++m)
#pragma unroll
                for (int bj = 0; bj < 2; ++bj) { const size_t off = (size_t)(row0 + ai * HALF + m * 16) * 1024 + col0 + bj * HALF;
                    if (IN_F32) { r0[m][bj] = *(const f32x4*)(xin + off); r1[m][bj] = *(const f32x4*)(xin + off + 4); } else rb[m][bj] = *(const u32x4*)(Hb + off); }
#pragma unroll
            for (int m = 0; m < 4; ++m) {
                const int row = row0 + ai * HALF + m * 16; float s = 0.f;
#pragma unroll
                for (int bj = 0; bj < 2; ++bj) {
                    const size_t off = (size_t)row * 1024 + col0 + bj * HALF;
                    f32x4 h0, h1;
                    if (IN_F32) { h0 = r0[m][bj]; h1 = r1[m][bj]; }
                    else { const u32x4 w = rb[m][bj]; h0 = (f32x4){__uint_as_float(w.x << 16), __uint_as_float(w.x & 0xffff0000u), __uint_as_float(w.y << 16), __uint_as_float(w.y & 0xffff0000u)};
                           h1 = (f32x4){__uint_as_float(w.z << 16), __uint_as_float(w.z & 0xffff0000u), __uint_as_float(w.w << 16), __uint_as_float(w.w & 0xffff0000u)}; }
                    const f32x4 v0 = h0 + acc[ai][bj][m][0], v1 = h1 + acc[ai][bj][m][1];
                    s += ((v0[0] * v0[0] + v0[1] * v0[1]) + (v0[2] * v0[2] + v0[3] * v0[3])) + ((v1[0] * v1[0] + v1[1] * v1[1]) + (v1[2] * v1[2] + v1[3] * v1[3]));
                    if (OUT_F32) { *(f32x4*)(H + off) = v0; *(f32x4*)(H + off + 4) = v1; }
                    else { u32x4 w; w.x = cvt_pk_bf16(v0[0], v0[1]); w.y = cvt_pk_bf16(v0[2], v0[3]); w.z = cvt_pk_bf16(v1[0], v1[1]); w.w = cvt_pk_bf16(v1[2], v1[3]); *(u32x4*)(Hb + off) = w; }
                }
                s += __shfl_xor(s, 16); s += __shfl_xor(s, 32);
                if (fq == 0) ss[(size_t)row * 16 + 4 * u.pn + wc] = s;
            }
        }
    }
};
template <class Epi, class Sched, bool ALIGN_EPI = false, bool SP2 = false>
__device__ __forceinline__ void gemm_phase(PG8_LAS unsigned char* lds, const Gemm g, const Sched& S, const Epi& E) {
    int tid_ = threadIdx.x; asm volatile("" : "+v"(tid_));
    const int tid = tid_, wid = __builtin_amdgcn_readfirstlane(tid >> 6), lane = tid & 63, wr = wid >> 2, wc = wid & 3, fr = lane & 15, fq = lane >> 4;
    const int K = g.K, nt = K / BK;
    unsigned voffA[2], voffB[2];
#pragma unroll
    for (int i = 0; i < 2; ++i) { int R, C; stage_rc(tid * 16 + i * 8192, R, C); const int Rb = Epi::PERM ? ((R & ~31) + perm32(R & 31)) : R;
        voffA[i] = (unsigned)(R * K + C) * 2u; voffB[i] = (unsigned)(Rb * K + C) * 2u; }
    const size_t kstep = (size_t)(BK * 2);
    const size_t hstep = (size_t)HALF * K * 2;
    const size_t tstep = 2 * hstep;
    const unsigned ldsw = (unsigned)wid * 1024u;
    const int aoff = lds_byte(wr * 64 + fr, fq * 8), boff = lds_byte(wc * 32 + fr, fq * 8);
#define PG8_SA(b, h) (((b) * 2 + (h)) * HTB)
#define PG8_SB(b, h) ((4 + (b) * 2 + (h)) * HTB)
#define PG8_STAGE(bufoff, gbase, voff) do { _Pragma("unroll") for (int _i = 0; _i < 2; ++_i) \
        __builtin_amdgcn_global_load_lds((const unsigned*)((const char*)(gbase) + (voff)[_i]), (PG8_LAS unsigned*)(lds + (bufoff) + ldsw + _i * 8192), 16, 0, 0); } while (0)
#define PG8_LDA(dst, b, h) do { _Pragma("unroll") for (int m = 0; m < 4; ++m) _Pragma("unroll") for (int k = 0; k < 2; ++k) dst[m][k] = *(const PG8_LAS bf16x8*)(lds + PG8_SA(b, h) + aoff + m * 2048 + k * 1024); } while (0)
#define PG8_LDB(dst, b, h) do { _Pragma("unroll") for (int n = 0; n < 2; ++n) _Pragma("unroll") for (int k = 0; k < 2; ++k) dst[n][k] = *(const PG8_LAS bf16x8*)(lds + PG8_SB(b, h) + boff + n * 2048 + k * 1024); } while (0)
#define PG8_MMA(ai, bj, At, Bt) do { __builtin_amdgcn_s_setprio(1); _Pragma("unroll") for (int m = 0; m < 4; ++m) _Pragma("unroll") for (int n = 0; n < 2; ++n) _Pragma("unroll") for (int k = 0; k < 2; ++k) \
        acc[ai][bj][m][n] = __builtin_amdgcn_mfma_f32_16x16x32_bf16(Bt[n][k], At[m][k], acc[ai][bj][m][n], 0, 0, 0); __builtin_amdgcn_s_setprio(0); } while (0)
#define PG8_WAIT_V(n) asm volatile("s_waitcnt vmcnt(" #n ")" ::: "memory")
#define PG8_WAIT_L(n) asm volatile("s_waitcnt lgkmcnt(" #n ")" ::: "memory")
#define PG8_BAR __builtin_amdgcn_s_barrier()
#define PG8_SCHED __builtin_amdgcn_sched_barrier(0)
    Unit cur, nxt; int ui = 0;
    if (!S.next(0, cur)) return;
    f32x4 acc[2][2][4][2];
#pragma unroll
    for (int a = 0; a < 2; ++a)
#pragma unroll
        for (int b = 0; b < 2; ++b)
#pragma unroll
            for (int m = 0; m < 4; ++m)
#pragma unroll
                for (int n = 0; n < 2; ++n) acc[a][b][m][n] = (f32x4){0.f, 0.f, 0.f, 0.f};
    bf16x8 At[4][2], B0[2][2], B1[2][2];
    const char* cA = (const char*)g.A + (size_t)cur.pm * tstep; const char* cB = (const char*)g.Bt + (size_t)cur.pn * tstep;
    S.a_ready(cur);
    if constexpr (SP2) {
        PG8_STAGE(PG8_SB(0, 0), cB, voffB); PG8_STAGE(PG8_SB(0, 1), cB + hstep, voffB); PG8_STAGE(PG8_SA(0, 0), cA, voffA); PG8_STAGE(PG8_SA(0, 1), cA + hstep, voffA);
        if (wr == 1) PG8_BAR;
        PG8_WAIT_V(2); PG8_BAR;
        PG8_STAGE(PG8_SB(1, 0), cB + kstep, voffB); PG8_STAGE(PG8_SA(1, 0), cA + kstep, voffA); PG8_STAGE(PG8_SB(1, 1), cB + hstep + kstep, voffB);
        PG8_WAIT_V(6); PG8_BAR;
    } else {
        PG8_STAGE(PG8_SB(0, 0), cB, voffB); PG8_STAGE(PG8_SA(0, 0), cA, voffA); PG8_STAGE(PG8_SB(0, 1), cB + hstep, voffB); PG8_STAGE(PG8_SA(0, 1), cA + hstep, voffA);
        if (wr == 1) PG8_BAR;
        PG8_WAIT_V(4); PG8_BAR;
        PG8_STAGE(PG8_SB(1, 0), cB + kstep, voffB); PG8_STAGE(PG8_SA(1, 0), cA + kstep, voffA); PG8_STAGE(PG8_SB(1, 1), cB + hstep + kstep, voffB);
        PG8_WAIT_V(6); PG8_BAR;
    }
    for (;;) {
        const bool has_next = S.next(ui + 1, nxt);
        const char* nA = has_next ? (const char*)g.A + (size_t)nxt.pm * tstep : cA; const char* nB = has_next ? (const char*)g.Bt + (size_t)nxt.pn * tstep : cB;
        for (int t = 0; t < nt; t += 2) {
            const bool last = (t == nt - 2);
            const char* a1 = cA + (size_t)(t + 1) * kstep;
            const char* a2 = last ? nA : cA + (size_t)(t + 2) * kstep; const char* b2 = last ? nB : cB + (size_t)(t + 2) * kstep;
            const char* a3 = a2 + kstep; const char* b3 = b2 + kstep;
            if (last && has_next) S.a_ready(nxt);
            if constexpr (SP2) {
            PG8_LDB(B0, 0, 0); PG8_LDB(B1, 0, 1); PG8_SCHED; PG8_LDA(At, 0, 0); PG8_STAGE(PG8_SA(1, 1), a1 + hstep, voffA);
            PG8_WAIT_V(8); PG8_WAIT_L(0); PG8_BAR; PG8_MMA(0, 0, At, B0); PG8_MMA(0, 1, At, B1); PG8_BAR; PG8_SCHED;
            PG8_LDA(At, 0, 1); PG8_STAGE(PG8_SB(0, 0), b2, voffB); PG8_STAGE(PG8_SB(0, 1), b2 + hstep, voffB); PG8_STAGE(PG8_SA(0, 0), a2, voffA);
            PG8_WAIT_V(8); PG8_WAIT_L(0); PG8_BAR; PG8_MMA(1, 0, At, B0); PG8_MMA(1, 1, At, B1); PG8_BAR; PG8_SCHED;
            PG8_LDB(B0, 1, 0); PG8_LDB(B1, 1, 1); PG8_SCHED; PG8_LDA(At, 1, 0); PG8_STAGE(PG8_SA(0, 1), a2 + hstep, voffA);
            PG8_WAIT_V(8); PG8_WAIT_L(0); PG8_BAR; PG8_MMA(0, 0, At, B0); PG8_MMA(0, 1, At, B1); PG8_BAR; PG8_SCHED;
            PG8_LDA(At, 1, 1); PG8_STAGE(PG8_SB(1, 0), b3, voffB); PG8_STAGE(PG8_SB(1, 1), b3 + hstep, voffB); PG8_STAGE(PG8_SA(1, 0), a3, voffA);
            PG8_WAIT_V(8); PG8_WAIT_L(0); PG8_BAR; PG8_MMA(1, 0, At, B0); PG8_MMA(1, 1, At, B1); PG8_BAR; PG8_SCHED;
            } else {
            PG8_LDB(B0, 0, 0); PG8_SCHED; PG8_LDA(At, 0, 0); PG8_STAGE(PG8_SA(1, 1), a1 + hstep, voffA);
            PG8_WAIT_L(8); PG8_BAR; PG8_WAIT_L(0); PG8_MMA(0, 0, At, B0); PG8_BAR; PG8_SCHED;
            PG8_LDB(B1, 0, 1); PG8_STAGE(PG8_SB(0, 0), b2, voffB);
            PG8_BAR; PG8_WAIT_L(0); PG8_MMA(0, 1, At, B1); PG8_BAR;
            PG8_LDA(At, 0, 1); PG8_STAGE(PG8_SA(0, 0), a2, voffA);
            PG8_BAR; PG8_WAIT_L(0); PG8_MMA(1, 0, At, B0); PG8_BAR; PG8_SCHED;
            PG8_STAGE(PG8_SB(0, 1), b2 + hstep, voffB);
            PG8_WAIT_V(6); PG8_BAR; PG8_MMA(1, 1, At, B1); PG8_BAR;
            PG8_LDB(B0, 1, 0); PG8_SCHED; PG8_LDA(At, 1, 0); PG8_STAGE(PG8_SA(0, 1), a2 + hstep, voffA);
            PG8_WAIT_L(8); PG8_BAR; PG8_WAIT_L(0); PG8_MMA(0, 0, At, B0); PG8_BAR; PG8_SCHED;
            PG8_LDB(B1, 1, 1); PG8_STAGE(PG8_SB(1, 0), b3, voffB);
            PG8_BAR; PG8_WAIT_L(0); PG8_MMA(0, 1, At, B1); PG8_BAR;
            PG8_LDA(At, 1, 1); PG8_STAGE(PG8_SA(1, 0), a3, voffA);
            PG8_BAR; PG8_WAIT_L(0); PG8_MMA(1, 0, At, B0); PG8_BAR; PG8_SCHED;
            PG8_STAGE(PG8_SB(1, 1), b3 + hstep, voffB);
            PG8_WAIT_V(6); PG8_BAR; PG8_MMA(1, 1, At, B1); PG8_BAR;
            }
        }
        if constexpr (ALIGN_EPI) { if (wr == 0) PG8_BAR; }
        if constexpr (!Epi::AFTER_DRAIN) { E(acc, cur, wr, wc, fr, fq); S.done(cur); }
        if (!has_next) break;
#pragma unroll
        for (int a = 0; a < 2; ++a)
#pragma unroll
            for (int b = 0; b < 2; ++b)
#pragma unroll
                for (int m = 0; m < 4; ++m)
#pragma unroll
                    for (int n = 0; n < 2; ++n) acc[a][b][m][n] = (f32x4){0.f, 0.f, 0.f, 0.f};
        cur = nxt; cA = nA; cB = nB; ++ui;
        if constexpr (ALIGN_EPI) { if (wr == 1) PG8_BAR; }
    }
    PG8_WAIT_V(0);
    if constexpr (!ALIGN_EPI) { if (wr == 0) PG8_BAR; }
    PG8_BAR;
    if constexpr (Epi::AFTER_DRAIN) { E.fused(acc, cur, wr, wc, fr, fq, lds, wid, lane); S.done(cur); }
#undef PG8_SA
#undef PG8_SB
#undef PG8_STAGE
#undef PG8_LDA
#undef PG8_LDB
#undef PG8_MMA
#undef PG8_WAIT_V
#undef PG8_WAIT_L
#undef PG8_BAR
#undef PG8_SCHED
}
}

namespace attn_body {
using bf16=unsigned short;
using bf16x8=__attribute__((ext_vector_type(8)))short;
using s16x4=__attribute__((ext_vector_type(4)))short;
using f32x16=__attribute__((ext_vector_type(16)))float;
using u32x4=__attribute__((ext_vector_type(4)))unsigned;
constexpr int ASEQ=4096,D=64,ADM=1024;
constexpr int NW=8,QBLK=32,QB=QBLK*NW,KVBLK=64;
__device__ __forceinline__ int crow(int r,int hi){return (r&3)+8*(r>>2)+4*hi;}
#define SBAR() __builtin_amdgcn_sched_barrier(0)
__device__ __forceinline__ void cmask(f32x16&p0,f32x16&p1,int jb,int qrel,int hi){
  const float NEG=-INFINITY; int kb=qrel-(64*jb+4*hi); asm volatile("":"+v"(kb));
  #pragma unroll
  for(int r=0;r<16;++r){const int c=(r&3)+8*(r>>2); if(c>kb)p0[r]=NEG; if(c+32>kb)p1[r]=NEG;}
}
__device__ __forceinline__ void wmask(f32x16&p0,f32x16&p1,int delta,int hi){
  const float NEG=-INFINITY; int d0=delta-4*hi; asm volatile("":"+v"(d0));
  #pragma unroll
  for(int r=0;r<16;++r){const int dd=d0-((r&3)+8*(r>>2)); if((unsigned)dd>=128u)p0[r]=NEG; if((unsigned)(dd-32)>=128u)p1[r]=NEG;}
}

constexpr int NSLOT=3, SLOTB=8192;
constexpr int LDS_K=0, LDS_V=NSLOT*SLOTB, LDS_WS=2*NSLOT*SLOTB, LDS_OST=LDS_WS+NW*64*4, LDS_KM=LDS_OST+NW*8192, LDS_BYTES=LDS_KM+4096;
__device__ __forceinline__ void glds16(const void*sbase,unsigned voff,unsigned lds_dst){unsigned keep;
  asm volatile("s_nop 4\n\ts_mov_b32 %0, m0\n\ts_mov_b32 m0, %2\n\ts_nop 0\n\tglobal_load_lds_dwordx4 %1, %3\n\ts_mov_b32 m0, %0":"=&s"(keep):"v"(voff),"s"(lds_dst),"s"(sbase):"memory");}
__device__ __forceinline__ float max3f(float a,float b,float c){float r;asm("v_max3_f32 %0, %1, %2, %3":"=v"(r):"v"(a),"v"(b),"v"(c));return r;}
__device__ __forceinline__ float max2f(float a,float b){float r;asm("v_max_f32_e32 %0, %1, %2":"=v"(r):"v"(a),"v"(b));return r;}
__device__ __forceinline__ float fadd_s(float a,float b){float r;asm("v_add_f32_e32 %0, %1, %2":"=v"(r):"v"(a),"v"(b));return r;}
__device__ __forceinline__ float fsub_s(float a,float b){float r;asm("v_sub_f32_e32 %0, %1, %2":"=v"(r):"v"(a),"v"(b));return r;}
typedef float f32x2_t __attribute__((ext_vector_type(2))); typedef __bf16 bf16x2_t __attribute__((ext_vector_type(2)));
__device__ __forceinline__ unsigned cvtpk_s(float lo,float hi){f32x2_t v={lo,hi};bf16x2_t b=__builtin_convertvector(v,bf16x2_t);return __builtin_bit_cast(unsigned,b);}
#define WAIT_BAR(N) asm volatile("s_waitcnt vmcnt(" #N ") lgkmcnt(0)\n\ts_barrier":::"memory")

__device__ __forceinline__ void qkt(f32x16&p0,f32x16&p1,const char*Kslot,const bf16x8*qr,const f32x16&negm,int r32,int hi){
  const char*kb=Kslot+hi*1024+r32*16;
  #pragma unroll
  for(int d0=0;d0<4;++d0){
    const bf16x8 b0=*reinterpret_cast<const bf16x8*>(kb+d0*2048);
    const bf16x8 b1=*reinterpret_cast<const bf16x8*>(kb+d0*2048+512);
    if(d0==0){p0=__builtin_amdgcn_mfma_f32_32x32x16_bf16(b0,qr[0],negm,0,0,0);p1=__builtin_amdgcn_mfma_f32_32x32x16_bf16(b1,qr[0],negm,0,0,0);}
    else{p0=__builtin_amdgcn_mfma_f32_32x32x16_bf16(b0,qr[d0],p0,0,0,0);p1=__builtin_amdgcn_mfma_f32_32x32x16_bf16(b1,qr[d0],p1,0,0,0);}}
}
typedef __attribute__((address_space(3))) const char* lds_cptr;
typedef short v4i16_t __attribute__((ext_vector_type(4)));
__device__ __forceinline__ void kload8(bf16x8*kf,lds_cptr kp){
  kf[0]=*(const __attribute__((address_space(3))) bf16x8*)(kp);      kf[1]=*(const __attribute__((address_space(3))) bf16x8*)(kp+512);
  kf[2]=*(const __attribute__((address_space(3))) bf16x8*)(kp+2048); kf[3]=*(const __attribute__((address_space(3))) bf16x8*)(kp+2560);
  kf[4]=*(const __attribute__((address_space(3))) bf16x8*)(kp+4096); kf[5]=*(const __attribute__((address_space(3))) bf16x8*)(kp+4608);
  kf[6]=*(const __attribute__((address_space(3))) bf16x8*)(kp+6144); kf[7]=*(const __attribute__((address_space(3))) bf16x8*)(kp+6656);
}
__device__ __forceinline__ void kload2(bf16x8*kf,lds_cptr kp,int j){ kf[2*j]=*(const __attribute__((address_space(3))) bf16x8*)(kp+j*2048); kf[2*j+1]=*(const __attribute__((address_space(3))) bf16x8*)(kp+j*2048+512); }
__device__ __forceinline__ s16x4 vtr(lds_cptr p){ return __builtin_bit_cast(s16x4,__builtin_amdgcn_ds_read_tr16_b64_v4i16((__attribute__((address_space(3))) v4i16_t*)p)); }
__device__ __forceinline__ float rowmax(const f32x16&p0,const f32x16&p1){
  float a=max3f(p0[0],p0[1],p1[0]),b=max3f(p0[2],p0[3],p1[1]);a=max3f(a,p1[2],p1[3]);
  #pragma unroll
  for(int r=4;r<16;r+=4){a=max3f(a,p0[r],p0[r+1]);b=max3f(b,p0[r+2],p0[r+3]);a=max3f(a,p1[r],p1[r+1]);b=max3f(b,p1[r+2],p1[r+3]);}
  const float m=max2f(a,b);
  auto rr=__builtin_amdgcn_permlane32_swap(__float_as_uint(m),__float_as_uint(m),false,false);
  return max2f(__uint_as_float(rr[0]),__uint_as_float(rr[1]));
}
__device__ __forceinline__ void pv(f32x16*o,int vb,bf16x8 pa0,bf16x8 pa1,bf16x8 pa2,bf16x8 pa3){
  #pragma unroll
  for(int d0=0;d0<2;++d0){s16x4 lo[4],hi[4];
    #pragma unroll
    for(int ks=0;ks<4;++ks){
      asm volatile("ds_read_b64_tr_b16 %0,%1 offset:%c2":"=&v"(lo[ks]):"v"(vb),"i"(d0*4096+ks*1024):"memory");
      asm volatile("ds_read_b64_tr_b16 %0,%1 offset:%c2":"=&v"(hi[ks]):"v"(vb),"i"(d0*4096+ks*1024+512):"memory");}
    asm volatile("s_waitcnt lgkmcnt(0)":::"memory");SBAR();
    #define PK(k) (bf16x8){lo[k][0],lo[k][1],lo[k][2],lo[k][3],hi[k][0],hi[k][1],hi[k][2],hi[k][3]}
    o[d0]=__builtin_amdgcn_mfma_f32_32x32x16_bf16(pa0,PK(0),o[d0],0,0,0);
    o[d0]=__builtin_amdgcn_mfma_f32_32x32x16_bf16(pa1,PK(1),o[d0],0,0,0);
    o[d0]=__builtin_amdgcn_mfma_f32_32x32x16_bf16(pa2,PK(2),o[d0],0,0,0);
    o[d0]=__builtin_amdgcn_mfma_f32_32x32x16_bf16(pa3,PK(3),o[d0],0,0,0);
    #undef PK
  }
}

template<int MODE,int THRL> __device__ __forceinline__ void attn_unit(int b,int h,int qb,const bf16*Q,const bf16*__restrict__ K,const bf16*__restrict__ V,const bf16*__restrict__ Z,bf16*G,const float*__restrict__ aux,char*shm){
  constexpr int KVW=MODE?256:128;
  const int kvh=MODE?(h>>2):(h>>3);
  int tid_=threadIdx.x; asm volatile("":"+v"(tid_));
  const int tid=tid_,lane=tid&63,r32=lane&31,hi=lane>>5; const int wid=__builtin_amdgcn_readfirstlane(tid>>6);
  const int hw=MODE?h:h+(wid>>2), wrow=MODE?wid*QBLK:(wid&3)*QBLK;
  const long rowbase=(long)b*ASEQ; const int q0=MODE?qb*QB:qb*128;
  const bf16*Qw=Q+(rowbase+q0+wrow)*ADM+hw*D;
  const bf16*Kh=K+rowbase*KVW+kvh*D,*Vh=V+rowbase*KVW+kvh*D;
  const unsigned lds0=(unsigned)(uintptr_t)shm;
  float*wsf=(float*)(shm+LDS_WS)+wid*64;
  const int NT=MODE?(4*qb+4):4;
  const int ktA=MODE?(4*qb):(qb?2*qb-2:0);
  #define KT(s) (MODE?(((s)<4)?(ktA+(s)):((s)-4)):(ktA+(s)))
  if(MODE){ float*km=(float*)(shm+LDS_KM); const float*ks=aux+((size_t)(b*16)*2)*256+kvh*64;
    for(int idx=tid;idx<qb*64;idx+=512){const int j=idx>>6,d=idx&63; km[idx]=(ks[(size_t)(2*j)*256+d]+ks[(size_t)(2*j+1)*256+d])*(1.0f/256.0f);} }
  const unsigned kvoff=(unsigned)(lane*KVW+wid*8)*2u;
  const unsigned vvoff=(unsigned)((16*(wid&3)+(lane>>2))*KVW+(wid>>2)*32+(lane&3)*8)*2u;
  const unsigned kdst=lds0+LDS_K+wid*1024, vdst=lds0+LDS_V+wid*1024;
  #define DMA_K(s,slot) glds16(Kh+(long)KT(s)*KVBLK*KVW,kvoff,(unsigned)__builtin_amdgcn_readfirstlane(kdst+(slot)))
  #define DMA_V(s,slot) glds16(Vh+(long)KT(s)*KVBLK*KVW,vvoff,(unsigned)__builtin_amdgcn_readfirstlane(vdst+(slot)))
  const int vb0=(int)(lds0+LDS_V)+((lane>>4)&1)*32+(lane&3)*8+(4*hi+((lane&15)>>2))*64;
  const char*Kbase=shm+LDS_K; bf16x8 kf[8];
  const lds_cptr shm3=(lds_cptr)shm; const lds_cptr kp0=shm3+LDS_K+hi*1024+r32*16; const lds_cptr vp0=shm3+LDS_V+((lane>>4)&1)*32+(lane&3)*8+(4*hi+((lane&15)>>2))*64;
  DMA_K(0,0);DMA_V(0,0);DMA_K(1,SLOTB);
  bf16x8 qr[4];
  #pragma unroll
  for(int d0=0;d0<4;++d0)qr[d0]=*reinterpret_cast<const bf16x8*>(&Qw[(long)r32*ADM+d0*16+hi*8]);
  float mhat=0.f,l_reg=0.f;f32x16 o[2];o[0]=f32x16{};o[1]=f32x16{};
  const f32x16 zc=f32x16{};
  const int qrel=wrow+r32;
  #define AMASK(P0,P1,s) do{ if(MODE){ if((s)<4)cmask(P0,P1,(s),qrel,hi); } else { wmask(P0,P1,q0+qrel-64*KT(s),hi); } }while(0)
  bool resc=false; unsigned selmask=0u; unsigned pm_=0xffffffffu;
  #define PMOF(s) ((MODE&&(s)>=4)?((((selmask>>((((s)-4)>>2)&31))&1u)!=0u)?0xffffffffu:0u):0xffffffffu)
  #define RESC() do{ if(resc){ asm volatile("s_waitcnt lgkmcnt(0)":::"memory"); \
      _Pragma("unroll") for(int d_=0;d_<2;++d_) _Pragma("unroll") for(int r=0;r<16;++r)o[d_][r]*=wsf[crow(r,hi)]; } }while(0)
  #define REFUPD(C0,C1,rm,LOWOK) do{ resc=false; \
      const float gr_=rm-mhat; \
      if(__builtin_expect(__any((gr_>(float)THRL)||((LOWOK)&&(rm<-60.f)&&(rm>-INFINITY))),0)){ \
        const float dl=((LOWOK)&&(rm<-60.f)&&(rm>-INFINITY))?gr_:__builtin_fmaxf(gr_,0.f); mhat+=dl; \
        const float f=__builtin_amdgcn_exp2f(-dl); l_reg*=f; if(hi==0)wsf[r32]=f; resc=true; } \
      if(__builtin_expect(__any(mhat!=0.f),0)){ _Pragma("unroll") for(int r=0;r<16;++r){C0[r]-=mhat;C1[r]-=mhat;} } }while(0)
  f32x16 pA0,pA1,pB0,pB1;
  int sl_prev=0,sl_cur=0,sl_next=SLOTB;
  #define ROT() do{sl_prev=sl_cur;sl_cur=sl_next;sl_next=(sl_next==(NSLOT-1)*SLOTB)?0:sl_next+SLOTB;}while(0)
  DMA_K(2,2*SLOTB);
  WAIT_BAR(3);
  SBAR();
  if(MODE){
    const float*km=(const float*)(shm+LDS_KM)+8*hi; float qf[32];
    #pragma unroll
    for(int d0=0;d0<4;++d0){
      #pragma unroll
      for(int e=0;e<8;++e)qf[d0*8+e]=__uint_as_float(((unsigned)(unsigned short)qr[d0][e])<<16);}
    float v1=-INFINITY,v2=-INFINITY,v3=-INFINITY; unsigned b1=0u,b2=0u,b3=0u;
    for(int j=0;j<qb;++j){ const float*kp=km+j*64; float g=0.f;
      #pragma unroll
      for(int d0=0;d0<4;++d0){
        #pragma unroll
        for(int e=0;e<8;++e)g+=qf[d0*8+e]*kp[16*d0+e];}
      g+=__shfl_xor(g,32);
      const unsigned bj=1u<<j; const bool c1=g>v1,c2=g>v2,c3=g>v3;
      v3=c2?v2:(c3?g:v3); b3=c2?b2:(c3?bj:b3);
      v2=c1?v1:(c2?g:v2); b2=c1?b1:(c2?bj:b2);
      v1=c1?g:v1;         b1=c1?bj:b1; }
    selmask=b1|b2|b3; asm volatile("":"+v"(selmask)); }
  SBAR();
  qkt(pA0,pA1,Kbase,qr,zc,r32,hi);asm volatile("s_nop 15\n\ts_nop 7":"+v"(pA0),"+v"(pA1));AMASK(pA0,pA1,0);
  { const float rm0=rowmax(pA0,pA1); REFUPD(pA0,pA1,rm0,true); }
  _Pragma("unroll") for(int r=0;r<16;++r)pA0[r]=__builtin_amdgcn_exp2f(pA0[r]);
  _Pragma("unroll") for(int r=0;r<16;++r)pA1[r]=__builtin_amdgcn_exp2f(pA1[r]);
  WAIT_BAR(0);
  DMA_K(3,0);DMA_V(1,SLOTB);
  ROT();
  kload8(kf,kp0+sl_cur);
  WAIT_BAR(2);
  s16x4 vlo[8],vhi[8]; u32x4 pw0,pw1,pw2,pw3;
  #define PKW(P,B) (MODE?(cvtpk_s(P[B],P[B+1])&pm_):cvtpk_s(P[B],P[B+1]))
  #define PAF(k) __builtin_bit_cast(bf16x8,pw##k)
  #define VFR(i) (bf16x8){vlo[i][0],vlo[i][1],vlo[i][2],vlo[i][3],vhi[i][0],vhi[i][1],vhi[i][2],vhi[i][3]}
  #define PIN(x) asm volatile("":"+v"(x))
  #define MX3(a,b,c) __builtin_fmaxf(__builtin_fmaxf((a),(b)),(c))
  #define GAPA(MF,A0,A1,A2,A3,W0,W1,PW) do{ MF; sacc+=A0; sacc+=A1; sacc+=A2; sacc+=A3; PIN(sacc); W0; W1; PIN(PW); SBAR(); }while(0)
  #define EX(v) __builtin_amdgcn_exp2f(v)
  #define GAPB(MF,X,B) do{ MF; X[B]=EX(X[B]); X[B+1]=EX(X[B+1]); X[B+2]=EX(X[B+2]); X[B+3]=EX(X[B+3]); PIN(X); SBAR(); }while(0)
  #define VRD(i) do{ vlo[i]=vtr(vp_+(((i)>>2)*4096+((i)&3)*1024)); vhi[i]=vtr(vp_+(((i)>>2)*4096+((i)&3)*1024+512)); }while(0)
  #define KRD(G,j) do{ if(G){ kload2(kf,kp0+sl_next,j); SBAR(); } }while(0)
  #define STEP(C0,C1,P0,P1,t,GK,GV,GL) do{ SBAR(); \
    const lds_cptr vp_=vp0+sl_prev; \
    VRD(0); SBAR(); float sacc=(P0[0]+P0[1]); \
    GAPA(C0=__builtin_amdgcn_mfma_f32_32x32x16_bf16(kf[0],qr[0],zc,0,0,0), P0[2],P0[3],P0[4],P0[5],     pw0[0]=PKW(P0,0), pw0[1]=PKW(P0,2), pw0); \
    VRD(4); SBAR(); GAPA(C1=__builtin_amdgcn_mfma_f32_32x32x16_bf16(kf[1],qr[0],zc,0,0,0), P0[6],P0[7],P0[8],P0[9],     pw0[2]=PKW(P0,4), pw0[3]=PKW(P0,6), pw0); \
    VRD(1); SBAR(); GAPA(C0=__builtin_amdgcn_mfma_f32_32x32x16_bf16(kf[2],qr[1],C0,0,0,0),   P0[10],P0[11],P0[12],P0[13], pw1[0]=PKW(P0,8), pw1[1]=PKW(P0,10), pw1); \
    VRD(5); SBAR(); GAPA(C1=__builtin_amdgcn_mfma_f32_32x32x16_bf16(kf[3],qr[1],C1,0,0,0),   P0[14],P0[15],P1[0],P1[1],   pw1[2]=PKW(P0,12),pw1[3]=PKW(P0,14), pw1); \
    VRD(2); SBAR(); GAPA(C0=__builtin_amdgcn_mfma_f32_32x32x16_bf16(kf[4],qr[2],C0,0,0,0),   P1[2],P1[3],P1[4],P1[5],     pw2[0]=PKW(P1,0), pw2[1]=PKW(P1,2), pw2); \
    VRD(6); SBAR(); GAPA(C1=__builtin_amdgcn_mfma_f32_32x32x16_bf16(kf[5],qr[2],C1,0,0,0),   P1[6],P1[7],P1[8],P1[9],     pw2[2]=PKW(P1,4), pw2[3]=PKW(P1,6), pw2); \
    VRD(3); SBAR(); GAPA(C0=__builtin_amdgcn_mfma_f32_32x32x16_bf16(kf[6],qr[3],C0,0,0,0),   P1[10],P1[11],P1[12],P1[13], pw3[0]=PKW(P1,8), pw3[1]=PKW(P1,10), pw3); \
    VRD(7); SBAR(); GAPA(C1=__builtin_amdgcn_mfma_f32_32x32x16_bf16(kf[7],qr[3],C1,0,0,0),   P1[14],P1[15],0.f,0.f,       pw3[2]=PKW(P1,12),pw3[3]=PKW(P1,14), pw3); \
    l_reg+=(MODE?(pm_?sacc:0.f):sacc); \
    if(GK){DMA_K((t)+3,sl_cur);} if(GV){DMA_V((t)+1,sl_next);} \
    AMASK(C0,C1,t); \
    { float a=MX3(C0[0],C0[1],C1[0]),b=MX3(C0[2],C0[3],C1[1]); a=MX3(a,C1[2],C1[3]); \
      _Pragma("unroll") for(int r=4;r<16;r+=4){a=MX3(a,C0[r],C0[r+1]);b=MX3(b,C0[r+2],C0[r+3]);a=MX3(a,C1[r],C1[r+1]);b=MX3(b,C1[r+2],C1[r+3]);} \
      float rm=__builtin_fmaxf(a,b); { auto rr=__builtin_amdgcn_permlane32_swap(__float_as_uint(rm),__float_as_uint(rm),false,false); rm=__builtin_fmaxf(__uint_as_float(rr[0]),__uint_as_float(rr[1])); } \
      pm_=PMOF(t); if(MODE){ rm=pm_?rm:-INFINITY; } \
      REFUPD(C0,C1,rm,false); } \
    SBAR(); \
    GAPB(o[0]=__builtin_amdgcn_mfma_f32_32x32x16_bf16(PAF(0),VFR(0),o[0],0,0,0), C0,0); \
    GAPB(o[1]=__builtin_amdgcn_mfma_f32_32x32x16_bf16(PAF(0),VFR(4),o[1],0,0,0), C0,4); \
    KRD(GL,0); GAPB(o[0]=__builtin_amdgcn_mfma_f32_32x32x16_bf16(PAF(1),VFR(1),o[0],0,0,0), C0,8); \
    KRD(GL,1); GAPB(o[1]=__builtin_amdgcn_mfma_f32_32x32x16_bf16(PAF(1),VFR(5),o[1],0,0,0), C0,12); \
    KRD(GL,2); GAPB(o[0]=__builtin_amdgcn_mfma_f32_32x32x16_bf16(PAF(2),VFR(2),o[0],0,0,0), C1,0); \
    KRD(GL,3); GAPB(o[1]=__builtin_amdgcn_mfma_f32_32x32x16_bf16(PAF(2),VFR(6),o[1],0,0,0), C1,4); \
    GAPB(o[0]=__builtin_amdgcn_mfma_f32_32x32x16_bf16(PAF(3),VFR(3),o[0],0,0,0), C1,8); \
    GAPB(o[1]=__builtin_amdgcn_mfma_f32_32x32x16_bf16(PAF(3),VFR(7),o[1],0,0,0), C1,12); \
    }while(0)
  int t=1;
  for(;t+5<NT;t+=2){
    STEP(pB0,pB1,pA0,pA1,t,true,true,true);     WAIT_BAR(2); RESC(); ROT();
    STEP(pA0,pA1,pB0,pB1,t+1,true,true,true);   WAIT_BAR(2); RESC(); ROT();
  }
  #define ENDW(tt) do{ if((tt)+3<NT){WAIT_BAR(2);} else if((tt)+2<NT){WAIT_BAR(1);} else {WAIT_BAR(0);} }while(0)
  for(;t+1<NT;t+=2){
    STEP(pB0,pB1,pA0,pA1,t,(t+3<NT),(t+1<NT),(t+1<NT));       ENDW(t);   RESC(); ROT();
    STEP(pA0,pA1,pB0,pB1,t+1,(t+4<NT),(t+2<NT),(t+2<NT));     ENDW(t+1); RESC(); ROT();
  }
  STEP(pB0,pB1,pA0,pA1,NT-1,false,false,false); RESC();
  { float sacc=pB0[0]+pB0[1]; _Pragma("unroll") for(int r=2;r<16;++r)sacc+=pB0[r]; _Pragma("unroll") for(int r=0;r<16;++r)sacc+=pB1[r]; l_reg+=(MODE?(pm_?sacc:0.f):sacc);
    pw0=(u32x4){PKW(pB0,0),PKW(pB0,2),PKW(pB0,4),PKW(pB0,6)};pw1=(u32x4){PKW(pB0,8),PKW(pB0,10),PKW(pB0,12),PKW(pB0,14)};pw2=(u32x4){PKW(pB1,0),PKW(pB1,2),PKW(pB1,4),PKW(pB1,6)};pw3=(u32x4){PKW(pB1,8),PKW(pB1,10),PKW(pB1,12),PKW(pB1,14)};
    SBAR(); pv(o,vb0+sl_cur,PAF(0),PAF(1),PAF(2),PAF(3)); }
  #undef PKW
  #undef PAF
  #undef VFR
  #undef PIN
  #undef MX3
  #undef GAPA
  #undef GAPB
  #undef EX
  #undef VRD
  #undef KRD
  #undef STEP
  #undef ENDW
  {auto rr=__builtin_amdgcn_permlane32_swap(__float_as_uint(l_reg),__float_as_uint(l_reg),false,false);l_reg=__uint_as_float(rr[0])+__uint_as_float(rr[1]);}
  if(!MODE)l_reg+=__builtin_amdgcn_exp2f(aux[hw]*1.4426950408889634f-mhat);
  long grow0=rowbase+q0+wrow; asm volatile("":"+v"(grow0));
  u32x4 zv[4];
  #pragma unroll
  for(int i=0;i<4;++i){const int row=i*8+(lane>>3),ch=lane&7; zv[i]=*(const u32x4*)(Z+(grow0+row)*ADM+hw*D+ch*8);}
  if(hi==0)wsf[32+r32]=l_reg;asm volatile("s_waitcnt lgkmcnt(0)":::"memory");
  float rli[16];
  #pragma unroll
  for(int r=0;r<16;++r)rli[r]=__builtin_amdgcn_rcpf(wsf[32+crow(r,hi)]);
  { float*stg=(float*)(shm+LDS_OST)+wid*2048;
    #pragma unroll
    for(int r=0;r<16;++r){const int orow=crow(r,hi);
      #pragma unroll
      for(int d0=0;d0<2;++d0)stg[orow*64+d0*32+r32]=o[d0][r]*rli[r];}
    asm volatile("s_waitcnt lgkmcnt(0)":::"memory");
    #pragma unroll
    for(int i=0;i<4;++i){const int row=i*8+(lane>>3),ch=lane&7; const f32x4 a0=*(const f32x4*)(stg+row*64+ch*8),a1=*(const f32x4*)(stg+row*64+ch*8+4);
      float zf[8]; zf[0]=__uint_as_float(zv[i].x<<16);zf[1]=__uint_as_float(zv[i].x&0xffff0000u);zf[2]=__uint_as_float(zv[i].y<<16);zf[3]=__uint_as_float(zv[i].y&0xffff0000u);
      zf[4]=__uint_as_float(zv[i].z<<16);zf[5]=__uint_as_float(zv[i].z&0xffff0000u);zf[6]=__uint_as_float(zv[i].w<<16);zf[7]=__uint_as_float(zv[i].w&0xffff0000u);
      float gv[8];
      #pragma unroll
      for(int e=0;e<8;++e){const float ov=e<4?a0[e]:a1[e-4]; gv[e]=ov*zf[e]*__builtin_amdgcn_rcpf(1.0f+__builtin_amdgcn_exp2f(-1.4426950408889634f*zf[e]));}
      u32x4 w; w.x=cvtpk_s(gv[0],gv[1]);w.y=cvtpk_s(gv[2],gv[3]);w.z=cvtpk_s(gv[4],gv[5]);w.w=cvtpk_s(gv[6],gv[7]);
      *(u32x4*)(G+(grow0+row)*ADM+hw*D+ch*8)=w;} }
  asm volatile("s_waitcnt lgkmcnt(0)\n\ts_barrier":::"memory");
  #undef DMA_K
  #undef DMA_V
  #undef KT
  #undef AMASK
  #undef PMOF
  #undef REFUPD
  #undef RESC
  #undef ROT
}
#undef SBAR
#undef WAIT_BAR
constexpr int M2_ACC=LDS_OST, M2_QN=M2_ACC+65536, M2_LIST=M2_QN+32768, M2_CNT=M2_LIST+7680, M2_NJ=M2_CNT+960, M2_SCHED=M2_NJ+128, M2_LACC=M2_SCHED+128, M2_MACC=M2_LACC+2048, LDS_BYTES_MOBA2=M2_MACC+2048;
typedef __attribute__((address_space(3))) float* lds_fptr;
typedef __attribute__((address_space(3))) unsigned* lds_uptr;
typedef __attribute__((address_space(3))) const unsigned char* lds_bptr;
__device__ __forceinline__ unsigned pk2bf(float lo,float hi){f32x2_t v={lo,hi};bf16x2_t b=__builtin_convertvector(v,bf16x2_t);return __builtin_bit_cast(unsigned,b);}
__device__ __forceinline__ void moba2_flush(const f32x16 (&o)[2],float l_part,float m_part,int kind,lds_bptr lbase,int pos0,int nA,int nv,lds_cptr shm3,lds_fptr wsf,int wid,int r32,int hi){
  const lds_uptr acc=(lds_uptr)(shm3+M2_ACC); const lds_fptr lacc=(lds_fptr)(shm3+M2_LACC), macc=(lds_fptr)(shm3+M2_MACC);
  const float ltot=l_part+__shfl_xor(l_part,32);
  if(kind<2){
    const int base=256*kind+32*wid;
    #pragma unroll
    for(int r=0;r<16;++r)acc[(base+crow(r,hi))*32+r32]=pk2bf(o[0][r],o[1][r]);
    if(hi==0){lacc[base+r32]=ltot; macc[base+r32]=m_part;}
  } else {
    unsigned w4[4];
    #pragma unroll
    for(int g=0;g<4;++g)w4[g]=*(const __attribute__((address_space(3))) unsigned*)(lbase+8*g+4*hi);
    const bool valid=r32<nv; const int ridl=(int)lbase[r32]+((pos0+r32>=nA)?256:0); const float mcur=valid?macc[ridl]:m_part;
    if(!__any(mcur!=m_part)){
      #pragma unroll
      for(int g=0;g<4;++g){ unsigned a[4]; int ix[4];
        #pragma unroll
        for(int q=0;q<4;++q){const int cp=8*g+4*hi+q; ix[q]=((int)((w4[g]>>(8*q))&255u)+((pos0+cp>=nA)?256:0))*32+r32; a[q]=acc[ix[q]];}
        #pragma unroll
        for(int q=0;q<4;++q){ if(8*g+4*hi+q<nv)acc[ix[q]]=pk2bf(__uint_as_float(a[q]<<16)+o[0][4*g+q],__uint_as_float(a[q]&0xffff0000u)+o[1][4*g+q]); }
        asm volatile("":::"memory"); }
      if(hi==0&&valid)lacc[ridl]+=ltot;
    } else {
      const float mn=__builtin_fmaxf(mcur,m_part), fa=__builtin_amdgcn_exp2f(mcur-mn), fp=__builtin_amdgcn_exp2f(m_part-mn);
      if(hi==0){wsf[r32]=fa;wsf[32+r32]=fp;}
      asm volatile("s_waitcnt lgkmcnt(0)":::"memory");
      #pragma unroll
      for(int r=0;r<16;++r){const int cp=crow(r,hi); const int ix=((int)((w4[r>>2]>>(8*(r&3)))&255u)+((pos0+cp>=nA)?256:0))*32+r32; const float far=wsf[cp],fpr=wsf[32+cp];
        if(cp<nv){const unsigned a=acc[ix]; acc[ix]=pk2bf(__uint_as_float(a<<16)*far+o[0][r]*fpr,__uint_as_float(a&0xffff0000u)*far+o[1][r]*fpr);}}
      if(hi==0&&valid){lacc[ridl]=lacc[ridl]*fa+ltot*fp; macc[ridl]=mn;}
      asm volatile("s_waitcnt lgkmcnt(0)":::"memory");
    }
  }
}
__device__ __forceinline__ unsigned moba_gate(const bf16x8 (&qx)[4],lds_cptr kmb,int qb,int r32,int hi){
  f32x16 gacc=f32x16{};
  #pragma unroll
  for(int d0=0;d0<4;++d0){ const bf16x8 ah=*(const __attribute__((address_space(3))) bf16x8*)(kmb+r32*128+((2*d0+hi)<<4)), al=*(const __attribute__((address_space(3))) bf16x8*)(kmb+4096+r32*128+((2*d0+hi)<<4));
    gacc=__builtin_amdgcn_mfma_f32_32x32x16_bf16(ah,qx[d0],gacc,0,0,0); gacc=__builtin_amdgcn_mfma_f32_32x32x16_bf16(al,qx[d0],gacc,0,0,0); }
  float mine[8],oth[8];
  #pragma unroll
  for(int r=0;r<8;++r){mine[r]=gacc[r]; oth[r]=__shfl_xor(mine[r],32);}
  float v1=-INFINITY,v2=-INFINITY,v3=-INFINITY; unsigned b1=0u,b2=0u,b3=0u;
  #pragma unroll
  for(int j=0;j<16;++j){ const int own=(j>>2)&1, r=(j&3)+4*(j>>3); const float g=(hi==own)?mine[r]:oth[r];
    const unsigned bj=1u<<j; const bool in=j<qb; const bool c1=in&&(g>v1),c2=in&&(g>v2),c3=in&&(g>v3);
    v3=c2?v2:(c3?g:v3); b3=c2?b2:(c3?bj:b3);
    v2=c1?v1:(c2?g:v2); b2=c1?b1:(c2?bj:b2);
    v1=c1?g:v1;         b1=c1?bj:b1; }
  return b1|b2|b3;
}
#define SBAR() __builtin_amdgcn_sched_barrier(0)
#define WAIT_BAR(N) asm volatile("s_waitcnt vmcnt(" #N ") lgkmcnt(0)\n\ts_barrier":::"memory")
template<int THRL> __device__ __forceinline__ void attn_unit_moba2(int b,int hp,int qb,const bf16*Q,const bf16*__restrict__ K,const bf16*__restrict__ V,const bf16*__restrict__ Z,bf16*G,const float*__restrict__ KSUM,char*shm){
  constexpr int KVW=256;
  const int kvh=hp>>1, hA=2*hp;
  int tid_=threadIdx.x; asm volatile("":"+v"(tid_));
  const int tid=tid_,lane=tid&63,r32=lane&31,hi=lane>>5; const int wid=__builtin_amdgcn_readfirstlane(tid>>6);
  const long rowbase=(long)b*ASEQ; const int q0=qb*QB;
  const bf16*Kh=K+rowbase*KVW+kvh*D,*Vh=V+rowbase*KVW+kvh*D;
  const bf16*Qu=Q+(rowbase+q0)*ADM+hA*D;
  const unsigned lds0=(unsigned)(uintptr_t)shm;
  const lds_cptr shm3=(lds_cptr)shm;
  const lds_fptr wsf=(lds_fptr)(shm3+LDS_WS)+wid*64;
  const lds_uptr sched=(lds_uptr)(shm3+M2_SCHED);
  const int ktA=4*qb;
  int jseg_cur=0,jseg_nxt=0,gseg=0;
  #define KT(s) ((((s)>>2)<2)?(ktA+((s)&3)):(4*((((s)>>2)==gseg)?jseg_cur:jseg_nxt)+((s)&3)))
  { const float*ks=KSUM+((size_t)(b*16)*2)*256+kvh*64;
    for(int idx=tid;idx<qb*64;idx+=512){const int j=idx>>6,d=idx&63; const float m_=(ks[(size_t)(2*j)*256+d]+ks[(size_t)(2*j+1)*256+d])*(1.0f/256.0f);
      const unsigned hb_=pk2bf(m_,0.f)&0xffffu; const float hf_=__uint_as_float(hb_<<16); const unsigned lb_=pk2bf(m_-hf_,0.f)&0xffffu;
      *(__attribute__((address_space(3))) unsigned short*)(shm3+M2_LIST+idx*2)=(unsigned short)hb_; *(__attribute__((address_space(3))) unsigned short*)(shm3+M2_LIST+4096+idx*2)=(unsigned short)lb_; } }
  { u32x4 qv[4];
    #pragma unroll
    for(int k=0;k<4;++k){const int c=tid+512*k,row=c>>3,ch=c&7; qv[k]=*(const u32x4*)(Qu+(long)row*ADM+D+ch*8);}
    #pragma unroll
    for(int k=0;k<4;++k){const int c=tid+512*k,row=c>>3,ch=c&7; *(__attribute__((address_space(3))) u32x4*)(shm3+M2_QN+row*128+((ch^(row&7))<<4))=qv[k];} }
  const unsigned kvoff=(unsigned)(lane*KVW+wid*8)*2u;
  const unsigned vvoff=(unsigned)((16*(wid&3)+(lane>>2))*KVW+(wid>>2)*32+(lane&3)*8)*2u;
  const unsigned kdst=lds0+LDS_K+wid*1024, vdst=lds0+LDS_V+wid*1024;
  #define DMA_K(s,slot) glds16(Kh+(long)KT(s)*KVBLK*KVW,kvoff,(unsigned)__builtin_amdgcn_readfirstlane(kdst+(slot)))
  #define DMA_V(s,slot) glds16(Vh+(long)KT(s)*KVBLK*KVW,vvoff,(unsigned)__builtin_amdgcn_readfirstlane(vdst+(slot)))
  const char*Kbase=shm+LDS_K; bf16x8 kf[8];
  const lds_cptr kp0=shm3+LDS_K+hi*1024+r32*16; const lds_cptr vp0=shm3+LDS_V+((lane>>4)&1)*32+(lane&3)*8+(4*hi+((lane&15)>>2))*64;
  DMA_K(0,0);DMA_V(0,0);DMA_K(1,SLOTB);
  bf16x8 qr[4];
  #pragma unroll
  for(int d0=0;d0<4;++d0)qr[d0]=*reinterpret_cast<const bf16x8*>(Qu+(long)(32*wid+r32)*ADM+d0*16+hi*8);
  DMA_K(2,2*SLOTB);
  WAIT_BAR(3);
  #define QLOAD(slot_) do{ const int rq_=(slot_); _Pragma("unroll") for(int d0=0;d0<4;++d0)qr[d0]=*(const __attribute__((address_space(3))) bf16x8*)(shm3+M2_QN+rq_*128+((((2*d0+hi)^(rq_&7)))<<4)); }while(0)
  float mhat=0.f,l_reg=0.f;f32x16 o[2];o[0]=f32x16{};o[1]=f32x16{};
  const f32x16 zc=f32x16{};
  const int qrel=wid*QBLK+r32;
  bool resc=false; bool act_cur=true; int kind_cur=0, lofs_cur=0, pos0_cur=0, nA_cur=0, nv_cur=32;
  int NR=0;
  SBAR();
  {
    const lds_cptr km=shm3+M2_LIST;
    unsigned selA=moba_gate(qr,km,qb,r32,hi);
#ifdef M2_DUPGATE
    { asm volatile("":"+v"(selA)); bf16x8 q2_[4]; _Pragma("unroll") for(int d0=0;d0<4;++d0){q2_[d0]=qr[d0]; asm volatile("":"+v"(q2_[d0]));} selA^=moba_gate(q2_,km,qb,r32,hi)^selA; const unsigned s3_=moba_gate(q2_,km+((int)(selA&0u)),qb,r32,hi); selA|=s3_&0u; }
#endif
    bf16x8 qb_[4]; { const int rq_=32*wid+r32;
      #pragma unroll
      for(int d0=0;d0<4;++d0)qb_[d0]=*(const __attribute__((address_space(3))) bf16x8*)(shm3+M2_QN+rq_*128+((((2*d0+hi)^(rq_&7)))<<4)); }
    const unsigned selB=moba_gate(qb_,km,qb,r32,hi);
    const lds_uptr cnt=(lds_uptr)(shm3+M2_CNT);
    { unsigned myA=0u,myB=0u;
      for(int j=0;j<qb;++j){ const unsigned mA=(unsigned)__ballot(((selA>>j)&1u)!=0u&&hi==0), mB=(unsigned)__ballot(((selB>>j)&1u)!=0u&&hi==0);
        if(lane==j){myA=(unsigned)__builtin_popcount(mA); myB=(unsigned)__builtin_popcount(mB);} }
      if(lane<qb){cnt[lane*16+wid]=myA; cnt[lane*16+8+wid]=myB;} }
    asm volatile("s_waitcnt lgkmcnt(0)\n\ts_barrier":::"memory");
    { unsigned nAj=0u,offAj=0u,offBj=0u,totj=0u;
      if(lane<qb){ const __attribute__((address_space(3))) u32x4* cp_=(const __attribute__((address_space(3))) u32x4*)(shm3+M2_CNT+lane*64);
        const u32x4 c0=cp_[0],c1=cp_[1],c2=cp_[2],c3=cp_[3]; const unsigned ca[8]={c0.x,c0.y,c0.z,c0.w,c1.x,c1.y,c1.z,c1.w}, cb[8]={c2.x,c2.y,c2.z,c2.w,c3.x,c3.y,c3.z,c3.w};
        unsigned nB=0u;
        #pragma unroll
        for(int w=0;w<8;++w){ nAj+=ca[w]; nB+=cb[w]; offAj+=(w<wid)?ca[w]:0u; offBj+=(w<wid)?cb[w]:0u; }
        offBj+=nAj; totj=nAj+nB;
        if(wid==0){((lds_uptr)(shm3+M2_NJ))[2*lane]=nAj;((lds_uptr)(shm3+M2_NJ))[2*lane+1]=totj;} }
      const unsigned below=(1u<<r32)-1u;
      for(int j=0;j<qb;++j){ const bool inA=((selA>>j)&1u)!=0u&&hi==0, inB=((selB>>j)&1u)!=0u&&hi==0; const unsigned mA=(unsigned)__ballot(inA), mB=(unsigned)__ballot(inB);
        const unsigned oa=(unsigned)__builtin_amdgcn_readlane((int)offAj,j), ob=(unsigned)__builtin_amdgcn_readlane((int)offBj,j);
        if(inA)*(__attribute__((address_space(3))) unsigned char*)(shm3+M2_LIST+j*512+oa+(unsigned)__builtin_popcount(mA&below))=(unsigned char)(32*wid+r32);
        if(inB)*(__attribute__((address_space(3))) unsigned char*)(shm3+M2_LIST+j*512+ob+(unsigned)__builtin_popcount(mB&below))=(unsigned char)(32*wid+r32); }
      if(wid==0){
        const int tot=(int)totj; const int nr=(tot+255)>>8; int pre=nr;
        #pragma unroll
        for(int d_=1;d_<16;d_<<=1){ const int v_=__shfl_up(pre,d_); if(lane>=d_)pre+=v_; }
        const int k0=pre-nr;
        if(nr>0)sched[k0]=(unsigned)(lane|(0<<8)|((tot<256?tot:256)<<16));
        if(nr>1)sched[k0+1]=(unsigned)(lane|(1<<8)|((tot-256)<<16));
        const int total=__shfl(pre,15); if(lane==0)sched[31]=(unsigned)total; } }
    asm volatile("s_waitcnt lgkmcnt(0)\n\ts_barrier":::"memory");
    NR=__builtin_amdgcn_readfirstlane((int)sched[31]);
  }
  const int NT=4*(2+NR);
  SBAR();
  #define RESC() do{ if(resc){ asm volatile("s_waitcnt lgkmcnt(0)":::"memory"); \
      _Pragma("unroll") for(int d_=0;d_<2;++d_) _Pragma("unroll") for(int r=0;r<16;++r)o[d_][r]*=wsf[crow(r,hi)]; } }while(0)
  #define REFUPD(C0,C1,rm,LOWOK) do{ resc=false; \
      const float gr_=rm-mhat; \
      if(__builtin_expect(__any((gr_>(float)THRL)||((LOWOK)&&(rm<-60.f)&&(rm>-INFINITY))),0)){ \
        const float dl=((LOWOK)&&(rm<-60.f)&&(rm>-INFINITY))?gr_:__builtin_fmaxf(gr_,0.f); mhat+=dl; \
        const float f=__builtin_amdgcn_exp2f(-dl); l_reg*=f; if(hi==0)wsf[r32]=f; resc=true; } \
      if(__builtin_expect(__any(mhat!=0.f),0)){ _Pragma("unroll") for(int r=0;r<16;++r){C0[r]-=mhat;C1[r]-=mhat;} } }while(0)
  f32x16 pA0,pA1,pB0,pB1;
  int sl_prev=0,sl_cur=0,sl_next=SLOTB;
  #define ROT() do{sl_prev=sl_cur;sl_cur=sl_next;sl_next=(sl_next==(NSLOT-1)*SLOTB)?0:sl_next+SLOTB;}while(0)
  qkt(pA0,pA1,Kbase,qr,zc,r32,hi);asm volatile("s_nop 15\n\ts_nop 7":"+v"(pA0),"+v"(pA1));cmask(pA0,pA1,0,qrel,hi);
  { const float rm0=rowmax(pA0,pA1); REFUPD(pA0,pA1,rm0,true); }
  _Pragma("unroll") for(int r=0;r<16;++r)pA0[r]=__builtin_amdgcn_exp2f(pA0[r]);
  _Pragma("unroll") for(int r=0;r<16;++r)pA1[r]=__builtin_amdgcn_exp2f(pA1[r]);
  WAIT_BAR(0);
  DMA_K(3,0);DMA_V(1,SLOTB);
  ROT();
  kload8(kf,kp0+sl_cur);
  WAIT_BAR(2);
  s16x4 vlo[8],vhi[8]; u32x4 pw0,pw1,pw2,pw3;
  #define PKW(P,B) cvtpk_s(P[B],P[B+1])
  #define PAF(k) __builtin_bit_cast(bf16x8,pw##k)
  #define VFR(i) (bf16x8){vlo[i][0],vlo[i][1],vlo[i][2],vlo[i][3],vhi[i][0],vhi[i][1],vhi[i][2],vhi[i][3]}
  #define PIN(x) asm volatile("":"+v"(x))
  #define MX3(a,b,c) __builtin_fmaxf(__builtin_fmaxf((a),(b)),(c))
  #define GAPA(MF,A0,A1,A2,A3,W0,W1,PW) do{ MF; sacc+=A0; sacc+=A1; sacc+=A2; sacc+=A3; PIN(sacc); W0; W1; PIN(PW); SBAR(); }while(0)
  #define EX(v) __builtin_amdgcn_exp2f(v)
  #define GAPB(MF,X,B) do{ MF; X[B]=EX(X[B]); X[B+1]=EX(X[B+1]); X[B+2]=EX(X[B+2]); X[B+3]=EX(X[B+3]); PIN(X); SBAR(); }while(0)
  #define VRD(i) do{ vlo[i]=vtr(vp_+(((i)>>2)*4096+((i)&3)*1024)); vhi[i]=vtr(vp_+(((i)>>2)*4096+((i)&3)*1024+512)); }while(0)
  #define KRD(G,j) do{ if(G){ kload2(kf,kp0+sl_next,j); SBAR(); } }while(0)
  #define QGATHER(k_) do{ const unsigned e_=(unsigned)__builtin_amdgcn_readfirstlane((int)sched[(k_)]); const int j_=(int)(e_&255u), r_=(int)((e_>>8)&255u); \
      const int nA_=__builtin_amdgcn_readfirstlane((int)((lds_uptr)(shm3+M2_NJ))[2*j_]); \
      _Pragma("unroll") for(int q_=0;q_<4;++q_){ const int slot_=32*wid+8*q_+(lane>>3); const int pos_=256*r_+slot_; \
        const int tok_=(int)*(lds_bptr)(shm3+M2_LIST+j_*512+pos_); const int hd_=(pos_>=nA_)?1:0; \
        glds16(Qu,(unsigned)((tok_*ADM+hd_*D)*2+(((lane&7)^(slot_&7))<<4)),(unsigned)__builtin_amdgcn_readfirstlane(lds0+M2_QN+(32*wid+8*q_)*128)); } }while(0)
  #define STEP(C0,C1,P0,P1,t,GK,GV,GL,BND,RF) do{ \
    const bool bnd_=(BND)&&(((t)&3)==0); const bool act_old_=act_cur; const int kind_old_=kind_cur, lofs_old_=lofs_cur, pos0_old_=pos0_cur, nA_old_=nA_cur, nv_old_=nv_cur; \
    if(bnd_){ const int g_=(t)>>2; gseg=g_; jseg_cur=jseg_nxt; jseg_nxt=(g_-1<NR)?(int)(__builtin_amdgcn_readfirstlane((int)sched[g_-1])&255):0; \
      if(g_==1){ kind_cur=1; act_cur=true; QLOAD(32*wid+r32); } \
      else { const unsigned e_=(unsigned)__builtin_amdgcn_readfirstlane((int)sched[g_-2]); const int j_=(int)(e_&255u), r_=(int)((e_>>8)&255u), n_=(int)(e_>>16); \
        kind_cur=2; lofs_cur=j_*512+256*r_+32*wid; pos0_cur=256*r_+32*wid; nA_cur=__builtin_amdgcn_readfirstlane((int)((lds_uptr)(shm3+M2_NJ))[2*j_]); nv_cur=n_-32*wid; act_cur=nv_cur>0; \
        if(act_cur){ QLOAD(32*wid+r32); } } } \
    if(GK){DMA_K((t)+3,sl_cur);} if(GV){DMA_V((t)+1,sl_next);} \
    if((RF)&&(((t)&3)==1)&&((t)>>2)>=1&&((t)>>2)-1<NR){ QGATHER(((t)>>2)-1); rf_=true; } \
    if(act_cur||act_old_){ SBAR(); \
    const lds_cptr vp_=vp0+sl_prev; \
    VRD(0); SBAR(); float sacc=(P0[0]+P0[1]); \
    GAPA(C0=__builtin_amdgcn_mfma_f32_32x32x16_bf16(kf[0],qr[0],zc,0,0,0), P0[2],P0[3],P0[4],P0[5],     pw0[0]=PKW(P0,0), pw0[1]=PKW(P0,2), pw0); \
    VRD(4); SBAR(); GAPA(C1=__builtin_amdgcn_mfma_f32_32x32x16_bf16(kf[1],qr[0],zc,0,0,0), P0[6],P0[7],P0[8],P0[9],     pw0[2]=PKW(P0,4), pw0[3]=PKW(P0,6), pw0); \
    VRD(1); SBAR(); GAPA(C0=__builtin_amdgcn_mfma_f32_32x32x16_bf16(kf[2],qr[1],C0,0,0,0),   P0[10],P0[11],P0[12],P0[13], pw1[0]=PKW(P0,8), pw1[1]=PKW(P0,10), pw1); \
    VRD(5); SBAR(); GAPA(C1=__builtin_amdgcn_mfma_f32_32x32x16_bf16(kf[3],qr[1],C1,0,0,0),   P0[14],P0[15],P1[0],P1[1],   pw1[2]=PKW(P0,12),pw1[3]=PKW(P0,14), pw1); \
    VRD(2); SBAR(); GAPA(C0=__builtin_amdgcn_mfma_f32_32x32x16_bf16(kf[4],qr[2],C0,0,0,0),   P1[2],P1[3],P1[4],P1[5],     pw2[0]=PKW(P1,0), pw2[1]=PKW(P1,2), pw2); \
    VRD(6); SBAR(); GAPA(C1=__builtin_amdgcn_mfma_f32_32x32x16_bf16(kf[5],qr[2],C1,0,0,0),   P1[6],P1[7],P1[8],P1[9],     pw2[2]=PKW(P1,4), pw2[3]=PKW(P1,6), pw2); \
    VRD(3); SBAR(); GAPA(C0=__builtin_amdgcn_mfma_f32_32x32x16_bf16(kf[6],qr[3],C0,0,0,0),   P1[10],P1[11],P1[12],P1[13], pw3[0]=PKW(P1,8), pw3[1]=PKW(P1,10), pw3); \
    VRD(7); SBAR(); GAPA(C1=__builtin_amdgcn_mfma_f32_32x32x16_bf16(kf[7],qr[3],C1,0,0,0),   P1[14],P1[15],0.f,0.f,       pw3[2]=PKW(P1,12),pw3[3]=PKW(P1,14), pw3); \
    l_reg+=sacc; \
    float l_old_=0.f,m_old_=0.f; \
    if(bnd_){ l_old_=l_reg; m_old_=mhat; l_reg=0.f; mhat=0.f; }     \
    if((t)<8)cmask(C0,C1,(t)&3,qrel,hi); \
    { float a=MX3(C0[0],C0[1],C1[0]),b=MX3(C0[2],C0[3],C1[1]); a=MX3(a,C1[2],C1[3]); \
      _Pragma("unroll") for(int r=4;r<16;r+=4){a=MX3(a,C0[r],C0[r+1]);b=MX3(b,C0[r+2],C0[r+3]);a=MX3(a,C1[r],C1[r+1]);b=MX3(b,C1[r+2],C1[r+3]);} \
      float rm=__builtin_fmaxf(a,b); { auto rr=__builtin_amdgcn_permlane32_swap(__float_as_uint(rm),__float_as_uint(rm),false,false); rm=__builtin_fmaxf(__uint_as_float(rr[0]),__uint_as_float(rr[1])); } \
      REFUPD(C0,C1,rm,(t)==4); } \
    SBAR(); \
    GAPB(o[0]=__builtin_amdgcn_mfma_f32_32x32x16_bf16(PAF(0),VFR(0),o[0],0,0,0), C0,0); \
    GAPB(o[1]=__builtin_amdgcn_mfma_f32_32x32x16_bf16(PAF(0),VFR(4),o[1],0,0,0), C0,4); \
    KRD(GL,0); GAPB(o[0]=__builtin_amdgcn_mfma_f32_32x32x16_bf16(PAF(1),VFR(1),o[0],0,0,0), C0,8); \
    KRD(GL,1); GAPB(o[1]=__builtin_amdgcn_mfma_f32_32x32x16_bf16(PAF(1),VFR(5),o[1],0,0,0), C0,12); \
    KRD(GL,2); GAPB(o[0]=__builtin_amdgcn_mfma_f32_32x32x16_bf16(PAF(2),VFR(2),o[0],0,0,0), C1,0); \
    KRD(GL,3); GAPB(o[1]=__builtin_amdgcn_mfma_f32_32x32x16_bf16(PAF(2),VFR(6),o[1],0,0,0), C1,4); \
    GAPB(o[0]=__builtin_amdgcn_mfma_f32_32x32x16_bf16(PAF(3),VFR(3),o[0],0,0,0), C1,8); \
    GAPB(o[1]=__builtin_amdgcn_mfma_f32_32x32x16_bf16(PAF(3),VFR(7),o[1],0,0,0), C1,12); \
    if(bnd_){ asm volatile("s_nop 15\n\ts_nop 7":"+v"(o[0]),"+v"(o[1])); \
      if(act_old_){ moba2_flush(o,l_old_,m_old_,kind_old_,(lds_bptr)(shm3+M2_LIST+lofs_old_),pos0_old_,nA_old_,nv_old_,shm3,wsf,wid,r32,hi); } \
      o[0]=f32x16{};o[1]=f32x16{}; } \
    } else { if(GL){kload8(kf,kp0+sl_next);} resc=false; } \
    }while(0)
  int t=1; bool rf_=false;
  for(;t+5<NT;t+=2){
    rf_=false;
    STEP(pB0,pB1,pA0,pA1,t,true,true,true,false,true);   if(rf_){WAIT_BAR(6);}else{WAIT_BAR(2);} RESC(); ROT();
    STEP(pA0,pA1,pB0,pB1,t+1,true,true,true,true,false);  WAIT_BAR(2); RESC(); ROT();
  }
  #define ENDW(tt) do{ if((tt)+3<NT){WAIT_BAR(2);} else if((tt)+2<NT){WAIT_BAR(1);} else {WAIT_BAR(0);} }while(0)
  for(;t+1<NT;t+=2){
    STEP(pB0,pB1,pA0,pA1,t,(t+3<NT),(t+1<NT),(t+1<NT),false,false);       ENDW(t);   RESC(); ROT();
    STEP(pA0,pA1,pB0,pB1,t+1,(t+4<NT),(t+2<NT),(t+2<NT),true,false);       ENDW(t+1); RESC(); ROT();
  }
  STEP(pB0,pB1,pA0,pA1,NT-1,false,false,false,false,false); RESC();
  if(act_cur){ float sacc=pB0[0]+pB0[1]; _Pragma("unroll") for(int r=2;r<16;++r)sacc+=pB0[r]; _Pragma("unroll") for(int r=0;r<16;++r)sacc+=pB1[r]; l_reg+=sacc;
    pw0=(u32x4){PKW(pB0,0),PKW(pB0,2),PKW(pB0,4),PKW(pB0,6)};pw1=(u32x4){PKW(pB0,8),PKW(pB0,10),PKW(pB0,12),PKW(pB0,14)};pw2=(u32x4){PKW(pB1,0),PKW(pB1,2),PKW(pB1,4),PKW(pB1,6)};pw3=(u32x4){PKW(pB1,8),PKW(pB1,10),PKW(pB1,12),PKW(pB1,14)};
    const int vb0=(int)(lds0+LDS_V)+((lane>>4)&1)*32+(lane&3)*8+(4*hi+((lane&15)>>2))*64;
    SBAR(); pv(o,vb0+sl_cur,PAF(0),PAF(1),PAF(2),PAF(3));
    asm volatile("s_nop 15\n\ts_nop 7":"+v"(o[0]),"+v"(o[1]));
    moba2_flush(o,l_reg,mhat,kind_cur,(lds_bptr)(shm3+M2_LIST+lofs_cur),pos0_cur,nA_cur,nv_cur,shm3,wsf,wid,r32,hi); }
  #undef PKW
  #undef PAF
  #undef VFR
  #undef PIN
  #undef MX3
  #undef GAPA
  #undef GAPB
  #undef EX
  #undef VRD
  #undef KRD
  #undef STEP
  #undef ENDW
  #undef QGATHER
  asm volatile("s_waitcnt lgkmcnt(0)\n\ts_barrier":::"memory");
#ifdef M2_DUPEPI
  for(int rep_=0;rep_<2;++rep_)
#endif
  { const int hd=wid>>2; long grow0=rowbase+q0+(wid&3)*64; asm volatile("":"+v"(grow0));
    const lds_uptr acc=(lds_uptr)(shm3+M2_ACC)+wid*2048; const lds_fptr lacc=(lds_fptr)(shm3+M2_LACC)+wid*64;
    #pragma unroll
    for(int ib=0;ib<8;ib+=4){
      u32x4 zv[4];
      #pragma unroll
      for(int i=0;i<4;++i){const int row=(ib+i)*8+(lane>>3),ch=lane&7; zv[i]=*(const u32x4*)(Z+(grow0+row)*ADM+(hA+hd)*D+ch*8);}
      #pragma unroll
      for(int i=0;i<4;++i){const int row=(ib+i)*8+(lane>>3),ch=lane&7;
        const u32x4 a0=*(const __attribute__((address_space(3))) u32x4*)(acc+row*32+8*(ch&3)),a1=*(const __attribute__((address_space(3))) u32x4*)(acc+row*32+8*(ch&3)+4);
        const float li=__builtin_amdgcn_rcpf(lacc[row]); const bool up=ch>=4;
        float ov[8]; ov[0]=__uint_as_float(up?(a0.x&0xffff0000u):(a0.x<<16));ov[1]=__uint_as_float(up?(a0.y&0xffff0000u):(a0.y<<16));ov[2]=__uint_as_float(up?(a0.z&0xffff0000u):(a0.z<<16));ov[3]=__uint_as_float(up?(a0.w&0xffff0000u):(a0.w<<16));
        ov[4]=__uint_as_float(up?(a1.x&0xffff0000u):(a1.x<<16));ov[5]=__uint_as_float(up?(a1.y&0xffff0000u):(a1.y<<16));ov[6]=__uint_as_float(up?(a1.z&0xffff0000u):(a1.z<<16));ov[7]=__uint_as_float(up?(a1.w&0xffff0000u):(a1.w<<16));
        float zf[8]; zf[0]=__uint_as_float(zv[i].x<<16);zf[1]=__uint_as_float(zv[i].x&0xffff0000u);zf[2]=__uint_as_float(zv[i].y<<16);zf[3]=__uint_as_float(zv[i].y&0xffff0000u);
        zf[4]=__uint_as_float(zv[i].z<<16);zf[5]=__uint_as_float(zv[i].z&0xffff0000u);zf[6]=__uint_as_float(zv[i].w<<16);zf[7]=__uint_as_float(zv[i].w&0xffff0000u);
        float gv[8];
        #pragma unroll
        for(int e=0;e<8;++e)gv[e]=ov[e]*li*zf[e]*__builtin_amdgcn_rcpf(1.0f+__builtin_amdgcn_exp2f(-1.4426950408889634f*zf[e]));
        u32x4 w; w.x=cvtpk_s(gv[0],gv[1]);w.y=cvtpk_s(gv[2],gv[3]);w.z=cvtpk_s(gv[4],gv[5]);w.w=cvtpk_s(gv[6],gv[7]);
        *(u32x4*)(G+(grow0+row)*ADM+(hA+hd)*D+ch*8)=w;} } }
  asm volatile("s_waitcnt lgkmcnt(0)\n\ts_barrier":::"memory");
  #undef DMA_K
  #undef DMA_V
  #undef KT
  #undef QLOAD
  #undef REFUPD
  #undef RESC
  #undef ROT
}
#undef SBAR
#undef WAIT_BAR
constexpr int ATTN_LDS_BYTES=LDS_BYTES_MOBA2;
}

#define GAS __attribute__((address_space(1)))
#define LAS __attribute__((address_space(3)))
typedef unsigned short bf16;
typedef unsigned v4u __attribute__((ext_vector_type(4)));
typedef float f32x4 __attribute__((ext_vector_type(4)));
typedef short bf16x8 __attribute__((ext_vector_type(8)));
typedef GAS unsigned gu32;
typedef GAS unsigned long long gu64;
#define RLX_AGENT __ATOMIC_RELAXED, __HIP_MEMORY_SCOPE_AGENT
#define LDS_WAIT() asm volatile("s_waitcnt lgkmcnt(0)" ::: "memory")
#define VM_WAIT() asm volatile("s_waitcnt vmcnt(0)" ::: "memory")
__device__ __forceinline__ unsigned long long rt() { return __builtin_amdgcn_s_memrealtime(); }
__device__ __forceinline__ unsigned pk2(float lo, float hi) { return f2bf(lo) | (f2bf(hi) << 16); }

#define XB_TMO      128
#define XB_XCNT(j)  (256  + 64 * (j))
#define XB_XSUB(j)  (1280 + 64 * (j))
#define XB_XGEN(j)  (2304 + 64 * (j))
#define XB_TOP      3328
#define XB_TOPGEN   3392
#define XCD_BAR_WORDS 3456
#define XB_SPIN_CAP (1u << 18)

__device__ __forceinline__ unsigned xb_ld(unsigned* p)              { return __hip_atomic_load(p, __ATOMIC_RELAXED, __HIP_MEMORY_SCOPE_AGENT); }
__device__ __forceinline__ unsigned xb_add(unsigned* p, unsigned v) { return __hip_atomic_fetch_add(p, v, __ATOMIC_RELAXED, __HIP_MEMORY_SCOPE_AGENT); }
__device__ __forceinline__ unsigned xb_xcc_id() { return (unsigned)__builtin_amdgcn_s_getreg((3 << 11) | 20) & 0xFu; }
#define XB_SPIN(cond, bar) do { unsigned _sp = 0; while (cond) { __builtin_amdgcn_s_sleep(1); \
    if ((++_sp & 255u) == 0u) { if (xb_ld(&(bar)[XB_TMO])) break; if (_sp > XB_SPIN_CAP) { atomicAdd(&(bar)[XB_TMO], 1u); break; } } } } while (0)

struct XcdBarrier {
    unsigned* bar; unsigned x;
    volatile LAS unsigned* st;
};

__device__ __forceinline__ XcdBarrier xcd_barrier_post(unsigned* bar, volatile LAS unsigned* st) {
    XcdBarrier b; b.bar = bar; b.x = xb_xcc_id(); b.st = st;
    if (threadIdx.x == 0) (void)xb_add(&bar[XB_XCNT(b.x)], 1u);
    return b;
}
__device__ __forceinline__ void xcd_barrier_complete(unsigned* bar, unsigned x, unsigned& nloc, unsigned& nx) {
    const unsigned G = gridDim.x * gridDim.y * gridDim.z;
    unsigned sum, cnt, mine, sp = 0u;
    for (;;) {
        sum = 0u; cnt = 0u; mine = 0u;
#pragma unroll
        for (unsigned j = 0; j < 16; ++j) { const unsigned c = xb_ld(&bar[XB_XCNT(j)]); sum += c; cnt += (c > 0u) ? 1u : 0u; mine = (j == x) ? c : mine; }
        if (sum == G) break;
        __builtin_amdgcn_s_sleep(1);
        if ((++sp & 255u) == 0u) { if (xb_ld(&bar[XB_TMO])) break; if (sp > XB_SPIN_CAP) { atomicAdd(&bar[XB_TMO], 1u); break; } }
    }
    nloc = mine > 0u ? mine : 1u; nx = cnt > 0u ? cnt : 1u;
}

__device__ __forceinline__ void xcd_barrier(const XcdBarrier& b) {
    asm volatile("s_waitcnt vmcnt(0)" ::: "memory");
    __syncthreads();
    if (threadIdx.x == 0) {
        unsigned* bar = b.bar;
        __builtin_amdgcn_s_waitcnt(0);
        unsigned nloc = b.st[0], nx = b.st[1];
        if (nloc == 0u) { xcd_barrier_complete(bar, b.x, nloc, nx); b.st[0] = nloc; b.st[1] = nx; }
        const unsigned old = xb_add(&bar[XB_XSUB(b.x)], 1u);
        const unsigned gen = old / nloc;
        if (old + 1u == (gen + 1u) * nloc) {
            __builtin_amdgcn_fence(__ATOMIC_RELEASE, "agent");
            asm volatile("s_waitcnt vmcnt(0)" ::: "memory");
            const unsigned og = xb_add(&bar[XB_TOP], 1u);
            const unsigned tg = og / nx;
            if (og + 1u == (tg + 1u) * nx) xb_add(&bar[XB_TOPGEN], 1u);
            else XB_SPIN(xb_ld(&bar[XB_TOPGEN]) == tg, bar);
            __builtin_amdgcn_fence(__ATOMIC_ACQUIRE, "agent");
            xb_add(&bar[XB_XGEN(b.x)], 1u);
            asm volatile("s_waitcnt vmcnt(0)" ::: "memory");
        } else {
            XB_SPIN(xb_ld(&bar[XB_XGEN(b.x)]) == gen, bar);
            __builtin_amdgcn_fence(__ATOMIC_ACQUIRE, "agent");
            asm volatile("s_waitcnt vmcnt(0)" ::: "memory");
        }
    }
    __syncthreads();
}

constexpr int NWAVES = 8;
#ifndef MK_EN
#define MK_EN 15
#endif
constexpr int NPH = 14;
constexpr int RING_OFF = 0, RING_BYTES = 131072;
constexpr int LDS_BYTES = 163840;
constexpr int LDSCTL_OFF = LDS_BYTES - 512, MISC_OFF = LDSCTL_OFF + 320;
constexpr int CW_TMO = 0, CW_BAR = 4096;
constexpr size_t CTL_ZERO_BYTES = 64 * 1024;
static_assert((CW_BAR + XCD_BAR_WORDS) * 4 <= (int)CTL_ZERO_BYTES, "barrier words inside the memset region");
static_assert(attn_body::ATTN_LDS_BYTES <= LDSCTL_OFF && attn_body::LDS_BYTES <= RING_BYTES, "attention LDS");

__constant__ const unsigned ROPE_INV_BITS[32] = {0x3f800000u, 0x3f3ff911u, 0x3f0ff59au, 0x3ed7e89bu, 0x3ea1e89bu, 0x3e72d424u, 0x3e361887u, 0x3e088d77u, 0x3dcccccdu, 0x3d99940eu, 0x3d6655c3u, 0x3d2cba15u, 0x3d0186e2u, 0x3cc24350u, 0x3c91ad39u, 0x3c5a7bf1u,
    0x3c23d70au, 0x3bf5b9b0u, 0x3bb8449cu, 0x3b8a2e77u, 0x3b4f3e37u, 0x3b1b690du, 0x3ae91528u, 0x3aaec98eu, 0x3a83126fu, 0x3a44948cu, 0x3a136a16u, 0x39dd1726u, 0x39a5cb5fu, 0x3978a814u, 0x393a7753u, 0x390bd472u};
struct Args { const float* in[7]; float* out; unsigned char* ws; int ph_lo, ph_hi; };

__device__ __forceinline__ void p0_w_item(const float* __restrict__ W, int ldw, int k0, int n0, bool perm, const float* __restrict__ g, bf16_t* __restrict__ Wt, LAS float* scr, int lane) {
#pragma unroll
    for (int kb = 0; kb < 64; kb += 32) { float wv[32];
#pragma unroll
        for (int kk = 0; kk < 32; ++kk) wv[kk] = W[(size_t)(k0 + kb + kk) * ldw + n0 + lane];
#pragma unroll
        for (int kk = 0; kk < 32; ++kk) { const float gv = g ? g[k0 + kb + kk] : 1.0f; scr[(kb + kk) * 65 + lane] = wv[kk] * gv; } }
    LDS_WAIT(); asm volatile("" ::: "memory");
    const int c = lane & 7;
#pragma unroll
    for (int j = 0; j < 8; ++j) { const int n = (lane >> 3) + 8 * j; const int sc = perm ? dmap(n) : n; const LAS float* s = scr + (8 * c) * 65 + sc;
        v4u o; o.x = pk2(s[0 * 65], s[1 * 65]); o.y = pk2(s[2 * 65], s[3 * 65]); o.z = pk2(s[4 * 65], s[5 * 65]); o.w = pk2(s[6 * 65], s[7 * 65]);
        *(GAS v4u*)(Wt + (size_t)(n0 + n) * 1024 + k0 + 8 * c) = o; }
    LDS_WAIT(); asm volatile("" ::: "memory");
}

__global__ void __launch_bounds__(NWAVES * 64, 2) mk_fwd(Args args) {
    extern __shared__ __attribute__((aligned(16))) unsigned char lds[];
    LAS unsigned char* ldsp = (LAS unsigned char*)lds;
    volatile LAS unsigned* MISC = (volatile LAS unsigned*)(ldsp + MISC_OFF);
    const int tid0 = threadIdx.x;
    gu32* ctl = (gu32*)(args.ws + WS_CTL);
    for (int u = tid0; u < (LDS_BYTES - LDSCTL_OFF) / 4; u += NWAVES * 64) ((LAS unsigned*)(ldsp + LDSCTL_OFF))[u] = 0u;
    __syncthreads();
    const int lo = args.ph_lo, hi = args.ph_hi;
    XcdBarrier bar; bar.bar = (unsigned*)(ctl + CW_BAR); bar.x = 0; bar.st = nullptr;
    if (hi - lo > 1) bar = xcd_barrier_post((unsigned*)(ctl + CW_BAR), MISC + 8);

#ifndef MK_DUP
#define MK_DUP (-1)
#endif
    for (int pk = lo; pk < hi + (MK_DUP >= 0 ? 1 : 0); ++pk) {
        const int p = (MK_DUP >= 0 && pk > MK_DUP) ? pk - 1 : pk;
        int tid = threadIdx.x, G = gridDim.x, bx = blockIdx.x; asm volatile("" : "+v"(tid), "+s"(G), "+s"(bx));
        const int lane = tid & 63, wave = __builtin_amdgcn_readfirstlane(tid >> 6);
        const int vcu = (G % 8 == 0) ? (bx % 8) * (G / 8) + bx / 8 : bx;
        const int gw = vcu * NWAVES + wave, NGW = G * NWAVES;
        GAS unsigned char* wsg = (GAS unsigned char*)args.ws; asm volatile("" : "+s"(wsg)); unsigned char* ws = (unsigned char*)wsg;
#define xin (args.in[0])
#define norm_g (args.in[1])
#define w_in_a (args.in[2])
#define sinks_a (args.in[3])
#define w_in_b (args.in[4])
#define w_out (args.in[5])
#define final_g (args.in[6])
#define H (args.out)
#define rope ((float*)(ws + WS_ROPE))
#define ss ((float*)(ws + WS_SS))
#define KS ((float*)(ws + WS_KS))
#define Hb ((bf16_t*)(ws + WS_HB))
#define Qb ((bf16_t*)(ws + WS_Q))
#define Zb ((bf16_t*)(ws + WS_Z))
#define Gb ((bf16_t*)(ws + WS_G))
#define Kb ((bf16_t*)(ws + WS_K))
#define Vb ((bf16_t*)(ws + WS_V))
        if (p == 0) {
            for (int idx = bx * (NWAVES * 64) + tid; idx < SEQ * 32; idx += G * NWAVES * 64) {
                const int pos = idx >> 5, i = idx & 31;
                const float ang = (float)pos * __uint_as_float(ROPE_INV_BITS[i]);
                float sn, cs; sincosf(ang, &sn, &cs);
                rope[2 * idx] = cs; rope[2 * idx + 1] = sn;
            }
            LAS float* scr = (LAS float*)(ldsp + RING_OFF + wave * 16640);
            constexpr int I_A = (IN_A / 64) * 16, I_B = (IN_B / 64) * 16, I_O = 256, I_L2 = I_A + I_O + I_B + I_O, NITEMS = 2 * I_L2;
            for (int it = gw; it < NITEMS; it += NGW) {
                const int l2 = it / I_L2; int r = it % I_L2; int l; bool isw2 = false; int IN = IN_A;
                if (r < I_A) { l = 2 * l2; }
                else if (r < I_A + I_O) { r -= I_A; l = 2 * l2; isw2 = true; }
                else if (r < I_A + I_O + I_B) { r -= I_A + I_O; l = 2 * l2 + 1; IN = IN_B; }
                else { r -= I_A + I_O + I_B; l = 2 * l2 + 1; isw2 = true; }
                const int cg = r >> 4, kg = r & 15;
                if (isw2) p0_w_item(w_out + (size_t)l * DM * DM, DM, kg * 64, cg * 64, false, nullptr, (bf16_t*)(ws + WS_W2T + l * W2T_STRIDE), scr, lane);
                else { const float* Win = (l & 1) ? w_in_b + (size_t)l2 * DM * IN_B : w_in_a + (size_t)l2 * DM * IN_A; const int kvw = (l & 1) ? 256 : 128;
                       p0_w_item(Win, IN, kg * 64, cg * 64, cg * 64 < 1024 + kvw, norm_g + l * DM, (bf16_t*)(ws + WS_W1T + l * W1T_STRIDE), scr, lane); }
            }
            for (int row = gw; row < M; row += 2 * NGW) {
                const int row2 = row + NGW; const bool two = row2 < M;
                const f32x4* xr = (const f32x4*)(xin + (size_t)row * DM) + lane; const f32x4* xr2 = (const f32x4*)(xin + (size_t)(two ? row2 : row) * DM) + lane;
                f32x4 va[4], vb[4];
#pragma unroll
                for (int j = 0; j < 4; ++j) { va[j] = xr[64 * j]; vb[j] = xr2[64 * j]; }
                float s = 0.f, s2 = 0.f;
                unsigned long long* o8 = (unsigned long long*)(Hb + (size_t)row * DM) + lane; unsigned long long* o82 = (unsigned long long*)(Hb + (size_t)row2 * DM) + lane;
#pragma unroll
                for (int j = 0; j < 4; ++j) { const f32x4 v = va[j]; s += (v[0] * v[0] + v[1] * v[1]) + (v[2] * v[2] + v[3] * v[3]);
                    o8[64 * j] = (unsigned long long)pk2(v[0], v[1]) | ((unsigned long long)pk2(v[2], v[3]) << 32);
                    const f32x4 w = vb[j]; s2 += (w[0] * w[0] + w[1] * w[1]) + (w[2] * w[2] + w[3] * w[3]);
                    if (two) o82[64 * j] = (unsigned long long)pk2(w[0], w[1]) | ((unsigned long long)pk2(w[2], w[3]) << 32); }
                s = wave_sum(s); s2 = wave_sum(s2);
                if (lane < 16) { ss[(size_t)row * 16 + lane] = lane == 0 ? s : 0.f; if (two) ss[(size_t)row2 * 16 + lane] = lane == 0 ? s2 : 0.f; }
            }
        } else if (p == NPH - 1) {
            for (int row = gw; row < M; row += NGW) {
                f32x4* hr = (f32x4*)(H + (size_t)row * DM) + lane; const f32x4* gr = (const f32x4*)final_g + lane;
                f32x4 v[4]; float s = 0.f;
#pragma unroll
                for (int j = 0; j < 4; ++j) { v[j] = hr[64 * j]; s += (v[j][0] * v[j][0] + v[j][1] * v[j][1]) + (v[j][2] * v[j][2] + v[j][3] * v[j][3]); }
                const float rstd = __builtin_amdgcn_rsqf(wave_sum(s) * (1.0f / DM) + EPS);
#pragma unroll
                for (int j = 0; j < 4; ++j) hr[64 * j] = v[j] * rstd * gr[64 * j];
            }
        } else {
            const int l = (p - 1) / 3, kind = (p - 1) % 3; const bool isB = l & 1;
            if (kind == 0) {
                const bf16_t* W1t = (const bf16_t*)(ws + WS_W1T + l * W1T_STRIDE);
                if (!(MK_EN & 1)) {} else if (!isB) { pg8::Gemm g{Hb, W1t, M, IN_A, DM}; pg8::StaticOrder S; S.init(M, IN_A, G, bx);
                    pg8::EpiG1<2> E{Qb, Kb, Vb, Zb, ss, rope, KS};
                    pg8::gemm_phase<pg8::EpiG1<2>, pg8::StaticOrder, true, true>(ldsp + RING_OFF, g, S, E);
                } else { pg8::Gemm g{Hb, W1t, M, IN_B, DM}; pg8::StaticOrder S; S.init(M, IN_B, G, bx);
                    pg8::EpiG1<4> E{Qb, Kb, Vb, Zb, ss, rope, KS};
                    pg8::gemm_phase<pg8::EpiG1<4>, pg8::StaticOrder, true, true>(ldsp + RING_OFF, g, S, E); }
            } else if (kind == 1) {
                if (!isB) { if (MK_EN & 2)
                    for (int U = vcu; U < 2048; U += G) { const int vc = U & 255, i = U >> 8; const int bp = vc >> 2, qb = (vc & 3) * 8 + i;
                        attn_body::attn_unit<0, 8>(bp >> 3, (bp & 7) * 2, qb, Qb, Kb, Vb, Zb, Gb, sinks_a + (l >> 1) * NH, (char*)lds + RING_OFF); }
                } else { if (MK_EN & 4)
                    for (int U = vcu; U < 1024; U += G) { const int vc = U & 255, i = U >> 8; const int grp = vc >> 2, c4 = vc & 3;
                        const int x = c4 == 0 ? 5 : c4 == 1 ? 4 : c4 == 2 ? 6 : 7; const int qb = i == 0 ? c4 : i == 1 ? 15 - c4 : i == 2 ? x : 15 - x;
                        attn_body::attn_unit_moba2<8>(grp >> 3, grp & 7, qb, Qb, Kb, Vb, Zb, Gb, KS, (char*)lds + RING_OFF); }
                }
            } else {
                const bf16_t* W2t = (const bf16_t*)(ws + WS_W2T + l * W2T_STRIDE);
                if (MK_EN & 8) {
                pg8::Gemm g{Gb, W2t, M, DM, DM}; pg8::StaticOrder S; S.init(M, DM, G, bx);
                if (l == 0) { pg8::EpiG2<true, false> E{xin, H, Hb, ss}; pg8::gemm_phase<pg8::EpiG2<true, false>, pg8::StaticOrder, true, true>(ldsp + RING_OFF, g, S, E); }
                else if (l < DEPTH - 1) { pg8::EpiG2<false, false> E{xin, H, Hb, ss}; pg8::gemm_phase<pg8::EpiG2<false, false>, pg8::StaticOrder, true, true>(ldsp + RING_OFF, g, S, E); }
                else { pg8::EpiG2<false, true> E{xin, H, Hb, ss}; pg8::gemm_phase<pg8::EpiG2<false, true>, pg8::StaticOrder, true, true>(ldsp + RING_OFF, g, S, E); } }
            }
        }
        if (pk + 1 < hi + (MK_DUP >= 0 ? 1 : 0)) { XcdBarrier b2 = bar; GAS unsigned* bg = (GAS unsigned*)bar.bar; asm volatile("" : "+s"(bg), "+s"(b2.x)); b2.bar = (unsigned*)bg; xcd_barrier(b2); }
    }
#undef xin
#undef norm_g
#undef w_in_a
#undef sinks_a
#undef w_in_b
#undef w_out
#undef final_g
#undef H
#undef rope
#undef ss
#undef KS
#undef Hb
#undef Qb
#undef Zb
#undef Gb
#undef Kb
#undef Vb
}

#ifndef MK_FAST_MASK
#define MK_FAST_MASK 0x3fff
#endif
#ifndef MK_ONE_LAUNCH
#define MK_ONE_LAUNCH 1
#endif
extern "C" void kernel_launch(void* const* d_in, const int* in_sizes, int n_in, void* d_out, int out_size, void* d_ws, size_t ws_size, hipStream_t stream) {
    static int grid = 0;
    if (grid == 0) {
        if (n_in != 7 || in_sizes[0] != M * DM || out_size != M * DM || ws_size < WS_END) { fprintf(stderr, "kernel_launch: unexpected shapes (n_in %d, in0 %d, out %d, ws %zu)\n", n_in, n_in > 0 ? in_sizes[0] : -1, out_size, ws_size); grid = -1; return; }
        int dev = 0, cus = 0, per_cu = 0;
        if (hipGetDevice(&dev) != hipSuccess || hipDeviceGetAttribute(&cus, hipDeviceAttributeMultiprocessorCount, dev) != hipSuccess) { grid = -1; return; }
        if (hipFuncSetAttribute((const void*)mk_fwd, hipFuncAttributeMaxDynamicSharedMemorySize, LDS_BYTES) != hipSuccess) { fprintf(stderr, "kernel_launch: hipFuncSetAttribute failed\n"); grid = -1; return; }
        if (hipOccupancyMaxActiveBlocksPerMultiprocessor(&per_cu, (const void*)mk_fwd, NWAVES * 64, LDS_BYTES) != hipSuccess || per_cu < 1) fprintf(stderr, "kernel_launch: occupancy query reports %d blocks per CU\n", per_cu);
        (void)hipGetLastError();
        grid = cus;
    }
    if (grid < 0) return;
    const float* x = (const float*)d_in[0]; const float* norm_g = (const float*)d_in[1]; const float* w_in_a = (const float*)d_in[2]; const float* sinks_a = (const float*)d_in[3];
    const float* w_in_b = (const float*)d_in[4]; const float* w_out = (const float*)d_in[5]; const float* final_g = (const float*)d_in[6];
    unsigned char* ws = (unsigned char*)d_ws; float* H = (float*)d_out;
    (void)hipMemsetAsync(ws + WS_CTL, 0, CTL_ZERO_BYTES, stream);
    Args a{};
    for (int i = 0; i < 7; ++i) a.in[i] = (const float*)d_in[i];
    a.out = H; a.ws = ws;
    if (MK_ONE_LAUNCH && MK_FAST_MASK == 0x3fff) { a.ph_lo = 0; a.ph_hi = NPH; hipLaunchKernelGGL(mk_fwd, dim3(grid), dim3(NWAVES * 64), LDS_BYTES, stream, a); return; }
    float2* rope = (float2*)(ws + WS_ROPE); float* ss = (float*)(ws + WS_SS); float* KS = (float*)(ws + WS_KS);
    bf16_t* Hb = (bf16_t*)(ws + WS_HB); bf16_t* Qb = (bf16_t*)(ws + WS_Q); bf16_t* Zb = (bf16_t*)(ws + WS_Z); bf16_t* Gb = (bf16_t*)(ws + WS_G); bf16_t* Kb = (bf16_t*)(ws + WS_K); bf16_t* Vb = (bf16_t*)(ws + WS_V);
    for (int p = 0; p < NPH; ++p) {
        if ((MK_FAST_MASK >> p) & 1) { a.ph_lo = p; a.ph_hi = p + 1; hipLaunchKernelGGL(mk_fwd, dim3(grid), dim3(NWAVES * 64), LDS_BYTES, stream, a); continue; }
        if (p == 0) {
            k_prep_rope<<<SEQ * 32 / 256, 256, 0, stream>>>(rope);
            for (int l = 0; l < DEPTH; ++l) { const bool isB = l & 1; const int IN = isB ? IN_B : IN_A, KVW = isB ? 256 : 128;
                const float* Win = (isB ? w_in_b : w_in_a) + (size_t)(l >> 1) * DM * IN;
                k_prep_w1<<<(unsigned)(((size_t)IN * DM + 255) / 256), 256, 0, stream>>>(Win, norm_g + l * DM, (bf16_t*)(ws + WS_W1T + l * W1T_STRIDE), IN, KVW);
                k_prep_w2<<<DM * DM / 256, 256, 0, stream>>>(w_out + (size_t)l * DM * DM, (bf16_t*)(ws + WS_W2T + l * W2T_STRIDE)); }
            k_prep_x<<<M / 4, 256, 0, stream>>>(x, Hb, ss);
        } else if (p == NPH - 1) { k_final<<<M / 4, 256, 0, stream>>>(H, final_g);
        } else { const int l = (p - 1) / 3, kind = (p - 1) % 3; const bool isB = l & 1;
            const bf16_t* W1t = (const bf16_t*)(ws + WS_W1T + l * W1T_STRIDE); const bf16_t* W2t = (const bf16_t*)(ws + WS_W2T + l * W2T_STRIDE);
            if (kind == 0) { if (!isB) k_gemm1_naive<2><<<(M / 16) * (IN_A / 64) / 4, 256, 0, stream>>>(Hb, W1t, ss, rope, Qb, Kb, Vb, Zb);
                             else { k_gemm1_naive<4><<<(M / 16) * (IN_B / 64) / 4, 256, 0, stream>>>(Hb, W1t, ss, rope, Qb, Kb, Vb, Zb); k_ksum_naive<<<BATCH * NBLK, 256, 0, stream>>>(Kb, KS); } }
            else if (kind == 1) { if (!isB) k_attn_swa_naive<<<M * NH / 4, 256, 0, stream>>>(Qb, Kb, Vb, Zb, sinks_a + (l >> 1) * NH, Gb); else k_attn_moba_naive<<<M * NH / 4, 256, 0, stream>>>(Qb, Kb, Vb, Zb, KS, Gb); }
            else k_gemm2_naive<<<(M / 16) * 16 / 4, 256, 0, stream>>>(Gb, W2t, l == 0 ? x : H, H, Hb, ss);
        }
    }
}
```

```cpp
#define MK_FAST_MASK 0x3fff
#define MK_ONE_LAUNCH 1
#include <hip/hip_runtime.h>
#include <cstdint>
#include <cstdio>

typedef unsigned short bf16_t;
typedef short bf16x8 __attribute__((ext_vector_type(8)));
typedef float f32x4 __attribute__((ext_vector_type(4)));
typedef unsigned u32x4 __attribute__((ext_vector_type(4)));

constexpr int BATCH = 8, SEQ = 4096, DM = 1024, DEPTH = 4, HD = 64, NH = 16;
constexpr int M = BATCH * SEQ;
constexpr int IN_A = 2304, IN_B = 2560;
constexpr int WINDOW = 128, MBLK = 256, NBLK = SEQ / MBLK;
constexpr float EPS = 1e-5f;
constexpr float LOG2E = 1.4426950408889634f;
constexpr float C2 = 0.125f * LOG2E;

constexpr size_t MiB = 1u << 20;
constexpr size_t WS_CTL = 0, WS_ROPE = 1 * MiB, WS_W1T = 2 * MiB, WS_W2T = 22 * MiB, WS_SS = 30 * MiB, WS_KS = 32 * MiB;
constexpr size_t WS_HB = 64 * MiB, WS_Q = 128 * MiB, WS_Z = 192 * MiB, WS_G = 256 * MiB, WS_K = 320 * MiB, WS_V = 336 * MiB, WS_END = 352 * MiB;
constexpr size_t W1T_STRIDE = 5 * MiB, W2T_STRIDE = 2 * MiB;

__device__ __forceinline__ unsigned f2bf(float f) { unsigned u = __builtin_bit_cast(unsigned, f); return (u + 0x7fffu + ((u >> 16) & 1u)) >> 16; }
__device__ __forceinline__ float bf2f(unsigned h) { return __builtin_bit_cast(float, h << 16); }
__host__ __device__ __forceinline__ int dmap(int cc) { return (((cc >> 2) & 1) << 5) | ((cc >> 5) << 4) | (((cc >> 3) & 3) << 2) | (cc & 3); }
__host__ __device__ __forceinline__ int dinv(int d) { return (((d >> 4) & 1) << 5) | (((d >> 2) & 3) << 3) | ((d >> 5) << 2) | (d & 3); }
__device__ __forceinline__ float wave_sum(float v) {
#pragma unroll
    for (int o = 1; o < 64; o <<= 1) v += __shfl_xor(v, o);
    return v;
}
__device__ __forceinline__ float wave_max(float v) {
#pragma unroll
    for (int o = 1; o < 64; o <<= 1) v = fmaxf(v, __shfl_xor(v, o));
    return v;
}

__global__ void k_prep_rope(float2* tab) {
    const int idx = blockIdx.x * blockDim.x + threadIdx.x; if (idx >= SEQ * 32) return;
    const int pos = idx >> 5, i = idx & 31;
    const float inv = (float)pow(10000.0, -(double)i / 32.0);
    const float ang = (float)pos * inv;
    tab[idx] = make_float2((float)cos((double)ang), (float)sin((double)ang));
}
__global__ void k_prep_w1(const float* __restrict__ Win, const float* __restrict__ g, bf16_t* __restrict__ W1t, int IN, int KVW) {
    const size_t idx = (size_t)blockIdx.x * blockDim.x + threadIdx.x; if (idx >= (size_t)IN * DM) return;
    const int cp = (int)(idx / DM), k = (int)(idx % DM);
    int col = cp;
    if (cp < 1024 + KVW) col = (cp & ~63) + dmap(cp & 63);
    W1t[idx] = (bf16_t)f2bf(g[k] * Win[(size_t)k * IN + col]);
}
__global__ void k_prep_w2(const float* __restrict__ Wout, bf16_t* __restrict__ W2t) {
    const size_t idx = (size_t)blockIdx.x * blockDim.x + threadIdx.x; if (idx >= (size_t)DM * DM) return;
    const int n = (int)(idx / DM), k = (int)(idx % DM);
    W2t[idx] = (bf16_t)f2bf(Wout[(size_t)k * DM + n]);
}
__global__ void k_prep_x(const float* __restrict__ x, bf16_t* __restrict__ Hb, float* __restrict__ ss) {
    const int row = (blockIdx.x * blockDim.x + threadIdx.x) >> 6, lane = threadIdx.x & 63; if (row >= M) return;
    const f32x4* xr = (const f32x4*)(x + (size_t)row * DM) + lane; float s = 0.f;
    unsigned long long* o8 = (unsigned long long*)(Hb + (size_t)row * DM) + lane;
#pragma unroll
    for (int j = 0; j < 4; ++j) { const f32x4 v = xr[64 * j]; s += (v.x * v.x + v.y * v.y) + (v.z * v.z + v.w * v.w);
        o8[64 * j] = (unsigned long long)(f2bf(v.x) | (f2bf(v.y) << 16)) | ((unsigned long long)(f2bf(v.z) | (f2bf(v.w) << 16)) << 32); }
    s = wave_sum(s);
    if (lane < 16) ss[(size_t)row * 16 + lane] = lane == 0 ? s : 0.f;
}

template <int KVH>
__global__ __launch_bounds__(256) void k_gemm1_naive(const bf16_t* __restrict__ Hb, const bf16_t* __restrict__ W1t, const float* __restrict__ ss, const float2* __restrict__ rope,
                                                     bf16_t* __restrict__ Q, bf16_t* __restrict__ K, bf16_t* __restrict__ V, bf16_t* __restrict__ Z) {
    constexpr int KVW = KVH * 64, IN = 2048 + 2 * KVW, NG = IN / 64;
    const int wave = (int)(((size_t)blockIdx.x * 256 + threadIdx.x) >> 6), lane = threadIdx.x & 63;
    const int rt = wave / NG, cg = wave % NG; if (rt >= M / 16) return;
    const int row0 = rt * 16, lr = lane & 15, lq = lane >> 4;
    const bool rot = cg < 16 + KVH;
    f32x4 acc[4];
#pragma unroll
    for (int nb = 0; nb < 4; ++nb) acc[nb] = (f32x4){0.f, 0.f, 0.f, 0.f};
    const bf16_t* ap = Hb + (size_t)(row0 + lr) * DM + 8 * lq;
    const bf16_t* bp[4];
#pragma unroll
    for (int nb = 0; nb < 4; ++nb) { const int d = 16 * nb + lr; bp[nb] = W1t + (size_t)(cg * 64 + (rot ? dinv(d) : d)) * DM + 8 * lq; }
    for (int k0 = 0; k0 < DM; k0 += 32) {
        const bf16x8 a = *(const bf16x8*)(ap + k0);
#pragma unroll
        for (int nb = 0; nb < 4; ++nb) { const bf16x8 b = *(const bf16x8*)(bp[nb] + k0); acc[nb] = __builtin_amdgcn_mfma_f32_16x16x32_bf16(a, b, acc[nb], 0, 0, 0); }
    }
#pragma unroll
    for (int reg = 0; reg < 4; ++reg) {
        const int row = row0 + 4 * lq + reg, pos = row & (SEQ - 1);
        const f32x4* sp = (const f32x4*)(ss + (size_t)row * 16);
        const f32x4 s0 = sp[0], s1 = sp[1], s2 = sp[2], s3 = sp[3];
        const float tot = ((s0.x + s0.y) + (s0.z + s0.w)) + ((s1.x + s1.y) + (s1.z + s1.w)) + ((s2.x + s2.y) + (s2.z + s2.w)) + ((s3.x + s3.y) + (s3.z + s3.w));
        const float rstd = rsqrtf(tot * (1.0f / DM) + EPS);
        if (rot) {
            const bool isq = cg < 16; const float sc = isq ? rstd * C2 : rstd;
            bf16_t* dst = isq ? Q + (size_t)row * DM + cg * 64 : K + (size_t)row * KVW + (cg - 16) * 64;
#pragma unroll
            for (int nb = 0; nb < 2; ++nb) { const int i = 16 * nb + lr; const float2 cs = rope[pos * 32 + i];
                const float x1 = acc[nb][reg] * sc, x2 = acc[nb + 2][reg] * sc;
                dst[i] = (bf16_t)f2bf(x1 * cs.x - x2 * cs.y); dst[i + 32] = (bf16_t)f2bf(x2 * cs.x + x1 * cs.y); }
        } else {
            const bool isv = cg < 16 + 2 * KVH;
            bf16_t* dst = isv ? V + (size_t)row * KVW + (cg - 16 - KVH) * 64 : Z + (size_t)row * DM + (cg - 16 - 2 * KVH) * 64;
#pragma unroll
            for (int nb = 0; nb < 4; ++nb) dst[16 * nb + lr] = (bf16_t)f2bf(acc[nb][reg] * rstd);
        }
    }
}
__global__ void k_ksum_naive(const bf16_t* __restrict__ K, float* __restrict__ KS) {
    const int bb = blockIdx.x, c = threadIdx.x;
    float s = 0.f;
    for (int r = 0; r < MBLK; ++r) s += bf2f(K[((size_t)bb * MBLK + r) * 256 + c]);
    KS[((size_t)bb * 2 + 0) * 256 + c] = s; KS[((size_t)bb * 2 + 1) * 256 + c] = 0.f;
}

__global__ __launch_bounds__(256) void k_attn_swa_naive(const bf16_t* __restrict__ Q, const bf16_t* __restrict__ K, const bf16_t* __restrict__ V, const bf16_t* __restrict__ Z,
                                                        const float* __restrict__ sinks, bf16_t* __restrict__ G) {
    __shared__ float sh[4][64 + 128];
    const int w = threadIdx.x >> 6, lane = threadIdx.x & 63;
    const int gw = blockIdx.x * 4 + w, row = gw >> 4, h = gw & 15, t = row & (SEQ - 1), kvh = h >> 3;
    float* qs = sh[w]; float* ps = sh[w] + 64;
    qs[lane] = bf2f(Q[(size_t)row * DM + h * 64 + lane]);
    __syncthreads();
    float s[2];
#pragma unroll
    for (int r = 0; r < 2; ++r) { const int kk = lane + 64 * r; float a = -INFINITY;
        if (kk <= t) { const u32x4* kp = (const u32x4*)(K + (size_t)(row - kk) * 128 + kvh * 64); a = 0.f;
#pragma unroll
            for (int c = 0; c < 8; ++c) { const u32x4 v = kp[c];
                a += qs[8 * c + 0] * bf2f(v.x & 0xffff) + qs[8 * c + 1] * bf2f(v.x >> 16) + qs[8 * c + 2] * bf2f(v.y & 0xffff) + qs[8 * c + 3] * bf2f(v.y >> 16)
                   + qs[8 * c + 4] * bf2f(v.z & 0xffff) + qs[8 * c + 5] * bf2f(v.z >> 16) + qs[8 * c + 6] * bf2f(v.w & 0xffff) + qs[8 * c + 7] * bf2f(v.w >> 16); } }
        s[r] = a; }
    const float sinkl = sinks[h] * LOG2E;
    const float m = fmaxf(wave_max(fmaxf(s[0], s[1])), sinkl);
    const float p0 = exp2f(s[0] - m), p1 = exp2f(s[1] - m);
    const float l = wave_sum(p0 + p1) + exp2f(sinkl - m);
    ps[lane] = p0; ps[lane + 64] = p1;
    __syncthreads();
    const int nk = t + 1 < WINDOW ? t + 1 : WINDOW; float o = 0.f;
    for (int kk = 0; kk < nk; ++kk) o += ps[kk] * bf2f(V[(size_t)(row - kk) * 128 + kvh * 64 + lane]);
    o /= l;
    const float z = bf2f(Z[(size_t)row * DM + h * 64 + lane]);
    G[(size_t)row * DM + h * 64 + lane] = (bf16_t)f2bf(o * z / (1.f + __expf(-z)));
}
__global__ __launch_bounds__(256) void k_attn_moba_naive(const bf16_t* __restrict__ Q, const bf16_t* __restrict__ K, const bf16_t* __restrict__ V, const bf16_t* __restrict__ Z,
                                                         const float* __restrict__ KS, bf16_t* __restrict__ G) {
    __shared__ float sh[4][64 + 1024];
    const int w = threadIdx.x >> 6, lane = threadIdx.x & 63;
    const int gw = blockIdx.x * 4 + w, row = gw >> 4, h = gw & 15, t = row & (SEQ - 1), b = row >> 12, kvh = h >> 2, qblk = t >> 8;
    float* qs = sh[w]; float* ps = sh[w] + 64;
    qs[lane] = bf2f(Q[(size_t)row * DM + h * 64 + lane]);
    __syncthreads();
    float gate = -INFINITY;
    if (lane < qblk) { const float* k0 = KS + ((size_t)(b * NBLK + lane) * 2) * 256 + kvh * 64; const float* k1 = k0 + 256; float a = 0.f;
        for (int d = 0; d < 64; ++d) a += qs[d] * ((k0[d] + k1[d]) * (1.0f / MBLK));
        gate = a; }
    unsigned chosen = 0; const int nsel = qblk < 3 ? qblk : 3;
    for (int si = 0; si < nsel; ++si) { float best = -INFINITY; int bi = -1;
        for (int j = 0; j < qblk; ++j) { const float gj = __shfl(gate, j); if (!((chosen >> j) & 1u) && (bi < 0 || gj > best)) { best = gj; bi = j; } }
        chosen |= 1u << bi; }
    chosen |= 1u << qblk;
    float mx = -INFINITY; int nslot = 0; int blks[4] = {0, 0, 0, 0};
    for (int j = 0; j <= qblk; ++j) { if (!((chosen >> j) & 1u)) continue;
        if (nslot == 0) blks[0] = j; else if (nslot == 1) blks[1] = j; else if (nslot == 2) blks[2] = j; else blks[3] = j;
#pragma unroll
        for (int r = 0; r < 4; ++r) { const int key = j * 256 + r * 64 + lane; float a = -INFINITY;
            if (key <= t) { const u32x4* kp = (const u32x4*)(K + ((size_t)b * SEQ + key) * 256 + kvh * 64); a = 0.f;
#pragma unroll
                for (int c = 0; c < 8; ++c) { const u32x4 v = kp[c];
                    a += qs[8 * c + 0] * bf2f(v.x & 0xffff) + qs[8 * c + 1] * bf2f(v.x >> 16) + qs[8 * c + 2] * bf2f(v.y & 0xffff) + qs[8 * c + 3] * bf2f(v.y >> 16)
                       + qs[8 * c + 4] * bf2f(v.z & 0xffff) + qs[8 * c + 5] * bf2f(v.z >> 16) + qs[8 * c + 6] * bf2f(v.w & 0xffff) + qs[8 * c + 7] * bf2f(v.w >> 16); } }
            ps[nslot * 256 + r * 64 + lane] = a; mx = fmaxf(mx, a); }
        ++nslot; }
    mx = wave_max(mx);
    float l = 0.f;
    for (int i = lane; i < nslot * 256; i += 64) { const float p = exp2f(ps[i] - mx); ps[i] = p; l += p; }
    l = wave_sum(l);
    __syncthreads();
    float o = 0.f;
    for (int sl = 0; sl < nslot; ++sl) { const int j = sl == 0 ? blks[0] : sl == 1 ? blks[1] : sl == 2 ? blks[2] : blks[3];
        const bf16_t* vp = V + ((size_t)b * SEQ + j * 256) * 256 + kvh * 64 + lane; const float* pp = ps + sl * 256;
        const int nk = (j == qblk) ? (t - j * 256 + 1) : 256;
        for (int kk = 0; kk < nk; ++kk) o += pp[kk] * bf2f(vp[(size_t)kk * 256]); }
    o /= l;
    const float z = bf2f(Z[(size_t)row * DM + h * 64 + lane]);
    G[(size_t)row * DM + h * 64 + lane] = (bf16_t)f2bf(o * z / (1.f + __expf(-z)));
}

__global__ __launch_bounds__(256) void k_gemm2_naive(const bf16_t* __restrict__ Gb, const bf16_t* __restrict__ W2t, const float* hold, float* H, bf16_t* __restrict__ Hb, float* __restrict__ ss) {
    const int wave = (int)(((size_t)blockIdx.x * 256 + threadIdx.x) >> 6), lane = threadIdx.x & 63;
    const int rt = wave >> 4, cg = wave & 15; if (rt >= M / 16) return;
    const int row0 = rt * 16, lr = lane & 15, lq = lane >> 4;
    f32x4 acc[4];
#pragma unroll
    for (int nb = 0; nb < 4; ++nb) acc[nb] = (f32x4){0.f, 0.f, 0.f, 0.f};
    const bf16_t* ap = Gb + (size_t)(row0 + lr) * DM + 8 * lq;
    const bf16_t* bp = W2t + (size_t)(cg * 64 + lr) * DM + 8 * lq;
    for (int k0 = 0; k0 < DM; k0 += 32) {
        const bf16x8 a = *(const bf16x8*)(ap + k0);
#pragma unroll
        for (int nb = 0; nb < 4; ++nb) { const bf16x8 b = *(const bf16x8*)(bp + (size_t)nb * 16 * DM + k0); acc[nb] = __builtin_amdgcn_mfma_f32_16x16x32_bf16(a, b, acc[nb], 0, 0, 0); }
    }
#pragma unroll
    for (int reg = 0; reg < 4; ++reg) {
        const int row = row0 + 4 * lq + reg; float s = 0.f;
#pragma unroll
        for (int nb = 0; nb < 4; ++nb) { const size_t off = (size_t)row * DM + cg * 64 + 16 * nb + lr; const float hn = hold[off] + acc[nb][reg]; H[off] = hn; Hb[off] = (bf16_t)f2bf(hn); s += hn * hn; }
        s += __shfl_xor(s, 1); s += __shfl_xor(s, 2); s += __shfl_xor(s, 4); s += __shfl_xor(s, 8);
        if (lr == 0) ss[(size_t)row * 16 + cg] = s;
    }
}
__global__ void k_final(float* H, const float* __restrict__ fg) {
    const int row = (blockIdx.x * blockDim.x + threadIdx.x) >> 6, lane = threadIdx.x & 63; if (row >= M) return;
    f32x4* hr = (f32x4*)(H + (size_t)row * DM) + lane; const f32x4* gr = (const f32x4*)fg + lane;
    f32x4 v[4]; float s = 0.f;
#pragma unroll
    for (int j = 0; j < 4; ++j) { v[j] = hr[64 * j]; s += (v[j].x * v[j].x + v[j].y * v[j].y) + (v[j].z * v[j].z + v[j].w * v[j].w); }
    const float rstd = rsqrtf(wave_sum(s) * (1.0f / DM) + EPS);
#pragma unroll
    for (int j = 0; j < 4; ++j) hr[64 * j] = v[j] * rstd * gr[64 * j];
}


namespace pg8 {
#define PG8_LAS __attribute__((address_space(3)))
typedef unsigned short bf16_t;
typedef short bf16x8 __attribute__((ext_vector_type(8)));
typedef float f32x4 __attribute__((ext_vector_type(4)));
typedef unsigned u32x4 __attribute__((ext_vector_type(4)));
constexpr int BM = 256, BK = 64, HALF = 128, HTB = HALF * BK * 2  , STAGE_BYTES = 8 * HTB, NXCD = 8, WGM = 8;

__host__ __device__ __forceinline__ int lds_byte(int r, int c) { const int st = (r >> 4) * 2 + (c >> 5), rr = r & 15, cc = c & 31, ob = rr * 64 + cc * 2; return st * 1024 + (ob ^ (((ob >> 9) & 1) << 5)); }
__host__ __device__ __forceinline__ void stage_rc(int b, int& R, int& C) { const int st = b / 1024, sb = b % 1024, swz = sb ^ (((sb >> 9) & 1) << 5); R = (st >> 1) * 16 + swz / 64; C = (st & 1) * 32 + (swz % 64) / 2; }
__host__ __device__ __forceinline__ int perm32(int rho) { const int n = rho >> 4, i = rho & 15; return 8 * (i >> 2) + 4 * n + (i & 3); }

struct Unit { int pm, pn; };
struct Gemm { const bf16_t* A; const bf16_t* Bt; int M, N, K; };

struct StaticOrder {
    int nM, nN, nwg, G, c;
    __host__ __device__ void init(int M, int N, int G_, int c_) { nM = M / BM; nN = N / BM; nwg = nM * nN; G = G_; c = c_; }
    __host__ __device__ bool next(int i, Unit& u) const {
        const long L = (long)i * G + c; if (L >= nwg) return false;
        int wgid = (int)L; { const int q = nwg / NXCD, r = nwg % NXCD, xcd = wgid % NXCD, off = wgid / NXCD; wgid = (xcd < r ? xcd * (q + 1) : r * (q + 1) + (xcd - r) * q) + off; }
        const int nig = WGM * nN, gid = wgid / nig, fm = gid * WGM, gsz = (nM - fm) < WGM ? (nM - fm) : WGM;
        u.pm = fm + ((wgid % nig) % gsz); u.pn = (wgid % nig) / gsz; return true;
    }
    __device__ __forceinline__ void a_ready(const Unit&) const {}
    __device__ __forceinline__ void done(const Unit&) const {}
};

__device__ __forceinline__ unsigned cvt_pk_bf16(float lo, float hi) { unsigned r; asm volatile("v_cvt_pk_bf16_f32 %0, %1, %2" : "=v"(r) : "v"(lo), "v"(hi)); return r; }
typedef unsigned u32x2 __attribute__((ext_vector_type(2)));

template <int KVH> struct EpiG1 {
    static constexpr bool PERM = true, AFTER_DRAIN = false;
    bf16_t *Q, *K, *V, *Z; const float* ss; const float* rope; float* KS;
    __device__ __forceinline__ void rstd8(float (&rs)[2][4], int row0) const {
        f32x4 sv[2][4];
#pragma unroll
        for (int ai = 0; ai < 2; ++ai)
#pragma unroll
            for (int m = 0; m < 4; ++m) sv[ai][m] = *(const f32x4*)(ss + (size_t)(row0 + ai * HALF + m * 16) * 4);
#pragma unroll
        for (int ai = 0; ai < 2; ++ai)
#pragma unroll
            for (int m = 0; m < 4; ++m) rs[ai][m] = __builtin_amdgcn_rsqf(((sv[ai][m][0] + sv[ai][m][1]) + (sv[ai][m][2] + sv[ai][m][3])) * (1.0f / 1024.0f) + 1e-5f);
    }
    __device__ __forceinline__ void rope4(f32x4 (&cc)[4], f32x4 (&sn)[4], int rowa, int wcl, int fq) const {
        f32x4 t0[4], t1[4];
#pragma unroll
        for (int m = 0; m < 4; ++m) { const int pos = (rowa + m * 16) & 4095; const f32x4* rp = (const f32x4*)(rope + ((size_t)pos * 32 + 16 * wcl + 4 * fq) * 2); t0[m] = rp[0]; t1[m] = rp[1]; }
#pragma unroll
        for (int m = 0; m < 4; ++m) { cc[m] = (f32x4){t0[m][0], t0[m][2], t1[m][0], t1[m][2]}; sn[m] = (f32x4){t0[m][1], t0[m][3], t1[m][1], t1[m][3]}; }
    }
    __device__ __forceinline__ void operator()(const f32x4 (&acc)[2][2][4][2], const Unit& u, int wr, int wc, int fr, int fq) const {
        constexpr int KVW = KVH * 64; constexpr float C2 = 0.125f * 1.4426950408889634f;
        const int pn = u.pn, wcl = wc & 1, hp = wc >> 1;
        const int row0 = u.pm * BM + wr * 64 + fr;
        if (pn < 4 || (pn == 4 && KVH == 4)) {
            const bool isq = pn < 4;
            f32x4 ks[2][2];
#pragma unroll
            for (int bj = 0; bj < 2; ++bj) { ks[bj][0] = (f32x4){0.f, 0.f, 0.f, 0.f}; ks[bj][1] = (f32x4){0.f, 0.f, 0.f, 0.f}; }
            float rsv[2][4]; rstd8(rsv, row0);
#pragma unroll
            for (int ai = 0; ai < 2; ++ai) { f32x4 ccv[4], snv[4]; rope4(ccv, snv, row0 + ai * HALF, wcl, fq);
#pragma unroll
                for (int m = 0; m < 4; ++m) {
                    const int row = row0 + ai * HALF + m * 16;
                    const float rs = rsv[ai][m], sc = isq ? rs * C2 : rs;
                    const f32x4 cc = ccv[m], sn = snv[m];
#pragma unroll
                    for (int bj = 0; bj < 2; ++bj) {
                        const f32x4 x1 = acc[ai][bj][m][0] * sc, x2 = acc[ai][bj][m][1] * sc;
                        const f32x4 o1 = x1 * cc - x2 * sn, o2 = x2 * cc + x1 * sn;
                        bf16_t* dst = isq ? Q + (size_t)row * 1024 + (4 * pn + 2 * bj + hp) * 64 + 16 * wcl + 4 * fq : K + (size_t)row * KVW + (2 * bj + hp) * 64 + 16 * wcl + 4 * fq;
                        u32x2 w1, w2; w1.x = cvt_pk_bf16(o1[0], o1[1]); w1.y = cvt_pk_bf16(o1[2], o1[3]); w2.x = cvt_pk_bf16(o2[0], o2[1]); w2.y = cvt_pk_bf16(o2[2], o2[3]);
                        *(u32x2*)dst = w1; *(u32x2*)(dst + 32) = w2;
                        if (!isq) { ks[bj][0] += o1; ks[bj][1] += o2; }
                    }
                } }
            if (!isq) {
#pragma unroll
                for (int bj = 0; bj < 2; ++bj)
#pragma unroll
                    for (int n = 0; n < 2; ++n) {
                        f32x4 v = ks[bj][n];
#pragma unroll
                        for (int j = 0; j < 4; ++j) { float s = v[j]; s += __shfl_xor(s, 1); s += __shfl_xor(s, 2); s += __shfl_xor(s, 4); s += __shfl_xor(s, 8); v[j] = s; }
                        if (fr == 0) *(f32x4*)(KS + ((size_t)(u.pm * 2 + wr)) * 256 + (2 * bj + hp) * 64 + 32 * n + 16 * wcl + 4 * fq) = v;
                    }
            }
        } else if (pn == 4) {
            float rsv[2][4]; rstd8(rsv, row0);
#pragma unroll
            for (int ai = 0; ai < 2; ++ai) { f32x4 ccv[4], snv[4]; rope4(ccv, snv, row0 + ai * HALF, wcl, fq);
#pragma unroll
                for (int m = 0; m < 4; ++m) {
                    const int row = row0 + ai * HALF + m * 16;
                    const float rs = rsv[ai][m];
                    const f32x4 cc = ccv[m], sn = snv[m];
                    { const f32x4 x1 = acc[ai][0][m][0] * rs, x2 = acc[ai][0][m][1] * rs;
                      const f32x4 o1 = x1 * cc - x2 * sn, o2 = x2 * cc + x1 * sn;
                      bf16_t* dst = K + (size_t)row * KVW + hp * 64 + 16 * wcl + 4 * fq;
                      u32x2 w1, w2; w1.x = cvt_pk_bf16(o1[0], o1[1]); w1.y = cvt_pk_bf16(o1[2], o1[3]); w2.x = cvt_pk_bf16(o2[0], o2[1]); w2.y = cvt_pk_bf16(o2[2], o2[3]);
                      *(u32x2*)dst = w1; *(u32x2*)(dst + 32) = w2; }
                    { const f32x4 v0 = acc[ai][1][m][0] * rs, v1 = acc[ai][1][m][1] * rs;
                      u32x4 w; w.x = cvt_pk_bf16(v0[0], v0[1]); w.y = cvt_pk_bf16(v0[2], v0[3]); w.z = cvt_pk_bf16(v1[0], v1[1]); w.w = cvt_pk_bf16(v1[2], v1[3]);
                      *(u32x4*)(V + (size_t)row * KVW + 32 * wc + 8 * fq) = w; }
                } }
        } else {
            const bool isv = (KVH == 4 && pn == 5);
            const int zt = pn - (KVH == 4 ? 6 : 5);
            float rsv[2][4]; rstd8(rsv, row0);
#pragma unroll
            for (int ai = 0; ai < 2; ++ai)
#pragma unroll
                for (int m = 0; m < 4; ++m) {
                    const int row = row0 + ai * HALF + m * 16;
                    const float rs = rsv[ai][m];
                    bf16_t* dst = isv ? V + (size_t)row * KVW + 32 * wc + 8 * fq : Z + (size_t)row * 1024 + zt * 256 + 32 * wc + 8 * fq;
#pragma unroll
                    for (int bj = 0; bj < 2; ++bj) {
                        const f32x4 v0 = acc[ai][bj][m][0] * rs, v1 = acc[ai][bj][m][1] * rs;
                        u32x4 w; w.x = cvt_pk_bf16(v0[0], v0[1]); w.y = cvt_pk_bf16(v0[2], v0[3]); w.z = cvt_pk_bf16(v1[0], v1[1]); w.w = cvt_pk_bf16(v1[2], v1[3]);
                        *(u32x4*)(dst + bj * HALF) = w;
                    }
                }
        }
    }
};
template <bool IN_F32, bool OUT_F32> struct EpiG2 {
    static constexpr bool PERM = true, AFTER_DRAIN = false;
    const float* xin; float* H; bf16_t* Hb; float* ss; PG8_LAS float* red;
    __device__ __forceinline__ void operator()(const f32x4 (&acc)[2][2][4][2], const Unit& u, int wr, int wc, int fr, int fq) const {
        const int row0 = u.pm * BM + wr * 64 + fr, col0 = u.pn * BM + 32 * wc + 8 * fq;
#pragma unroll
        for (int ai = 0; ai < 2; ++ai) {
            f32x4 r0[4][2], r1[4][2]; u32x4 rb[4][2];
#pragma unroll
            for (int m = 0; m < 4; ++m)
#pragma unroll
                for (int bj = 0; bj < 2; ++bj) { const size_t off = (size_t)(row0 + ai * HALF + m * 16) * 1024 + col0 + bj * HALF;
                    if (IN_F32) { r0[m][bj] = *(const f32x4*)(xin + off); r1[m][bj] = *(const f32x4*)(xin + off + 4); } else rb[m][bj] = *(const u32x4*)(Hb + off); }
#pragma unroll
            for (int m = 0; m < 4; ++m) {
                const int row = row0 + ai * HALF + m * 16; float s = 0.f;
#pragma unroll
                for (int bj = 0; bj < 2; ++bj) {
                    const size_t off = (size_t)row * 1024 + col0 + bj * HALF;
                    f32x4 h0, h1;
                    if (IN_F32) { h0 = r0[m][bj]; h1 = r1[m][bj]; }
                    else { const u32x4 w = rb[m][bj]; h0 = (f32x4){__uint_as_float(w.x << 16), __uint_as_float(w.x & 0xffff0000u), __uint_as_float(w.y << 16), __uint_as_float(w.y & 0xffff0000u)};
                           h1 = (f32x4){__uint_as_float(w.z << 16), __uint_as_float(w.z & 0xffff0000u), __uint_as_float(w.w << 16), __uint_as_float(w.w & 0xffff0000u)}; }
                    const f32x4 v0 = h0 + acc[ai][bj][m][0], v1 = h1 + acc[ai][bj][m][1];
                    s += ((v0[0] * v0[0] + v0[1] * v0[1]) + (v0[2] * v0[2] + v0[3] * v0[3])) + ((v1[0] * v1[0] + v1[1] * v1[1]) + (v1[2] * v1[2] + v1[3] * v1[3]));
                    if (OUT_F32) { *(f32x4*)(H + off) = v0; *(f32x4*)(H + off + 4) = v1; }
                    else { u32x4 w; w.x = cvt_pk_bf16(v0[0], v0[1]); w.y = cvt_pk_bf16(v0[2], v0[3]); w.z = cvt_pk_bf16(v1[0], v1[1]); w.w = cvt_pk_bf16(v1[2], v1[3]); *(u32x4*)(Hb + off) = w; }
                }
                s += __shfl_xor(s, 16); s += __shfl_xor(s, 32);
                if (fq == 0) red[(ai * HALF + wr * 64 + m * 16 + fr) * 4 + wc] = s;
            }
        }
        asm volatile("s_waitcnt lgkmcnt(0)\n\ts_barrier" ::: "memory");
        const int tid = (wr * 4 + wc) * 64 + fq * 16 + fr;
        if (tid < 256) { const f32x4 v = *(const PG8_LAS f32x4*)(red + tid * 4); ss[(size_t)(u.pm * BM + tid) * 4 + u.pn] = (v[0] + v[1]) + (v[2] + v[3]); }
    }
};
template <class Epi, class Sched, bool ALIGN_EPI = false, bool SP2 = false>
__device__ __forceinline__ void gemm_phase(PG8_LAS unsigned char* lds, const Gemm g, const Sched& S, const Epi& E) {
    int tid_ = threadIdx.x; asm volatile("" : "+v"(tid_));
    const int tid = tid_, wid = __builtin_amdgcn_readfirstlane(tid >> 6), lane = tid & 63, wr = wid >> 2, wc = wid & 3, fr = lane & 15, fq = lane >> 4;
    const int K = g.K, nt = K / BK;
    unsigned voffA[2], voffB[2];
#pragma unroll
    for (int i = 0; i < 2; ++i) { int R, C; stage_rc(tid * 16 + i * 8192, R, C); const int Rb = Epi::PERM ? ((R & ~31) + perm32(R & 31)) : R;
        voffA[i] = (unsigned)(R * K + C) * 2u; voffB[i] = (unsigned)(Rb * K + C) * 2u; }
    const size_t kstep = (size_t)(BK * 2);
    const size_t hstep = (size_t)HALF * K * 2;
    const size_t tstep = 2 * hstep;
    const unsigned ldsw = (unsigned)wid * 1024u;
    const int aoff = lds_byte(wr * 64 + fr, fq * 8), boff = lds_byte(wc * 32 + fr, fq * 8);
#define PG8_SA(b, h) (((b) * 2 + (h)) * HTB)
#define PG8_SB(b, h) ((4 + (b) * 2 + (h)) * HTB)
#define PG8_STAGE(bufoff, gbase, voff) do { _Pragma("unroll") for (int _i = 0; _i < 2; ++_i) \
        __builtin_amdgcn_global_load_lds((const unsigned*)((const char*)(gbase) + (voff)[_i]), (PG8_LAS unsigned*)(lds + (bufoff) + ldsw + _i * 8192), 16, 0, 0); } while (0)
#define PG8_LDA(dst, b, h) do { _Pragma("unroll") for (int m = 0; m < 4; ++m) _Pragma("unroll") for (int k = 0; k < 2; ++k) dst[m][k] = *(const PG8_LAS bf16x8*)(lds + PG8_SA(b, h) + aoff + m * 2048 + k * 1024); } while (0)
#define PG8_LDB(dst, b, h) do { _Pragma("unroll") for (int n = 0; n < 2; ++n) _Pragma("unroll") for (int k = 0; k < 2; ++k) dst[n][k] = *(const PG8_LAS bf16x8*)(lds + PG8_SB(b, h) + boff + n * 2048 + k * 1024); } while (0)
#define PG8_MMA(ai, bj, At, Bt) do { __builtin_amdgcn_s_setprio(1); _Pragma("unroll") for (int m = 0; m < 4; ++m) _Pragma("unroll") for (int n = 0; n < 2; ++n) _Pragma("unroll") for (int k = 0; k < 2; ++k) \
        acc[ai][bj][m][n] = __builtin_amdgcn_mfma_f32_16x16x32_bf16(Bt[n][k], At[m][k], acc[ai][bj][m][n], 0, 0, 0); __builtin_amdgcn_s_setprio(0); } while (0)
#define PG8_WAIT_V(n) asm volatile("s_waitcnt vmcnt(" #n ")" ::: "memory")
#define PG8_WAIT_L(n) asm volatile("s_waitcnt lgkmcnt(" #n ")" ::: "memory")
#define PG8_BAR __builtin_amdgcn_s_barrier()
#define PG8_SCHED __builtin_amdgcn_sched_barrier(0)
    Unit cur, nxt; int ui = 0;
    if (!S.next(0, cur)) return;
    f32x4 acc[2][2][4][2];
#pragma unroll
    for (int a = 0; a < 2; ++a)
#pragma unroll
        for (int b = 0; b < 2; ++b)
#pragma unroll
            for (int m = 0; m < 4; ++m)
#pragma unroll
                for (int n = 0; n < 2; ++n) acc[a][b][m][n] = (f32x4){0.f, 0.f, 0.f, 0.f};
    bf16x8 At[4][2], B0[2][2], B1[2][2];
    const char* cA = (const char*)g.A + (size_t)cur.pm * tstep; const char* cB = (const char*)g.Bt + (size_t)cur.pn * tstep;
    S.a_ready(cur);
    if constexpr (SP2) {
        PG8_STAGE(PG8_SB(0, 0), cB, voffB); PG8_STAGE(PG8_SB(0, 1), cB + hstep, voffB); PG8_STAGE(PG8_SA(0, 0), cA, voffA); PG8_STAGE(PG8_SA(0, 1), cA + hstep, voffA);
        if (wr == 1) PG8_BAR;
        PG8_WAIT_V(2); PG8_BAR;
        PG8_STAGE(PG8_SB(1, 0), cB + kstep, voffB); PG8_STAGE(PG8_SA(1, 0), cA + kstep, voffA); PG8_STAGE(PG8_SB(1, 1), cB + hstep + kstep, voffB);
        PG8_WAIT_V(6); PG8_BAR;
    } else {
        PG8_STAGE(PG8_SB(0, 0), cB, voffB); PG8_STAGE(PG8_SA(0, 0), cA, voffA); PG8_STAGE(PG8_SB(0, 1), cB + hstep, voffB); PG8_STAGE(PG8_SA(0, 1), cA + hstep, voffA);
        if (wr == 1) PG8_BAR;
        PG8_WAIT_V(4); PG8_BAR;
        PG8_STAGE(PG8_SB(1, 0), cB + kstep, voffB); PG8_STAGE(PG8_SA(1, 0), cA + kstep, voffA); PG8_STAGE(PG8_SB(1, 1), cB + hstep + kstep, voffB);
        PG8_WAIT_V(6); PG8_BAR;
    }
    for (;;) {
        const bool has_next = S.next(ui + 1, nxt);
        const char* nA = has_next ? (const char*)g.A + (size_t)nxt.pm * tstep : cA; const char* nB = has_next ? (const char*)g.Bt + (size_t)nxt.pn * tstep : cB;
        for (int t = 0; t < nt; t += 2) {
            const bool last = (t == nt - 2);
            const char* a1 = cA + (size_t)(t + 1) * kstep;
            const char* a2 = last ? nA : cA + (size_t)(t + 2) * kstep; const char* b2 = last ? nB : cB + (size_t)(t + 2) * kstep;
            const char* a3 = a2 + kstep; const char* b3 = b2 + kstep;
            if (last && has_next) S.a_ready(nxt);
            if constexpr (SP2) {
            PG8_LDB(B0, 0, 0); PG8_LDB(B1, 0, 1); PG8_SCHED; PG8_LDA(At, 0, 0); PG8_STAGE(PG8_SA(1, 1), a1 + hstep, voffA);
            PG8_WAIT_V(8); PG8_WAIT_L(0); PG8_BAR; PG8_MMA(0, 0, At, B0); PG8_MMA(0, 1, At, B1); PG8_BAR; PG8_SCHED;
            PG8_LDA(At, 0, 1); PG8_STAGE(PG8_SB(0, 0), b2, voffB); PG8_STAGE(PG8_SB(0, 1), b2 + hstep, voffB); PG8_STAGE(PG8_SA(0, 0), a2, voffA);
            PG8_WAIT_V(8); PG8_WAIT_L(0); PG8_BAR; PG8_MMA(1, 0, At, B0); PG8_MMA(1, 1, At, B1); PG8_BAR; PG8_SCHED;
            PG8_LDB(B0, 1, 0); PG8_LDB(B1, 1, 1); PG8_SCHED; PG8_LDA(At, 1, 0); PG8_STAGE(PG8_SA(0, 1), a2 + hstep, voffA);
            PG8_WAIT_V(8); PG8_WAIT_L(0); PG8_BAR; PG8_MMA(0, 0, At, B0); PG8_MMA(0, 1, At, B1); PG8_BAR; PG8_SCHED;
            PG8_LDA(At, 1, 1); PG8_STAGE(PG8_SB(1, 0), b3, voffB); PG8_STAGE(PG8_SB(1, 1), b3 + hstep, voffB); PG8_STAGE(PG8_SA(1, 0), a3, voffA);
            PG8_WAIT_V(8); PG8_WAIT_L(0); PG8_BAR; PG8_MMA(1, 0, At, B0); PG8_MMA(1, 1, At, B1); PG8_BAR; PG8_SCHED;
            } else {
            PG8_LDB(B0, 0, 0); PG8_SCHED; PG8_LDA(At, 0, 0); PG8_STAGE(PG8_SA(1, 1), a1 + hstep, voffA);
            PG8_WAIT_L(8); PG8_BAR; PG8_WAIT_L(0); PG8_MMA(0, 0, At, B0); PG8_BAR; PG8_SCHED;
            PG8_LDB(B1, 0, 1); PG8_STAGE(PG8_SB(0, 0), b2, voffB);
            PG8_BAR; PG8_WAIT_L(0); PG8_MMA(0, 1, At, B1); PG8_BAR;
            PG8_LDA(At, 0, 1); PG8_STAGE(PG8_SA(0, 0), a2, voffA);
            PG8_BAR; PG8_WAIT_L(0); PG8_MMA(1, 0, At, B0); PG8_BAR; PG8_SCHED;
            PG8_STAGE(PG8_SB(0, 1), b2 + hstep, voffB);
            PG8_WAIT_V(6); PG8_BAR; PG8_MMA(1, 1, At, B1); PG8_BAR;
            PG8_LDB(B0, 1, 0); PG8_SCHED; PG8_LDA(At, 1, 0); PG8_STAGE(PG8_SA(0, 1), a2 + hstep, voffA);
            PG8_WAIT_L(8); PG8_BAR; PG8_WAIT_L(0); PG8_MMA(0, 0, At, B0); PG8_BAR; PG8_SCHED;
            PG8_LDB(B1, 1, 1); PG8_STAGE(PG8_SB(1, 0), b3, voffB);
            PG8_BAR; PG8_WAIT_L(0); PG8_MMA(0, 1, At, B1); PG8_BAR;
            PG8_LDA(At, 1, 1); PG8_STAGE(PG8_SA(1, 0), a3, voffA);
            PG8_BAR; PG8_WAIT_L(0); PG8_MMA(1, 0, At, B0); PG8_BAR; PG8_SCHED;
            PG8_STAGE(PG8_SB(1, 1), b3 + hstep, voffB);
            PG8_WAIT_V(6); PG8_BAR; PG8_MMA(1, 1, At, B1); PG8_BAR;
            }
        }
        if constexpr (ALIGN_EPI) { if (wr == 0) PG8_BAR; }
        if constexpr (!Epi::AFTER_DRAIN) { E(acc, cur, wr, wc, fr, fq); S.done(cur); }
        if (!has_next) break;
#pragma unroll
        for (int a = 0; a < 2; ++a)
#pragma unroll
            for (int b = 0; b < 2; ++b)
#pragma unroll
                for (int m = 0; m < 4; ++m)
#pragma unroll
                    for (int n = 0; n < 2; ++n) acc[a][b][m][n] = (f32x4){0.f, 0.f, 0.f, 0.f};
        cur = nxt; cA = nA; cB = nB; ++ui;
        if constexpr (ALIGN_EPI) { if (wr == 1) PG8_BAR; }
    }
    PG8_WAIT_V(0);
    if constexpr (!ALIGN_EPI) { if (wr == 0) PG8_BAR; }
    PG8_BAR;
    if constexpr (Epi::AFTER_DRAIN) { E.fused(acc, cur, wr, wc, fr, fq, lds, wid, lane); S.done(cur); }
#undef PG8_SA
#undef PG8_SB
#undef PG8_STAGE
#undef PG8_LDA
#undef PG8_LDB
#undef PG8_MMA
#undef PG8_WAIT_V
#undef PG8_WAIT_L
#undef PG8_BAR
#undef PG8_SCHED
}
}

namespace attn_body {
using bf16=unsigned short;
using bf16x8=__attribute__((ext_vector_type(8)))short;
using s16x4=__attribute__((ext_vector_type(4)))short;
using f32x16=__attribute__((ext_vector_type(16)))float;
using u32x4=__attribute__((ext_vector_type(4)))unsigned;
constexpr int ASEQ=4096,D=64,ADM=1024;
constexpr int NW=8,QBLK=32,QB=QBLK*NW,KVBLK=64;
__device__ __forceinline__ int crow(int r,int hi){return (r&3)+8*(r>>2)+4*hi;}
#define SBAR() __builtin_amdgcn_sched_barrier(0)
__device__ __forceinline__ void cmask(f32x16&p0,f32x16&p1,int jb,int qrel,int hi){
  const float NEG=-INFINITY; int kb=qrel-(64*jb+4*hi); asm volatile("":"+v"(kb));
  #pragma unroll
  for(int r=0;r<16;++r){const int c=(r&3)+8*(r>>2); if(c>kb)p0[r]=NEG; if(c+32>kb)p1[r]=NEG;}
}
__device__ __forceinline__ void wmask(f32x16&p0,f32x16&p1,int delta,int hi){
  const float NEG=-INFINITY; int d0=delta-4*hi; asm volatile("":"+v"(d0));
  #pragma unroll
  for(int r=0;r<16;++r){const int dd=d0-((r&3)+8*(r>>2)); if((unsigned)dd>=128u)p0[r]=NEG; if((unsigned)(dd-32)>=128u)p1[r]=NEG;}
}

constexpr int NSLOT=3, SLOTB=8192;
constexpr int LDS_K=0, LDS_V=NSLOT*SLOTB, LDS_WS=2*NSLOT*SLOTB, LDS_OST=LDS_WS+NW*64*4, LDS_KM=LDS_OST+NW*8192, LDS_BYTES=LDS_KM+4096;
__device__ __forceinline__ void glds16(const void*sbase,unsigned voff,unsigned lds_dst){unsigned keep;
  asm volatile("s_nop 4\n\ts_mov_b32 %0, m0\n\ts_mov_b32 m0, %2\n\ts_nop 0\n\tglobal_load_lds_dwordx4 %1, %3\n\ts_mov_b32 m0, %0":"=&s"(keep):"v"(voff),"s"(lds_dst),"s"(sbase):"memory");}
__device__ __forceinline__ float max3f(float a,float b,float c){float r;asm("v_max3_f32 %0, %1, %2, %3":"=v"(r):"v"(a),"v"(b),"v"(c));return r;}
__device__ __forceinline__ float max2f(float a,float b){float r;asm("v_max_f32_e32 %0, %1, %2":"=v"(r):"v"(a),"v"(b));return r;}
__device__ __forceinline__ float fadd_s(float a,float b){float r;asm("v_add_f32_e32 %0, %1, %2":"=v"(r):"v"(a),"v"(b));return r;}
__device__ __forceinline__ float fsub_s(float a,float b){float r;asm("v_sub_f32_e32 %0, %1, %2":"=v"(r):"v"(a),"v"(b));return r;}
typedef float f32x2_t __attribute__((ext_vector_type(2))); typedef __bf16 bf16x2_t __attribute__((ext_vector_type(2)));
__device__ __forceinline__ unsigned cvtpk_s(float lo,float hi){f32x2_t v={lo,hi};bf16x2_t b=__builtin_convertvector(v,bf16x2_t);return __builtin_bit_cast(unsigned,b);}
#define WAIT_BAR(N) asm volatile("s_waitcnt vmcnt(" #N ") lgkmcnt(0)\n\ts_barrier":::"memory")

__device__ __forceinline__ void qkt(f32x16&p0,f32x16&p1,const char*Kslot,const bf16x8*qr,const f32x16&negm,int r32,int hi){
  const char*kb=Kslot+hi*1024+r32*16;
  #pragma unroll
  for(int d0=0;d0<4;++d0){
    const bf16x8 b0=*reinterpret_cast<const bf16x8*>(kb+d0*2048);
    const bf16x8 b1=*reinterpret_cast<const bf16x8*>(kb+d0*2048+512);
    if(d0==0){p0=__builtin_amdgcn_mfma_f32_32x32x16_bf16(b0,qr[0],negm,0,0,0);p1=__builtin_amdgcn_mfma_f32_32x32x16_bf16(b1,qr[0],negm,0,0,0);}
    else{p0=__builtin_amdgcn_mfma_f32_32x32x16_bf16(b0,qr[d0],p0,0,0,0);p1=__builtin_amdgcn_mfma_f32_32x32x16_bf16(b1,qr[d0],p1,0,0,0);}}
}
typedef __attribute__((address_space(3))) const char* lds_cptr;
typedef short v4i16_t __attribute__((ext_vector_type(4)));
__device__ __forceinline__ void kload8(bf16x8*kf,lds_cptr kp){
  kf[0]=*(const __attribute__((address_space(3))) bf16x8*)(kp);      kf[1]=*(const __attribute__((address_space(3))) bf16x8*)(kp+512);
  kf[2]=*(const __attribute__((address_space(3))) bf16x8*)(kp+2048); kf[3]=*(const __attribute__((address_space(3))) bf16x8*)(kp+2560);
  kf[4]=*(const __attribute__((address_space(3))) bf16x8*)(kp+4096); kf[5]=*(const __attribute__((address_space(3))) bf16x8*)(kp+4608);
  kf[6]=*(const __attribute__((address_space(3))) bf16x8*)(kp+6144); kf[7]=*(const __attribute__((address_space(3))) bf16x8*)(kp+6656);
}
__device__ __forceinline__ void kload2(bf16x8*kf,lds_cptr kp,int j){ kf[2*j]=*(const __attribute__((address_space(3))) bf16x8*)(kp+j*2048); kf[2*j+1]=*(const __attribute__((address_space(3))) bf16x8*)(kp+j*2048+512); }
__device__ __forceinline__ s16x4 vtr(lds_cptr p){ return __builtin_bit_cast(s16x4,__builtin_amdgcn_ds_read_tr16_b64_v4i16((__attribute__((address_space(3))) v4i16_t*)p)); }
__device__ __forceinline__ float rowmax(const f32x16&p0,const f32x16&p1){
  float a=max3f(p0[0],p0[1],p1[0]),b=max3f(p0[2],p0[3],p1[1]);a=max3f(a,p1[2],p1[3]);
  #pragma unroll
  for(int r=4;r<16;r+=4){a=max3f(a,p0[r],p0[r+1]);b=max3f(b,p0[r+2],p0[r+3]);a=max3f(a,p1[r],p1[r+1]);b=max3f(b,p1[r+2],p1[r+3]);}
  const float m=max2f(a,b);
  auto rr=__builtin_amdgcn_permlane32_swap(__float_as_uint(m),__float_as_uint(m),false,false);
  return max2f(__uint_as_float(rr[0]),__uint_as_float(rr[1]));
}
__device__ __forceinline__ void pv(f32x16*o,int vb,bf16x8 pa0,bf16x8 pa1,bf16x8 pa2,bf16x8 pa3){
  #pragma unroll
  for(int d0=0;d0<2;++d0){s16x4 lo[4],hi[4];
    #pragma unroll
    for(int ks=0;ks<4;++ks){
      asm volatile("ds_read_b64_tr_b16 %0,%1 offset:%c2":"=&v"(lo[ks]):"v"(vb),"i"(d0*4096+ks*1024):"memory");
      asm volatile("ds_read_b64_tr_b16 %0,%1 offset:%c2":"=&v"(hi[ks]):"v"(vb),"i"(d0*4096+ks*1024+512):"memory");}
    asm volatile("s_waitcnt lgkmcnt(0)":::"memory");SBAR();
    #define PK(k) (bf16x8){lo[k][0],lo[k][1],lo[k][2],lo[k][3],hi[k][0],hi[k][1],hi[k][2],hi[k][3]}
    o[d0]=__builtin_amdgcn_mfma_f32_32x32x16_bf16(pa0,PK(0),o[d0],0,0,0);
    o[d0]=__builtin_amdgcn_mfma_f32_32x32x16_bf16(pa1,PK(1),o[d0],0,0,0);
    o[d0]=__builtin_amdgcn_mfma_f32_32x32x16_bf16(pa2,PK(2),o[d0],0,0,0);
    o[d0]=__builtin_amdgcn_mfma_f32_32x32x16_bf16(pa3,PK(3),o[d0],0,0,0);
    #undef PK
  }
}

template<int MODE,int THRL> __device__ __forceinline__ void attn_unit(int b,int h,int qb,const bf16*Q,const bf16*__restrict__ K,const bf16*__restrict__ V,const bf16*__restrict__ Z,bf16*G,const float*__restrict__ aux,char*shm){
  constexpr int KVW=MODE?256:128;
  const int kvh=MODE?(h>>2):(h>>3);
  int tid_=threadIdx.x; asm volatile("":"+v"(tid_));
  const int tid=tid_,lane=tid&63,r32=lane&31,hi=lane>>5; const int wid=__builtin_amdgcn_readfirstlane(tid>>6);
  const int hw=MODE?h:h+(wid>>2), wrow=MODE?wid*QBLK:(wid&3)*QBLK;
  const long rowbase=(long)b*ASEQ; const int q0=MODE?qb*QB:qb*128;
  const bf16*Qw=Q+(rowbase+q0+wrow)*ADM+hw*D;
  const bf16*Kh=K+rowbase*KVW+kvh*D,*Vh=V+rowbase*KVW+kvh*D;
  const unsigned lds0=(unsigned)(uintptr_t)shm;
  float*wsf=(float*)(shm+LDS_WS)+wid*64;
  const int NT=MODE?(4*qb+4):4;
  const int ktA=MODE?(4*qb):(qb?2*qb-2:0);
  #define KT(s) (MODE?(((s)<4)?(ktA+(s)):((s)-4)):(ktA+(s)))
  if(MODE){ float*km=(float*)(shm+LDS_KM); const float*ks=aux+((size_t)(b*16)*2)*256+kvh*64;
    for(int idx=tid;idx<qb*64;idx+=512){const int j=idx>>6,d=idx&63; km[idx]=(ks[(size_t)(2*j)*256+d]+ks[(size_t)(2*j+1)*256+d])*(1.0f/256.0f);} }
  const unsigned kvoff=(unsigned)(lane*KVW+wid*8)*2u;
  const unsigned vvoff=(unsigned)((16*(wid&3)+(lane>>2))*KVW+(wid>>2)*32+(lane&3)*8)*2u;
  const unsigned kdst=lds0+LDS_K+wid*1024, vdst=lds0+LDS_V+wid*1024;
  #define DMA_K(s,slot) glds16(Kh+(long)KT(s)*KVBLK*KVW,kvoff,(unsigned)__builtin_amdgcn_readfirstlane(kdst+(slot)))
  #define DMA_V(s,slot) glds16(Vh+(long)KT(s)*KVBLK*KVW,vvoff,(unsigned)__builtin_amdgcn_readfirstlane(vdst+(slot)))
  const int vb0=(int)(lds0+LDS_V)+((lane>>4)&1)*32+(lane&3)*8+(4*hi+((lane&15)>>2))*64;
  const char*Kbase=shm+LDS_K; bf16x8 kf[8];
  const lds_cptr shm3=(lds_cptr)shm; const lds_cptr kp0=shm3+LDS_K+hi*1024+r32*16; const lds_cptr vp0=shm3+LDS_V+((lane>>4)&1)*32+(lane&3)*8+(4*hi+((lane&15)>>2))*64;
  DMA_K(0,0);DMA_V(0,0);DMA_K(1,SLOTB);
  bf16x8 qr[4];
  #pragma unroll
  for(int d0=0;d0<4;++d0)qr[d0]=*reinterpret_cast<const bf16x8*>(&Qw[(long)r32*ADM+d0*16+hi*8]);
  float mhat=0.f,l_reg=0.f;f32x16 o[2];o[0]=f32x16{};o[1]=f32x16{};
  const f32x16 zc=f32x16{};
  const int qrel=wrow+r32;
  #define AMASK(P0,P1,s) do{ if(MODE){ if((s)<4)cmask(P0,P1,(s),qrel,hi); } else { wmask(P0,P1,q0+qrel-64*KT(s),hi); } }while(0)
  bool resc=false; unsigned selmask=0u; unsigned pm_=0xffffffffu;
  #define PMOF(s) ((MODE&&(s)>=4)?((((selmask>>((((s)-4)>>2)&31))&1u)!=0u)?0xffffffffu:0u):0xffffffffu)
  #define RESC() do{ if(resc){ asm volatile("s_waitcnt lgkmcnt(0)":::"memory"); \
      _Pragma("unroll") for(int d_=0;d_<2;++d_) _Pragma("unroll") for(int r=0;r<16;++r)o[d_][r]*=wsf[crow(r,hi)]; } }while(0)
  #define REFUPD(C0,C1,rm,LOWOK) do{ resc=false; \
      const float gr_=rm-mhat; \
      if(__builtin_expect(__any((gr_>(float)THRL)||((LOWOK)&&(rm<-60.f)&&(rm>-INFINITY))),0)){ \
        const float dl=((LOWOK)&&(rm<-60.f)&&(rm>-INFINITY))?gr_:__builtin_fmaxf(gr_,0.f); mhat+=dl; \
        const float f=__builtin_amdgcn_exp2f(-dl); l_reg*=f; if(hi==0)wsf[r32]=f; resc=true; } \
      if(__builtin_expect(__any(mhat!=0.f),0)){ _Pragma("unroll") for(int r=0;r<16;++r){C0[r]-=mhat;C1[r]-=mhat;} } }while(0)
  f32x16 pA0,pA1,pB0,pB1;
  int sl_prev=0,sl_cur=0,sl_next=SLOTB;
  #define ROT() do{sl_prev=sl_cur;sl_cur=sl_next;sl_next=(sl_next==(NSLOT-1)*SLOTB)?0:sl_next+SLOTB;}while(0)
  DMA_K(2,2*SLOTB);
  WAIT_BAR(3);
  SBAR();
  if(MODE){
    const float*km=(const float*)(shm+LDS_KM)+8*hi; float qf[32];
    #pragma unroll
    for(int d0=0;d0<4;++d0){
      #pragma unroll
      for(int e=0;e<8;++e)qf[d0*8+e]=__uint_as_float(((unsigned)(unsigned short)qr[d0][e])<<16);}
    float v1=-INFINITY,v2=-INFINITY,v3=-INFINITY; unsigned b1=0u,b2=0u,b3=0u;
    for(int j=0;j<qb;++j){ const float*kp=km+j*64; float g=0.f;
      #pragma unroll
      for(int d0=0;d0<4;++d0){
        #pragma unroll
        for(int e=0;e<8;++e)g+=qf[d0*8+e]*kp[16*d0+e];}
      g+=__shfl_xor(g,32);
      const unsigned bj=1u<<j; const bool c1=g>v1,c2=g>v2,c3=g>v3;
      v3=c2?v2:(c3?g:v3); b3=c2?b2:(c3?bj:b3);
      v2=c1?v1:(c2?g:v2); b2=c1?b1:(c2?bj:b2);
      v1=c1?g:v1;         b1=c1?bj:b1; }
    selmask=b1|b2|b3; asm volatile("":"+v"(selmask)); }
  SBAR();
  qkt(pA0,pA1,Kbase,qr,zc,r32,hi);asm volatile("s_nop 15\n\ts_nop 7":"+v"(pA0),"+v"(pA1));AMASK(pA0,pA1,0);
  { const float rm0=rowmax(pA0,pA1); REFUPD(pA0,pA1,rm0,true); }
  _Pragma("unroll") for(int r=0;r<16;++r)pA0[r]=__builtin_amdgcn_exp2f(pA0[r]);
  _Pragma("unroll") for(int r=0;r<16;++r)pA1[r]=__builtin_amdgcn_exp2f(pA1[r]);
  WAIT_BAR(0);
  DMA_K(3,0);DMA_V(1,SLOTB);
  ROT();
  kload8(kf,kp0+sl_cur);
  WAIT_BAR(2);
  s16x4 vlo[8],vhi[8]; u32x4 pw0,pw1,pw2,pw3;
  #define PKW(P,B) (MODE?(cvtpk_s(P[B],P[B+1])&pm_):cvtpk_s(P[B],P[B+1]))
  #define PAF(k) __builtin_bit_cast(bf16x8,pw##k)
  #define VFR(i) (bf16x8){vlo[i][0],vlo[i][1],vlo[i][2],vlo[i][3],vhi[i][0],vhi[i][1],vhi[i][2],vhi[i][3]}
  #define PIN(x) asm volatile("":"+v"(x))
  #define MX3(a,b,c) __builtin_fmaxf(__builtin_fmaxf((a),(b)),(c))
  #define GAPA(MF,A0,A1,A2,A3,W0,W1,PW) do{ MF; sacc+=A0; sacc+=A1; sacc+=A2; sacc+=A3; PIN(sacc); W0; W1; PIN(PW); SBAR(); }while(0)
  #define EX(v) __builtin_amdgcn_exp2f(v)
  #define GAPB(MF,X,B) do{ MF; X[B]=EX(X[B]); X[B+1]=EX(X[B+1]); X[B+2]=EX(X[B+2]); X[B+3]=EX(X[B+3]); PIN(X); SBAR(); }while(0)
  #define VRD(i) do{ vlo[i]=vtr(vp_+(((i)>>2)*4096+((i)&3)*1024)); vhi[i]=vtr(vp_+(((i)>>2)*4096+((i)&3)*1024+512)); }while(0)
  #define KRD(G,j) do{ if(G){ kload2(kf,kp0+sl_next,j); SBAR(); } }while(0)
  #define STEP(C0,C1,P0,P1,t,GK,GV,GL) do{ SBAR(); \
    const lds_cptr vp_=vp0+sl_prev; \
    VRD(0); SBAR(); float sacc=(P0[0]+P0[1]); \
    GAPA(C0=__builtin_amdgcn_mfma_f32_32x32x16_bf16(kf[0],qr[0],zc,0,0,0), P0[2],P0[3],P0[4],P0[5],     pw0[0]=PKW(P0,0), pw0[1]=PKW(P0,2), pw0); \
    VRD(4); SBAR(); GAPA(C1=__builtin_amdgcn_mfma_f32_32x32x16_bf16(kf[1],qr[0],zc,0,0,0), P0[6],P0[7],P0[8],P0[9],     pw0[2]=PKW(P0,4), pw0[3]=PKW(P0,6), pw0); \
    VRD(1); SBAR(); GAPA(C0=__builtin_amdgcn_mfma_f32_32x32x16_bf16(kf[2],qr[1],C0,0,0,0),   P0[10],P0[11],P0[12],P0[13], pw1[0]=PKW(P0,8), pw1[1]=PKW(P0,10), pw1); \
    VRD(5); SBAR(); GAPA(C1=__builtin_amdgcn_mfma_f32_32x32x16_bf16(kf[3],qr[1],C1,0,0,0),   P0[14],P0[15],P1[0],P1[1],   pw1[2]=PKW(P0,12),pw1[3]=PKW(P0,14), pw1); \
    VRD(2); SBAR(); GAPA(C0=__builtin_amdgcn_mfma_f32_32x32x16_bf16(kf[4],qr[2],C0,0,0,0),   P1[2],P1[3],P1[4],P1[5],     pw2[0]=PKW(P1,0), pw2[1]=PKW(P1,2), pw2); \
    VRD(6); SBAR(); GAPA(C1=__builtin_amdgcn_mfma_f32_32x32x16_bf16(kf[5],qr[2],C1,0,0,0),   P1[6],P1[7],P1[8],P1[9],     pw2[2]=PKW(P1,4), pw2[3]=PKW(P1,6), pw2); \
    VRD(3); SBAR(); GAPA(C0=__builtin_amdgcn_mfma_f32_32x32x16_bf16(kf[6],qr[3],C0,0,0,0),   P1[10],P1[11],P1[12],P1[13], pw3[0]=PKW(P1,8), pw3[1]=PKW(P1,10), pw3); \
    VRD(7); SBAR(); GAPA(C1=__builtin_amdgcn_mfma_f32_32x32x16_bf16(kf[7],qr[3],C1,0,0,0),   P1[14],P1[15],0.f,0.f,       pw3[2]=PKW(P1,12),pw3[3]=PKW(P1,14), pw3); \
    l_reg+=(MODE?(pm_?sacc:0.f):sacc); \
    if(GK){DMA_K((t)+3,sl_cur);} if(GV){DMA_V((t)+1,sl_next);} \
    AMASK(C0,C1,t); \
    { float a=MX3(C0[0],C0[1],C1[0]),b=MX3(C0[2],C0[3],C1[1]); a=MX3(a,C1[2],C1[3]); \
      _Pragma("unroll") for(int r=4;r<16;r+=4){a=MX3(a,C0[r],C0[r+1]);b=MX3(b,C0[r+2],C0[r+3]);a=MX3(a,C1[r],C1[r+1]);b=MX3(b,C1[r+2],C1[r+3]);} \
      float rm=__builtin_fmaxf(a,b); { auto rr=__builtin_amdgcn_permlane32_swap(__float_as_uint(rm),__float_as_uint(rm),false,false); rm=__builtin_fmaxf(__uint_as_float(rr[0]),__uint_as_float(rr[1])); } \
      pm_=PMOF(t); if(MODE){ rm=pm_?rm:-INFINITY; } \
      REFUPD(C0,C1,rm,false); } \
    SBAR(); \
    GAPB(o[0]=__builtin_amdgcn_mfma_f32_32x32x16_bf16(PAF(0),VFR(0),o[0],0,0,0), C0,0); \
    GAPB(o[1]=__builtin_amdgcn_mfma_f32_32x32x16_bf16(PAF(0),VFR(4),o[1],0,0,0), C0,4); \
    KRD(GL,0); GAPB(o[0]=__builtin_amdgcn_mfma_f32_32x32x16_bf16(PAF(1),VFR(1),o[0],0,0,0), C0,8); \
    KRD(GL,1); GAPB(o[1]=__builtin_amdgcn_mfma_f32_32x32x16_bf16(PAF(1),VFR(5),o[1],0,0,0), C0,12); \
    KRD(GL,2); GAPB(o[0]=__builtin_amdgcn_mfma_f32_32x32x16_bf16(PAF(2),VFR(2),o[0],0,0,0), C1,0); \
    KRD(GL,3); GAPB(o[1]=__builtin_amdgcn_mfma_f32_32x32x16_bf16(PAF(2),VFR(6),o[1],0,0,0), C1,4); \
    GAPB(o[0]=__builtin_amdgcn_mfma_f32_32x32x16_bf16(PAF(3),VFR(3),o[0],0,0,0), C1,8); \
    GAPB(o[1]=__builtin_amdgcn_mfma_f32_32x32x16_bf16(PAF(3),VFR(7),o[1],0,0,0), C1,12); \
    }while(0)
  int t=1;
  for(;t+5<NT;t+=2){
    STEP(pB0,pB1,pA0,pA1,t,true,true,true);     WAIT_BAR(2); RESC(); ROT();
    STEP(pA0,pA1,pB0,pB1,t+1,true,true,true);   WAIT_BAR(2); RESC(); ROT();
  }
  #define ENDW(tt) do{ if((tt)+3<NT){WAIT_BAR(2);} else if((tt)+2<NT){WAIT_BAR(1);} else {WAIT_BAR(0);} }while(0)
  for(;t+1<NT;t+=2){
    STEP(pB0,pB1,pA0,pA1,t,(t+3<NT),(t+1<NT),(t+1<NT));       ENDW(t);   RESC(); ROT();
    STEP(pA0,pA1,pB0,pB1,t+1,(t+4<NT),(t+2<NT),(t+2<NT));     ENDW(t+1); RESC(); ROT();
  }
  STEP(pB0,pB1,pA0,pA1,NT-1,false,false,false); RESC();
  { float sacc=pB0[0]+pB0[1]; _Pragma("unroll") for(int r=2;r<16;++r)sacc+=pB0[r]; _Pragma("unroll") for(int r=0;r<16;++r)sacc+=pB1[r]; l_reg+=(MODE?(pm_?sacc:0.f):sacc);
    pw0=(u32x4){PKW(pB0,0),PKW(pB0,2),PKW(pB0,4),PKW(pB0,6)};pw1=(u32x4){PKW(pB0,8),PKW(pB0,10),PKW(pB0,12),PKW(pB0,14)};pw2=(u32x4){PKW(pB1,0),PKW(pB1,2),PKW(pB1,4),PKW(pB1,6)};pw3=(u32x4){PKW(pB1,8),PKW(pB1,10),PKW(pB1,12),PKW(pB1,14)};
    SBAR(); pv(o,vb0+sl_cur,PAF(0),PAF(1),PAF(2),PAF(3)); }
  #undef PKW
  #undef PAF
  #undef VFR
  #undef PIN
  #undef MX3
  #undef GAPA
  #undef GAPB
  #undef EX
  #undef VRD
  #undef KRD
  #undef STEP
  #undef ENDW
  {auto rr=__builtin_amdgcn_permlane32_swap(__float_as_uint(l_reg),__float_as_uint(l_reg),false,false);l_reg=__uint_as_float(rr[0])+__uint_as_float(rr[1]);}
  if(!MODE)l_reg+=__builtin_amdgcn_exp2f(aux[hw]*1.4426950408889634f-mhat);
  long grow0=rowbase+q0+wrow; asm volatile("":"+v"(grow0));
  u32x4 zv[4];
  #pragma unroll
  for(int i=0;i<4;++i){const int row=i*8+(lane>>3),ch=lane&7; zv[i]=*(const u32x4*)(Z+(grow0+row)*ADM+hw*D+ch*8);}
  if(hi==0)wsf[32+r32]=l_reg;asm volatile("s_waitcnt lgkmcnt(0)":::"memory");
  float rli[16];
  #pragma unroll
  for(int r=0;r<16;++r)rli[r]=__builtin_amdgcn_rcpf(wsf[32+crow(r,hi)]);
  { float*stg=(float*)(shm+LDS_OST)+wid*2048;
    #pragma unroll
    for(int r=0;r<16;++r){const int orow=crow(r,hi);
      #pragma unroll
      for(int d0=0;d0<2;++d0)stg[orow*64+d0*32+r32]=o[d0][r]*rli[r];}
    asm volatile("s_waitcnt lgkmcnt(0)":::"memory");
    #pragma unroll
    for(int i=0;i<4;++i){const int row=i*8+(lane>>3),ch=lane&7; const f32x4 a0=*(const f32x4*)(stg+row*64+ch*8),a1=*(const f32x4*)(stg+row*64+ch*8+4);
      float zf[8]; zf[0]=__uint_as_float(zv[i].x<<16);zf[1]=__uint_as_float(zv[i].x&0xffff0000u);zf[2]=__uint_as_float(zv[i].y<<16);zf[3]=__uint_as_float(zv[i].y&0xffff0000u);
      zf[4]=__uint_as_float(zv[i].z<<16);zf[5]=__uint_as_float(zv[i].z&0xffff0000u);zf[6]=__uint_as_float(zv[i].w<<16);zf[7]=__uint_as_float(zv[i].w&0xffff0000u);
      float gv[8];
      #pragma unroll
      for(int e=0;e<8;++e){const float ov=e<4?a0[e]:a1[e-4]; gv[e]=ov*zf[e]*__builtin_amdgcn_rcpf(1.0f+__builtin_amdgcn_exp2f(-1.4426950408889634f*zf[e]));}
      u32x4 w; w.x=cvtpk_s(gv[0],gv[1]);w.y=cvtpk_s(gv[2],gv[3]);w.z=cvtpk_s(gv[4],gv[5]);w.w=cvtpk_s(gv[6],gv[7]);
      *(u32x4*)(G+(grow0+row)*ADM+hw*D+ch*8)=w;} }
  asm volatile("s_waitcnt lgkmcnt(0)\n\ts_barrier":::"memory");
  #undef DMA_K
  #undef DMA_V
  #undef KT
  #undef AMASK
  #undef PMOF
  #undef REFUPD
  #undef RESC
  #undef ROT
}
#undef SBAR
#undef WAIT_BAR
constexpr int M2_ACC=LDS_OST, M2_QN=M2_ACC+65536, M2_LIST=M2_QN+32768, M2_CNT=M2_LIST+7680, M2_NJ=M2_CNT+960, M2_SCHED=M2_NJ+128, M2_LACC=M2_SCHED+128, M2_MACC=M2_LACC+2048, LDS_BYTES_MOBA2=M2_MACC+2048;
typedef __attribute__((address_space(3))) float* lds_fptr;
typedef __attribute__((address_space(3))) unsigned* lds_uptr;
typedef __attribute__((address_space(3))) const unsigned char* lds_bptr;
__device__ __forceinline__ unsigned pk2bf(float lo,float hi){f32x2_t v={lo,hi};bf16x2_t b=__builtin_convertvector(v,bf16x2_t);return __builtin_bit_cast(unsigned,b);}
__device__ __forceinline__ void moba2_flush(const f32x16 (&o)[2],float l_part,float m_part,int kind,lds_bptr lbase,int pos0,int nA,int nv,lds_cptr shm3,lds_fptr wsf,int wid,int r32,int hi){
  const lds_uptr acc=(lds_uptr)(shm3+M2_ACC); const lds_fptr lacc=(lds_fptr)(shm3+M2_LACC), macc=(lds_fptr)(shm3+M2_MACC);
  const float ltot=l_part+__shfl_xor(l_part,32);
  if(kind<2){
    const int base=256*kind+32*wid;
    #pragma unroll
    for(int r=0;r<16;++r)acc[(base+crow(r,hi))*32+r32]=pk2bf(o[0][r],o[1][r]);
    if(hi==0){lacc[base+r32]=ltot; macc[base+r32]=m_part;}
  } else {
    unsigned w4[4];
    #pragma unroll
    for(int g=0;g<4;++g)w4[g]=*(const __attribute__((address_space(3))) unsigned*)(lbase+8*g+4*hi);
    const bool valid=r32<nv; const int ridl=(int)lbase[r32]+((pos0+r32>=nA)?256:0); const float mcur=valid?macc[ridl]:m_part;
    if(!__any(mcur!=m_part)){
      #pragma unroll
      for(int g=0;g<4;++g){ unsigned a[4]; int ix[4];
        #pragma unroll
        for(int q=0;q<4;++q){const int cp=8*g+4*hi+q; ix[q]=((int)((w4[g]>>(8*q))&255u)+((pos0+cp>=nA)?256:0))*32+r32; a[q]=acc[ix[q]];}
        #pragma unroll
        for(int q=0;q<4;++q){ if(8*g+4*hi+q<nv)acc[ix[q]]=pk2bf(__uint_as_float(a[q]<<16)+o[0][4*g+q],__uint_as_float(a[q]&0xffff0000u)+o[1][4*g+q]); }
        asm volatile("":::"memory"); }
      if(hi==0&&valid)lacc[ridl]+=ltot;
    } else {
      const float mn=__builtin_fmaxf(mcur,m_part), fa=__builtin_amdgcn_exp2f(mcur-mn), fp=__builtin_amdgcn_exp2f(m_part-mn);
      if(hi==0){wsf[r32]=fa;wsf[32+r32]=fp;}
      asm volatile("s_waitcnt lgkmcnt(0)":::"memory");
      #pragma unroll
      for(int r=0;r<16;++r){const int cp=crow(r,hi); const int ix=((int)((w4[r>>2]>>(8*(r&3)))&255u)+((pos0+cp>=nA)?256:0))*32+r32; const float far=wsf[cp],fpr=wsf[32+cp];
        if(cp<nv){const unsigned a=acc[ix]; acc[ix]=pk2bf(__uint_as_float(a<<16)*far+o[0][r]*fpr,__uint_as_float(a&0xffff0000u)*far+o[1][r]*fpr);}}
      if(hi==0&&valid){lacc[ridl]=lacc[ridl]*fa+ltot*fp; macc[ridl]=mn;}
      asm volatile("s_waitcnt lgkmcnt(0)":::"memory");
    }
  }
}
__device__ __forceinline__ unsigned moba_gate(const bf16x8 (&qx)[4],lds_cptr kmb,int qb,int r32,int hi){
  f32x16 gacc=f32x16{};
  #pragma unroll
  for(int d0=0;d0<4;++d0){ const bf16x8 ah=*(const __attribute__((address_space(3))) bf16x8*)(kmb+r32*128+((2*d0+hi)<<4)), al=*(const __attribute__((address_space(3))) bf16x8*)(kmb+4096+r32*128+((2*d0+hi)<<4));
    gacc=__builtin_amdgcn_mfma_f32_32x32x16_bf16(ah,qx[d0],gacc,0,0,0); gacc=__builtin_amdgcn_mfma_f32_32x32x16_bf16(al,qx[d0],gacc,0,0,0); }
  float mine[8],oth[8];
  #pragma unroll
  for(int r=0;r<8;++r){mine[r]=gacc[r]; oth[r]=__shfl_xor(mine[r],32);}
  float v1=-INFINITY,v2=-INFINITY,v3=-INFINITY; unsigned b1=0u,b2=0u,b3=0u;
  #pragma unroll
  for(int j=0;j<16;++j){ const int own=(j>>2)&1, r=(j&3)+4*(j>>3); const float g=(hi==own)?mine[r]:oth[r];
    const unsigned bj=1u<<j; const bool in=j<qb; const bool c1=in&&(g>v1),c2=in&&(g>v2),c3=in&&(g>v3);
    v3=c2?v2:(c3?g:v3); b3=c2?b2:(c3?bj:b3);
    v2=c1?v1:(c2?g:v2); b2=c1?b1:(c2?bj:b2);
    v1=c1?g:v1;         b1=c1?bj:b1; }
  return b1|b2|b3;
}
#define SBAR() __builtin_amdgcn_sched_barrier(0)
#define WAIT_BAR(N) asm volatile("s_waitcnt vmcnt(" #N ") lgkmcnt(0)\n\ts_barrier":::"memory")
template<int THRL> __device__ __forceinline__ void attn_unit_moba2(int b,int hp,int qb,const bf16*Q,const bf16*__restrict__ K,const bf16*__restrict__ V,const bf16*__restrict__ Z,bf16*G,const float*__restrict__ KSUM,char*shm){
  constexpr int KVW=256;
  const int kvh=hp>>1, hA=2*hp;
  int tid_=threadIdx.x; asm volatile("":"+v"(tid_));
  const int tid=tid_,lane=tid&63,r32=lane&31,hi=lane>>5; const int wid=__builtin_amdgcn_readfirstlane(tid>>6);
  const long rowbase=(long)b*ASEQ; const int q0=qb*QB;
  const bf16*Kh=K+rowbase*KVW+kvh*D,*Vh=V+rowbase*KVW+kvh*D;
  const bf16*Qu=Q+(rowbase+q0)*ADM+hA*D;
  const unsigned lds0=(unsigned)(uintptr_t)shm;
  const lds_cptr shm3=(lds_cptr)shm;
  const lds_fptr wsf=(lds_fptr)(shm3+LDS_WS)+wid*64;
  const lds_uptr sched=(lds_uptr)(shm3+M2_SCHED);
  const int ktA=4*qb;
  int jseg_cur=0,jseg_nxt=0,gseg=0;
  #define KT(s) ((((s)>>2)<2)?(ktA+((s)&3)):(4*((((s)>>2)==gseg)?jseg_cur:jseg_nxt)+((s)&3)))
  { const float*ks=KSUM+((size_t)(b*16)*2)*256+kvh*64;
    for(int idx=tid;idx<qb*64;idx+=512){const int j=idx>>6,d=idx&63; const float m_=(ks[(size_t)(2*j)*256+d]+ks[(size_t)(2*j+1)*256+d])*(1.0f/256.0f);
      const unsigned hb_=pk2bf(m_,0.f)&0xffffu; const float hf_=__uint_as_float(hb_<<16); const unsigned lb_=pk2bf(m_-hf_,0.f)&0xffffu;
      *(__attribute__((address_space(3))) unsigned short*)(shm3+M2_LIST+idx*2)=(unsigned short)hb_; *(__attribute__((address_space(3))) unsigned short*)(shm3+M2_LIST+4096+idx*2)=(unsigned short)lb_; } }
  { u32x4 qv[4];
    #pragma unroll
    for(int k=0;k<4;++k){const int c=tid+512*k,row=c>>3,ch=c&7; qv[k]=*(const u32x4*)(Qu+(long)row*ADM+D+ch*8);}
    #pragma unroll
    for(int k=0;k<4;++k){const int c=tid+512*k,row=c>>3,ch=c&7; *(__attribute__((address_space(3))) u32x4*)(shm3+M2_QN+row*128+((ch^(row&7))<<4))=qv[k];} }
  const unsigned kvoff=(unsigned)(lane*KVW+wid*8)*2u;
  const unsigned vvoff=(unsigned)((16*(wid&3)+(lane>>2))*KVW+(wid>>2)*32+(lane&3)*8)*2u;
  const unsigned kdst=lds0+LDS_K+wid*1024, vdst=lds0+LDS_V+wid*1024;
  #define DMA_K(s,slot) glds16(Kh+(long)KT(s)*KVBLK*KVW,kvoff,(unsigned)__builtin_amdgcn_readfirstlane(kdst+(slot)))
  #define DMA_V(s,slot) glds16(Vh+(long)KT(s)*KVBLK*KVW,vvoff,(unsigned)__builtin_amdgcn_readfirstlane(vdst+(slot)))
  const char*Kbase=shm+LDS_K; bf16x8 kf[8];
  const lds_cptr kp0=shm3+LDS_K+hi*1024+r32*16; const lds_cptr vp0=shm3+LDS_V+((lane>>4)&1)*32+(lane&3)*8+(4*hi+((lane&15)>>2))*64;
  DMA_K(0,0);DMA_V(0,0);DMA_K(1,SLOTB);
  bf16x8 qr[4];
  #pragma unroll
  for(int d0=0;d0<4;++d0)qr[d0]=*reinterpret_cast<const bf16x8*>(Qu+(long)(32*wid+r32)*ADM+d0*16+hi*8);
  DMA_K(2,2*SLOTB);
  WAIT_BAR(3);
  #define QLOAD(slot_) do{ const int rq_=(slot_); _Pragma("unroll") for(int d0=0;d0<4;++d0)qr[d0]=*(const __attribute__((address_space(3))) bf16x8*)(shm3+M2_QN+rq_*128+((((2*d0+hi)^(rq_&7)))<<4)); }while(0)
  float mhat=0.f,l_reg=0.f;f32x16 o[2];o[0]=f32x16{};o[1]=f32x16{};
  const f32x16 zc=f32x16{};
  const int qrel=wid*QBLK+r32;
  bool resc=false; bool act_cur=true; int kind_cur=0, lofs_cur=0, pos0_cur=0, nA_cur=0, nv_cur=32;
  int NR=0;
  SBAR();
  {
    const lds_cptr km=shm3+M2_LIST;
    unsigned selA=moba_gate(qr,km,qb,r32,hi);
#ifdef M2_DUPGATE
    { asm volatile("":"+v"(selA)); bf16x8 q2_[4]; _Pragma("unroll") for(int d0=0;d0<4;++d0){q2_[d0]=qr[d0]; asm volatile("":"+v"(q2_[d0]));} selA^=moba_gate(q2_,km,qb,r32,hi)^selA; const unsigned s3_=moba_gate(q2_,km+((int)(selA&0u)),qb,r32,hi); selA|=s3_&0u; }
#endif
    bf16x8 qb_[4]; { const int rq_=32*wid+r32;
      #pragma unroll
      for(int d0=0;d0<4;++d0)qb_[d0]=*(const __attribute__((address_space(3))) bf16x8*)(shm3+M2_QN+rq_*128+((((2*d0+hi)^(rq_&7)))<<4)); }
    const unsigned selB=moba_gate(qb_,km,qb,r32,hi);
    const lds_uptr cnt=(lds_uptr)(shm3+M2_CNT);
    { unsigned myA=0u,myB=0u;
      for(int j=0;j<qb;++j){ const unsigned mA=(unsigned)__ballot(((selA>>j)&1u)!=0u&&hi==0), mB=(unsigned)__ballot(((selB>>j)&1u)!=0u&&hi==0);
        if(lane==j){myA=(unsigned)__builtin_popcount(mA); myB=(unsigned)__builtin_popcount(mB);} }
      if(lane<qb){cnt[lane*16+wid]=myA; cnt[lane*16+8+wid]=myB;} }
    asm volatile("s_waitcnt lgkmcnt(0)\n\ts_barrier":::"memory");
    { unsigned nAj=0u,offAj=0u,offBj=0u,totj=0u;
      if(lane<qb){ const __attribute__((address_space(3))) u32x4* cp_=(const __attribute__((address_space(3))) u32x4*)(shm3+M2_CNT+lane*64);
        const u32x4 c0=cp_[0],c1=cp_[1],c2=cp_[2],c3=cp_[3]; const unsigned ca[8]={c0.x,c0.y,c0.z,c0.w,c1.x,c1.y,c1.z,c1.w}, cb[8]={c2.x,c2.y,c2.z,c2.w,c3.x,c3.y,c3.z,c3.w};
        unsigned nB=0u;
        #pragma unroll
        for(int w=0;w<8;++w){ nAj+=ca[w]; nB+=cb[w]; offAj+=(w<wid)?ca[w]:0u; offBj+=(w<wid)?cb[w]:0u; }
        offBj+=nAj; totj=nAj+nB;
        if(wid==0){((lds_uptr)(shm3+M2_NJ))[2*lane]=nAj;((lds_uptr)(shm3+M2_NJ))[2*lane+1]=totj;} }
      const unsigned below=(1u<<r32)-1u;
      for(int j=0;j<qb;++j){ const bool inA=((selA>>j)&1u)!=0u&&hi==0, inB=((selB>>j)&1u)!=0u&&hi==0; const unsigned mA=(unsigned)__ballot(inA), mB=(unsigned)__ballot(inB);
        const unsigned oa=(unsigned)__builtin_amdgcn_readlane((int)offAj,j), ob=(unsigned)__builtin_amdgcn_readlane((int)offBj,j);
        if(inA)*(__attribute__((address_space(3))) unsigned char*)(shm3+M2_LIST+j*512+oa+(unsigned)__builtin_popcount(mA&below))=(unsigned char)(32*wid+r32);
        if(inB)*(__attribute__((address_space(3))) unsigned char*)(shm3+M2_LIST+j*512+ob+(unsigned)__builtin_popcount(mB&below))=(unsigned char)(32*wid+r32); }
      if(wid==0){
        const int tot=(int)totj; const int nr=(tot+255)>>8; int pre=nr;
        #pragma unroll
        for(int d_=1;d_<16;d_<<=1){ const int v_=__shfl_up(pre,d_); if(lane>=d_)pre+=v_; }
        const int k0=pre-nr;
        if(nr>0)sched[k0]=(unsigned)(lane|(0<<8)|((tot<256?tot:256)<<16));
        if(nr>1)sched[k0+1]=(unsigned)(lane|(1<<8)|((tot-256)<<16));
        const int total=__shfl(pre,15); if(lane==0)sched[31]=(unsigned)total; } }
    asm volatile("s_waitcnt lgkmcnt(0)\n\ts_barrier":::"memory");
    NR=__builtin_amdgcn_readfirstlane((int)sched[31]);
  }
  const int NT=4*(2+NR);
  SBAR();
  #define RESC() do{ if(resc){ asm volatile("s_waitcnt lgkmcnt(0)":::"memory"); \
      _Pragma("unroll") for(int d_=0;d_<2;++d_) _Pragma("unroll") for(int r=0;r<16;++r)o[d_][r]*=wsf[crow(r,hi)]; } }while(0)
  #define REFUPD(C0,C1,rm,LOWOK) do{ resc=false; \
      const float gr_=rm-mhat; \
      if(__builtin_expect(__any((gr_>(float)THRL)||((LOWOK)&&(rm<-60.f)&&(rm>-INFINITY))),0)){ \
        const float dl=((LOWOK)&&(rm<-60.f)&&(rm>-INFINITY))?gr_:__builtin_fmaxf(gr_,0.f); mhat+=dl; \
        const float f=__builtin_amdgcn_exp2f(-dl); l_reg*=f; if(hi==0)wsf[r32]=f; resc=true; } \
      if(__builtin_expect(__any(mhat!=0.f),0)){ _Pragma("unroll") for(int r=0;r<16;++r){C0[r]-=mhat;C1[r]-=mhat;} } }while(0)
  f32x16 pA0,pA1,pB0,pB1;
  int sl_prev=0,sl_cur=0,sl_next=SLOTB;
  #define ROT() do{sl_prev=sl_cur;sl_cur=sl_next;sl_next=(sl_next==(NSLOT-1)*SLOTB)?0:sl_next+SLOTB;}while(0)
  qkt(pA0,pA1,Kbase,qr,zc,r32,hi);asm volatile("s_nop 15\n\ts_nop 7":"+v"(pA0),"+v"(pA1));cmask(pA0,pA1,0,qrel,hi);
  { const float rm0=rowmax(pA0,pA1); REFUPD(pA0,pA1,rm0,true); }
  _Pragma("unroll") for(int r=0;r<16;++r)pA0[r]=__builtin_amdgcn_exp2f(pA0[r]);
  _Pragma("unroll") for(int r=0;r<16;++r)pA1[r]=__builtin_amdgcn_exp2f(pA1[r]);
  WAIT_BAR(0);
  DMA_K(3,0);DMA_V(1,SLOTB);
  ROT();
  kload8(kf,kp0+sl_cur);
  WAIT_BAR(2);
  s16x4 vlo[8],vhi[8]; u32x4 pw0,pw1,pw2,pw3;
  #define PKW(P,B) cvtpk_s(P[B],P[B+1])
  #define PAF(k) __builtin_bit_cast(bf16x8,pw##k)
  #define VFR(i) (bf16x8){vlo[i][0],vlo[i][1],vlo[i][2],vlo[i][3],vhi[i][0],vhi[i][1],vhi[i][2],vhi[i][3]}
  #define PIN(x) asm volatile("":"+v"(x))
  #define MX3(a,b,c) __builtin_fmaxf(__builtin_fmaxf((a),(b)),(c))
  #define GAPA(MF,A0,A1,A2,A3,W0,W1,PW) do{ MF; sacc+=A0; sacc+=A1; sacc+=A2; sacc+=A3; PIN(sacc); W0; W1; PIN(PW); SBAR(); }while(0)
  #define EX(v) __builtin_amdgcn_exp2f(v)
  #define GAPB(MF,X,B) do{ MF; X[B]=EX(X[B]); X[B+1]=EX(X[B+1]); X[B+2]=EX(X[B+2]); X[B+3]=EX(X[B+3]); PIN(X); SBAR(); }while(0)
  #define VRD(i) do{ vlo[i]=vtr(vp_+(((i)>>2)*4096+((i)&3)*1024)); vhi[i]=vtr(vp_+(((i)>>2)*4096+((i)&3)*1024+512)); }while(0)
  #define KRD(G,j) do{ if(G){ kload2(kf,kp0+sl_next,j); SBAR(); } }while(0)
  #define QGATHER(k_) do{ const unsigned e_=(unsigned)__builtin_amdgcn_readfirstlane((int)sched[(k_)]); const int j_=(int)(e_&255u), r_=(int)((e_>>8)&255u); \
      const int nA_=__builtin_amdgcn_readfirstlane((int)((lds_uptr)(shm3+M2_NJ))[2*j_]); \
      _Pragma("unroll") for(int q_=0;q_<4;++q_){ const int slot_=32*wid+8*q_+(lane>>3); const int pos_=256*r_+slot_; \
        const int tok_=(int)*(lds_bptr)(shm3+M2_LIST+j_*512+pos_); const int hd_=(pos_>=nA_)?1:0; \
        glds16(Qu,(unsigned)((tok_*ADM+hd_*D)*2+(((lane&7)^(slot_&7))<<4)),(unsigned)__builtin_amdgcn_readfirstlane(lds0+M2_QN+(32*wid+8*q_)*128)); } }while(0)
  #define STEP(C0,C1,P0,P1,t,GK,GV,GL,BND,RF) do{ \
    const bool bnd_=(BND)&&(((t)&3)==0); const bool act_old_=act_cur; const int kind_old_=kind_cur, lofs_old_=lofs_cur, pos0_old_=pos0_cur, nA_old_=nA_cur, nv_old_=nv_cur; \
    if(bnd_){ const int g_=(t)>>2; gseg=g_; jseg_cur=jseg_nxt; jseg_nxt=(g_-1<NR)?(int)(__builtin_amdgcn_readfirstlane((int)sched[g_-1])&255):0; \
      if(g_==1){ kind_cur=1; act_cur=true; QLOAD(32*wid+r32); } \
      else { const unsigned e_=(unsigned)__builtin_amdgcn_readfirstlane((int)sched[g_-2]); const int j_=(int)(e_&255u), r_=(int)((e_>>8)&255u), n_=(int)(e_>>16); \
        kind_cur=2; lofs_cur=j_*512+256*r_+32*wid; pos0_cur=256*r_+32*wid; nA_cur=__builtin_amdgcn_readfirstlane((int)((lds_uptr)(shm3+M2_NJ))[2*j_]); nv_cur=n_-32*wid; act_cur=nv_cur>0; \
        if(act_cur){ QLOAD(32*wid+r32); } } } \
    if(GK){DMA_K((t)+3,sl_cur);} if(GV){DMA_V((t)+1,sl_next);} \
    if((RF)&&(((t)&3)==1)&&((t)>>2)>=1&&((t)>>2)-1<NR){ QGATHER(((t)>>2)-1); rf_=true; } \
    if(act_cur||act_old_){ SBAR(); \
    const lds_cptr vp_=vp0+sl_prev; \
    VRD(0); SBAR(); float sacc=(P0[0]+P0[1]); \
    GAPA(C0=__builtin_amdgcn_mfma_f32_32x32x16_bf16(kf[0],qr[0],zc,0,0,0), P0[2],P0[3],P0[4],P0[5],     pw0[0]=PKW(P0,0), pw0[1]=PKW(P0,2), pw0); \
    VRD(4); SBAR(); GAPA(C1=__builtin_amdgcn_mfma_f32_32x32x16_bf16(kf[1],qr[0],zc,0,0,0), P0[6],P0[7],P0[8],P0[9],     pw0[2]=PKW(P0,4), pw0[3]=PKW(P0,6), pw0); \
    VRD(1); SBAR(); GAPA(C0=__builtin_amdgcn_mfma_f32_32x32x16_bf16(kf[2],qr[1],C0,0,0,0),   P0[10],P0[11],P0[12],P0[13], pw1[0]=PKW(P0,8), pw1[1]=PKW(P0,10), pw1); \
    VRD(5); SBAR(); GAPA(C1=__builtin_amdgcn_mfma_f32_32x32x16_bf16(kf[3],qr[1],C1,0,0,0),   P0[14],P0[15],P1[0],P1[1],   pw1[2]=PKW(P0,12),pw1[3]=PKW(P0,14), pw1); \
    VRD(2); SBAR(); GAPA(C0=__builtin_amdgcn_mfma_f32_32x32x16_bf16(kf[4],qr[2],C0,0,0,0),   P1[2],P1[3],P1[4],P1[5],     pw2[0]=PKW(P1,0), pw2[1]=PKW(P1,2), pw2); \
    VRD(6); SBAR(); GAPA(C1=__builtin_amdgcn_mfma_f32_32x32x16_bf16(kf[5],qr[2],C1,0,0,0),   P1[6],P1[7],P1[8],P1[9],     pw2[2]=PKW(P1,4), pw2[3]=PKW(P1,6), pw2); \
    VRD(3); SBAR(); GAPA(C0=__builtin_amdgcn_mfma_f32_32x32x16_bf16(kf[6],qr[3],C0,0,0,0),   P1[10],P1[11],P1[12],P1[13], pw3[0]=PKW(P1,8), pw3[1]=PKW(P1,10), pw3); \
    VRD(7); SBAR(); GAPA(C1=__builtin_amdgcn_mfma_f32_32x32x16_bf16(kf[7],qr[3],C1,0,0,0),   P1[14],P1[15],0.f,0.f,       pw3[2]=PKW(P1,12),pw3[3]=PKW(P1,14), pw3); \
    l_reg+=sacc; \
    float l_old_=0.f,m_old_=0.f; \
    if(bnd_){ l_old_=l_reg; m_old_=mhat; l_reg=0.f; mhat=0.f; }     \
    if((t)<8)cmask(C0,C1,(t)&3,qrel,hi); \
    { float a=MX3(C0[0],C0[1],C1[0]),b=MX3(C0[2],C0[3],C1[1]); a=MX3(a,C1[2],C1[3]); \
      _Pragma("unroll") for(int r=4;r<16;r+=4){a=MX3(a,C0[r],C0[r+1]);b=MX3(b,C0[r+2],C0[r+3]);a=MX3(a,C1[r],C1[r+1]);b=MX3(b,C1[r+2],C1[r+3]);} \
      float rm=__builtin_fmaxf(a,b); { auto rr=__builtin_amdgcn_permlane32_swap(__float_as_uint(rm),__float_as_uint(rm),false,false); rm=__builtin_fmaxf(__uint_as_float(rr[0]),__uint_as_float(rr[1])); } \
      REFUPD(C0,C1,rm,(t)==4); } \
    SBAR(); \
    GAPB(o[0]=__builtin_amdgcn_mfma_f32_32x32x16_bf16(PAF(0),VFR(0),o[0],0,0,0), C0,0); \
    GAPB(o[1]=__builtin_amdgcn_mfma_f32_32x32x16_bf16(PAF(0),VFR(4),o[1],0,0,0), C0,4); \
    KRD(GL,0); GAPB(o[0]=__builtin_amdgcn_mfma_f32_32x32x16_bf16(PAF(1),VFR(1),o[0],0,0,0), C0,8); \
    KRD(GL,1); GAPB(o[1]=__builtin_amdgcn_mfma_f32_32x32x16_bf16(PAF(1),VFR(5),o[1],0,0,0), C0,12); \
    KRD(GL,2); GAPB(o[0]=__builtin_amdgcn_mfma_f32_32x32x16_bf16(PAF(2),VFR(2),o[0],0,0,0), C1,0); \
    KRD(GL,3); GAPB(o[1]=__builtin_amdgcn_mfma_f32_32x32x16_bf16(PAF(2),VFR(6),o[1],0,0,0), C1,4); \
    GAPB(o[0]=__builtin_amdgcn_mfma_f32_32x32x16_bf16(PAF(3),VFR(3),o[0],0,0,0), C1,8); \
    GAPB(o[1]=__builtin_amdgcn_mfma_f32_32x32x16_bf16(PAF(3),VFR(7),o[1],0,0,0), C1,12); \
    if(bnd_){ asm volatile("s_nop 15\n\ts_nop 7":"+v"(o[0]),"+v"(o[1])); \
      if(act_old_){ moba2_flush(o,l_old_,m_old_,kind_old_,(lds_bptr)(shm3+M2_LIST+lofs_old_),pos0_old_,nA_old_,nv_old_,shm3,wsf,wid,r32,hi); } \
      o[0]=f32x16{};o[1]=f32x16{}; } \
    } else { if(GL){kload8(kf,kp0+sl_next);} resc=false; } \
    }while(0)
  int t=1; bool rf_=false;
  for(;t+5<NT;t+=2){
    rf_=false;
    STEP(pB0,pB1,pA0,pA1,t,true,true,true,false,true);   if(rf_){WAIT_BAR(6);}else{WAIT_BAR(2);} RESC(); ROT();
    STEP(pA0,pA1,pB0,pB1,t+1,true,true,true,true,false);  WAIT_BAR(2); RESC(); ROT();
  }
  #define ENDW(tt) do{ if((tt)+3<NT){WAIT_BAR(2);} else if((tt)+2<NT){WAIT_BAR(1);} else {WAIT_BAR(0);} }while(0)
  for(;t+1<NT;t+=2){
    STEP(pB0,pB1,pA0,pA1,t,(t+3<NT),(t+1<NT),(t+1<NT),false,false);       ENDW(t);   RESC(); ROT();
    STEP(pA0,pA1,pB0,pB1,t+1,(t+4<NT),(t+2<NT),(t+2<NT),true,false);       ENDW(t+1); RESC(); ROT();
  }
  STEP(pB0,pB1,pA0,pA1,NT-1,false,false,false,false,false); RESC();
  if(act_cur){ float sacc=pB0[0]+pB0[1]; _Pragma("unroll") for(int r=2;r<16;++r)sacc+=pB0[r]; _Pragma("unroll") for(int r=0;r<16;++r)sacc+=pB1[r]; l_reg+=sacc;
    pw0=(u32x4){PKW(pB0,0),PKW(pB0,2),PKW(pB0,4),PKW(pB0,6)};pw1=(u32x4){PKW(pB0,8),PKW(pB0,10),PKW(pB0,12),PKW(pB0,14)};pw2=(u32x4){PKW(pB1,0),PKW(pB1,2),PKW(pB1,4),PKW(pB1,6)};pw3=(u32x4){PKW(pB1,8),PKW(pB1,10),PKW(pB1,12),PKW(pB1,14)};
    const int vb0=(int)(lds0+LDS_V)+((lane>>4)&1)*32+(lane&3)*8+(4*hi+((lane&15)>>2))*64;
    SBAR(); pv(o,vb0+sl_cur,PAF(0),PAF(1),PAF(2),PAF(3));
    asm volatile("s_nop 15\n\ts_nop 7":"+v"(o[0]),"+v"(o[1]));
    moba2_flush(o,l_reg,mhat,kind_cur,(lds_bptr)(shm3+M2_LIST+lofs_cur),pos0_cur,nA_cur,nv_cur,shm3,wsf,wid,r32,hi); }
  #undef PKW
  #undef PAF
  #undef VFR
  #undef PIN
  #undef MX3
  #undef GAPA
  #undef GAPB
  #undef EX
  #undef VRD
  #undef KRD
  #undef STEP
  #undef ENDW
  #undef QGATHER
  asm volatile("s_waitcnt lgkmcnt(0)\n\ts_barrier":::"memory");
#ifdef M2_DUPEPI
  for(int rep_=0;rep_<2;++rep_)
#endif
  { const int hd=wid>>2; long grow0=rowbase+q0+(wid&3)*64; asm volatile("":"+v"(grow0));
    const lds_uptr acc=(lds_uptr)(shm3+M2_ACC)+wid*2048; const lds_fptr lacc=(lds_fptr)(shm3+M2_LACC)+wid*64;
    #pragma unroll
    for(int ib=0;ib<8;ib+=4){
      u32x4 zv[4];
      #pragma unroll
      for(int i=0;i<4;++i){const int row=(ib+i)*8+(lane>>3),ch=lane&7; zv[i]=*(const u32x4*)(Z+(grow0+row)*ADM+(hA+hd)*D+ch*8);}
      #pragma unroll
      for(int i=0;i<4;++i){const int row=(ib+i)*8+(lane>>3),ch=lane&7;
        const u32x4 a0=*(const __attribute__((address_space(3))) u32x4*)(acc+row*32+8*(ch&3)),a1=*(const __attribute__((address_space(3))) u32x4*)(acc+row*32+8*(ch&3)+4);
        const float li=__builtin_amdgcn_rcpf(lacc[row]); const bool up=ch>=4;
        float ov[8]; ov[0]=__uint_as_float(up?(a0.x&0xffff0000u):(a0.x<<16));ov[1]=__uint_as_float(up?(a0.y&0xffff0000u):(a0.y<<16));ov[2]=__uint_as_float(up?(a0.z&0xffff0000u):(a0.z<<16));ov[3]=__uint_as_float(up?(a0.w&0xffff0000u):(a0.w<<16));
        ov[4]=__uint_as_float(up?(a1.x&0xffff0000u):(a1.x<<16));ov[5]=__uint_as_float(up?(a1.y&0xffff0000u):(a1.y<<16));ov[6]=__uint_as_float(up?(a1.z&0xffff0000u):(a1.z<<16));ov[7]=__uint_as_float(up?(a1.w&0xffff0000u):(a1.w<<16));
        float zf[8]; zf[0]=__uint_as_float(zv[i].x<<16);zf[1]=__uint_as_float(zv[i].x&0xffff0000u);zf[2]=__uint_as_float(zv[i].y<<16);zf[3]=__uint_as_float(zv[i].y&0xffff0000u);
        zf[4]=__uint_as_float(zv[i].z<<16);zf[5]=__uint_as_float(zv[i].z&0xffff0000u);zf[6]=__uint_as_float(zv[i].w<<16);zf[7]=__uint_as_float(zv[i].w&0xffff0000u);
        float gv[8];
        #pragma unroll
        for(int e=0;e<8;++e)gv[e]=ov[e]*li*zf[e]*__builtin_amdgcn_rcpf(1.0f+__builtin_amdgcn_exp2f(-1.4426950408889634f*zf[e]));
        u32x4 w; w.x=cvtpk_s(gv[0],gv[1]);w.y=cvtpk_s(gv[2],gv[3]);w.z=cvtpk_s(gv[4],gv[5]);w.w=cvtpk_s(gv[6],gv[7]);
        *(u32x4*)(G+(grow0+row)*ADM+(hA+hd)*D+ch*8)=w;} } }
  asm volatile("s_waitcnt lgkmcnt(0)\n\ts_barrier":::"memory");
  #undef DMA_K
  #undef DMA_V
  #undef KT
  #undef QLOAD
  #undef REFUPD
  #undef RESC
  #undef ROT
}
#undef SBAR
#undef WAIT_BAR
constexpr int ATTN_LDS_BYTES=LDS_BYTES_MOBA2;
}

#define GAS __attribute__((address_space(1)))
#define LAS __attribute__((address_space(3)))
typedef unsigned short bf16;
typedef unsigned v4u __attribute__((ext_vector_type(4)));
typedef float f32x4 __attribute__((ext_vector_type(4)));
typedef short bf16x8 __attribute__((ext_vector_type(8)));
typedef GAS unsigned gu32;
typedef GAS unsigned long long gu64;
#define RLX_AGENT __ATOMIC_RELAXED, __HIP_MEMORY_SCOPE_AGENT
#define LDS_WAIT() asm volatile("s_waitcnt lgkmcnt(0)" ::: "memory")
#define VM_WAIT() asm volatile("s_waitcnt vmcnt(0)" ::: "memory")
__device__ __forceinline__ unsigned long long rt() { return __builtin_amdgcn_s_memrealtime(); }
__device__ __forceinline__ unsigned pk2(float lo, float hi) { return f2bf(lo) | (f2bf(hi) << 16); }

#define XB_TMO      128
#define XB_XCNT(j)  (256  + 64 * (j))
#define XB_XSUB(j)  (1280 + 64 * (j))
#define XB_XGEN(j)  (2304 + 64 * (j))
#define XB_TOP      3328
#define XB_TOPGEN   3392
#define XCD_BAR_WORDS 3456
#define XB_SPIN_CAP (1u << 18)

__device__ __forceinline__ unsigned xb_ld(unsigned* p)              { return __hip_atomic_load(p, __ATOMIC_RELAXED, __HIP_MEMORY_SCOPE_AGENT); }
__device__ __forceinline__ unsigned xb_add(unsigned* p, unsigned v) { return __hip_atomic_fetch_add(p, v, __ATOMIC_RELAXED, __HIP_MEMORY_SCOPE_AGENT); }
__device__ __forceinline__ unsigned xb_xcc_id() { return (unsigned)__builtin_amdgcn_s_getreg((3 << 11) | 20) & 0xFu; }
#define XB_SPIN(cond, bar) do { unsigned _sp = 0; while (cond) { __builtin_amdgcn_s_sleep(1); \
    if ((++_sp & 255u) == 0u) { if (xb_ld(&(bar)[XB_TMO])) break; if (_sp > XB_SPIN_CAP) { atomicAdd(&(bar)[XB_TMO], 1u); break; } } } } while (0)

struct XcdBarrier {
    unsigned* bar; unsigned x;
    volatile LAS unsigned* st;
};

__device__ __forceinline__ XcdBarrier xcd_barrier_post(unsigned* bar, volatile LAS unsigned* st) {
    XcdBarrier b; b.bar = bar; b.x = xb_xcc_id(); b.st = st;
    if (threadIdx.x == 0) (void)xb_add(&bar[XB_XCNT(b.x)], 1u);
    return b;
}
__device__ __forceinline__ void xcd_barrier_complete(unsigned* bar, unsigned x, unsigned& nloc, unsigned& nx) {
    const unsigned G = gridDim.x * gridDim.y * gridDim.z;
    unsigned sum, cnt, mine, sp = 0u;
    for (;;) {
        sum = 0u; cnt = 0u; mine = 0u;
#pragma unroll
        for (unsigned j = 0; j < 16; ++j) { const unsigned c = xb_ld(&bar[XB_XCNT(j)]); sum += c; cnt += (c > 0u) ? 1u : 0u; mine = (j == x) ? c : mine; }
        if (sum == G) break;
        __builtin_amdgcn_s_sleep(1);
        if ((++sp & 255u) == 0u) { if (xb_ld(&bar[XB_TMO])) break; if (sp > XB_SPIN_CAP) { atomicAdd(&bar[XB_TMO], 1u); break; } }
    }
    nloc = mine > 0u ? mine : 1u; nx = cnt > 0u ? cnt : 1u;
}

__device__ __forceinline__ void xcd_barrier(const XcdBarrier& b) {
    asm volatile("s_waitcnt vmcnt(0)" ::: "memory");
    __syncthreads();
    if (threadIdx.x == 0) {
        unsigned* bar = b.bar;
        __builtin_amdgcn_s_waitcnt(0);
        unsigned nloc = b.st[0], nx = b.st[1];
        if (nloc == 0u) { xcd_barrier_complete(bar, b.x, nloc, nx); b.st[0] = nloc; b.st[1] = nx; }
        const unsigned old = xb_add(&bar[XB_XSUB(b.x)], 1u);
        const unsigned gen = old / nloc;
        if (old + 1u == (gen + 1u) * nloc) {
            __builtin_amdgcn_fence(__ATOMIC_RELEASE, "agent");
            asm volatile("s_waitcnt vmcnt(0)" ::: "memory");
            const unsigned og = xb_add(&bar[XB_TOP], 1u);
            const unsigned tg = og / nx;
            if (og + 1u == (tg + 1u) * nx) xb_add(&bar[XB_TOPGEN], 1u);
            else XB_SPIN(xb_ld(&bar[XB_TOPGEN]) == tg, bar);
            __builtin_amdgcn_fence(__ATOMIC_ACQUIRE, "agent");
            xb_add(&bar[XB_XGEN(b.x)], 1u);
            asm volatile("s_waitcnt vmcnt(0)" ::: "memory");
        } else {
            XB_SPIN(xb_ld(&bar[XB_XGEN(b.x)]) == gen, bar);
            __builtin_amdgcn_fence(__ATOMIC_ACQUIRE, "agent");
            asm volatile("s_waitcnt vmcnt(0)" ::: "memory");
        }
    }
    __syncthreads();
}

constexpr int NWAVES = 8;
#ifndef MK_EN
#define MK_EN 15
#endif
constexpr int NPH = 14;
constexpr int RING_OFF = 0, RING_BYTES = 131072;
constexpr int LDS_BYTES = 163840;
constexpr int LDSCTL_OFF = LDS_BYTES - 512, MISC_OFF = LDSCTL_OFF + 320;
constexpr int CW_TMO = 0, CW_BAR = 4096;
constexpr size_t CTL_ZERO_BYTES = 64 * 1024;
static_assert((CW_BAR + XCD_BAR_WORDS) * 4 <= (int)CTL_ZERO_BYTES, "barrier words inside the memset region");
static_assert(attn_body::ATTN_LDS_BYTES <= LDSCTL_OFF && attn_body::LDS_BYTES <= RING_BYTES, "attention LDS");

__constant__ const unsigned ROPE_INV_BITS[32] = {0x3f800000u, 0x3f3ff911u, 0x3f0ff59au, 0x3ed7e89bu, 0x3ea1e89bu, 0x3e72d424u, 0x3e361887u, 0x3e088d77u, 0x3dcccccdu, 0x3d99940eu, 0x3d6655c3u, 0x3d2cba15u, 0x3d0186e2u, 0x3cc24350u, 0x3c91ad39u, 0x3c5a7bf1u,
    0x3c23d70au, 0x3bf5b9b0u, 0x3bb8449cu, 0x3b8a2e77u, 0x3b4f3e37u, 0x3b1b690du, 0x3ae91528u, 0x3aaec98eu, 0x3a83126fu, 0x3a44948cu, 0x3a136a16u, 0x39dd1726u, 0x39a5cb5fu, 0x3978a814u, 0x393a7753u, 0x390bd472u};
struct Args { const float* in[7]; float* out; unsigned char* ws; int ph_lo, ph_hi; };

__device__ __forceinline__ void p0_w_item(const float* __restrict__ W, int ldw, int k0, int n0, bool perm, const float* __restrict__ g, bf16_t* __restrict__ Wt, LAS float* scr, int lane) {
#pragma unroll
    for (int kb = 0; kb < 64; kb += 32) { float wv[32];
#pragma unroll
        for (int kk = 0; kk < 32; ++kk) wv[kk] = W[(size_t)(k0 + kb + kk) * ldw + n0 + lane];
#pragma unroll
        for (int kk = 0; kk < 32; ++kk) { const float gv = g ? g[k0 + kb + kk] : 1.0f; scr[(kb + kk) * 65 + lane] = wv[kk] * gv; } }
    LDS_WAIT(); asm volatile("" ::: "memory");
    const int c = lane & 7;
#pragma unroll
    for (int j = 0; j < 8; ++j) { const int n = (lane >> 3) + 8 * j; const int sc = perm ? dmap(n) : n; const LAS float* s = scr + (8 * c) * 65 + sc;
        v4u o; o.x = pk2(s[0 * 65], s[1 * 65]); o.y = pk2(s[2 * 65], s[3 * 65]); o.z = pk2(s[4 * 65], s[5 * 65]); o.w = pk2(s[6 * 65], s[7 * 65]);
        *(GAS v4u*)(Wt + (size_t)(n0 + n) * 1024 + k0 + 8 * c) = o; }
    LDS_WAIT(); asm volatile("" ::: "memory");
}

__global__ void __launch_bounds__(NWAVES * 64, 2) mk_fwd(Args args) {
    extern __shared__ __attribute__((aligned(16))) unsigned char lds[];
    LAS unsigned char* ldsp = (LAS unsigned char*)lds;
    volatile LAS unsigned* MISC = (volatile LAS unsigned*)(ldsp + MISC_OFF);
    const int tid0 = threadIdx.x;
    gu32* ctl = (gu32*)(args.ws + WS_CTL);
    for (int u = tid0; u < (LDS_BYTES - LDSCTL_OFF) / 4; u += NWAVES * 64) ((LAS unsigned*)(ldsp + LDSCTL_OFF))[u] = 0u;
    __syncthreads();
    const int lo = args.ph_lo, hi = args.ph_hi;
    XcdBarrier bar; bar.bar = (unsigned*)(ctl + CW_BAR); bar.x = 0; bar.st = nullptr;
    if (hi - lo > 1) bar = xcd_barrier_post((unsigned*)(ctl + CW_BAR), MISC + 8);

#ifndef MK_DUP
#define MK_DUP (-1)
#endif
    for (int pk = lo; pk < hi + (MK_DUP >= 0 ? 1 : 0); ++pk) {
        const int p = (MK_DUP >= 0 && pk > MK_DUP) ? pk - 1 : pk;
        int tid = threadIdx.x, G = gridDim.x, bx = blockIdx.x; asm volatile("" : "+v"(tid), "+s"(G), "+s"(bx));
        const int lane = tid & 63, wave = __builtin_amdgcn_readfirstlane(tid >> 6);
        const int vcu = (G % 8 == 0) ? (bx % 8) * (G / 8) + bx / 8 : bx;
        const int gw = vcu * NWAVES + wave, NGW = G * NWAVES;
        GAS unsigned char* wsg = (GAS unsigned char*)args.ws; asm volatile("" : "+s"(wsg)); unsigned char* ws = (unsigned char*)wsg;
#define xin (args.in[0])
#define norm_g (args.in[1])
#define w_in_a (args.in[2])
#define sinks_a (args.in[3])
#define w_in_b (args.in[4])
#define w_out (args.in[5])
#define final_g (args.in[6])
#define H (args.out)
#define rope ((float*)(ws + WS_ROPE))
#define ss ((float*)(ws + WS_SS))
#define KS ((float*)(ws + WS_KS))
#define Hb ((bf16_t*)(ws + WS_HB))
#define Qb ((bf16_t*)(ws + WS_Q))
#define Zb ((bf16_t*)(ws + WS_Z))
#define Gb ((bf16_t*)(ws + WS_G))
#define Kb ((bf16_t*)(ws + WS_K))
#define Vb ((bf16_t*)(ws + WS_V))
        if (p == 0) {
            for (int idx = bx * (NWAVES * 64) + tid; idx < SEQ * 32; idx += G * NWAVES * 64) {
                const int pos = idx >> 5, i = idx & 31;
                const float ang = (float)pos * __uint_as_float(ROPE_INV_BITS[i]);
                float sn, cs; sincosf(ang, &sn, &cs);
                rope[2 * idx] = cs; rope[2 * idx + 1] = sn;
            }
            LAS float* scr = (LAS float*)(ldsp + RING_OFF + wave * 16640);
            constexpr int I_A = (IN_A / 64) * 16, I_B = (IN_B / 64) * 16, I_O = 256, I_L2 = I_A + I_O + I_B + I_O, NITEMS = 2 * I_L2;
            for (int it = gw; it < NITEMS; it += NGW) {
                const int l2 = it / I_L2; int r = it % I_L2; int l; bool isw2 = false; int IN = IN_A;
                if (r < I_A) { l = 2 * l2; }
                else if (r < I_A + I_O) { r -= I_A; l = 2 * l2; isw2 = true; }
                else if (r < I_A + I_O + I_B) { r -= I_A + I_O; l = 2 * l2 + 1; IN = IN_B; }
                else { r -= I_A + I_O + I_B; l = 2 * l2 + 1; isw2 = true; }
                const int cg = r >> 4, kg = r & 15;
                if (isw2) p0_w_item(w_out + (size_t)l * DM * DM, DM, kg * 64, cg * 64, false, nullptr, (bf16_t*)(ws + WS_W2T + l * W2T_STRIDE), scr, lane);
                else { const float* Win = (l & 1) ? w_in_b + (size_t)l2 * DM * IN_B : w_in_a + (size_t)l2 * DM * IN_A; const int kvw = (l & 1) ? 256 : 128;
                       p0_w_item(Win, IN, kg * 64, cg * 64, cg * 64 < 1024 + kvw, norm_g + l * DM, (bf16_t*)(ws + WS_W1T + l * W1T_STRIDE), scr, lane); }
            }
            for (int row = gw; row < M; row += 2 * NGW) {
                const int row2 = row + NGW; const bool two = row2 < M;
                const f32x4* xr = (const f32x4*)(xin + (size_t)row * DM) + lane; const f32x4* xr2 = (const f32x4*)(xin + (size_t)(two ? row2 : row) * DM) + lane;
                f32x4 va[4], vb[4];
#pragma unroll
                for (int j = 0; j < 4; ++j) { va[j] = xr[64 * j]; vb[j] = xr2[64 * j]; }
                float s = 0.f, s2 = 0.f;
                unsigned long long* o8 = (unsigned long long*)(Hb + (size_t)row * DM) + lane; unsigned long long* o82 = (unsigned long long*)(Hb + (size_t)row2 * DM) + lane;
#pragma unroll
                for (int j = 0; j < 4; ++j) { const f32x4 v = va[j]; s += (v[0] * v[0] + v[1] * v[1]) + (v[2] * v[2] + v[3] * v[3]);
                    o8[64 * j] = (unsigned long long)pk2(v[0], v[1]) | ((unsigned long long)pk2(v[2], v[3]) << 32);
                    const f32x4 w = vb[j]; s2 += (w[0] * w[0] + w[1] * w[1]) + (w[2] * w[2] + w[3] * w[3]);
                    if (two) o82[64 * j] = (unsigned long long)pk2(w[0], w[1]) | ((unsigned long long)pk2(w[2], w[3]) << 32); }
                s = wave_sum(s); s2 = wave_sum(s2);
                if (lane < 4) { ss[(size_t)row * 4 + lane] = lane == 0 ? s : 0.f; if (two) ss[(size_t)row2 * 4 + lane] = lane == 0 ? s2 : 0.f; }
            }
        } else if (p == NPH - 1) {
            for (int row = gw; row < M; row += NGW) {
                const unsigned long long* hr = (const unsigned long long*)(Hb + (size_t)row * DM) + lane; f32x4* orow = (f32x4*)(H + (size_t)row * DM) + lane; const f32x4* gr = (const f32x4*)final_g + lane;
                unsigned long long hv[4];
#pragma unroll
                for (int j = 0; j < 4; ++j) hv[j] = hr[64 * j];
                const f32x4 s0 = *(const f32x4*)(ss + (size_t)row * 4);
                const float tot = (s0[0] + s0[1]) + (s0[2] + s0[3]);
                const float rstd = __builtin_amdgcn_rsqf(tot * (1.0f / DM) + EPS);
#pragma unroll
                for (int j = 0; j < 4; ++j) { const unsigned lo = (unsigned)hv[j], hi2 = (unsigned)(hv[j] >> 32);
                    const f32x4 v = (f32x4){__uint_as_float(lo << 16), __uint_as_float(lo & 0xffff0000u), __uint_as_float(hi2 << 16), __uint_as_float(hi2 & 0xffff0000u)};
                    orow[64 * j] = v * rstd * gr[64 * j]; }
            }
        } else {
            const int l = (p - 1) / 3, kind = (p - 1) % 3; const bool isB = l & 1;
            if (kind == 0) {
                const bf16_t* W1t = (const bf16_t*)(ws + WS_W1T + l * W1T_STRIDE);
                if (!(MK_EN & 1)) {} else if (!isB) { pg8::Gemm g{Hb, W1t, M, IN_A, DM}; pg8::StaticOrder S; S.init(M, IN_A, G, bx);
                    pg8::EpiG1<2> E{Qb, Kb, Vb, Zb, ss, rope, KS};
                    pg8::gemm_phase<pg8::EpiG1<2>, pg8::StaticOrder, true, true>(ldsp + RING_OFF, g, S, E);
                } else { pg8::Gemm g{Hb, W1t, M, IN_B, DM}; pg8::StaticOrder S; S.init(M, IN_B, G, bx);
                    pg8::EpiG1<4> E{Qb, Kb, Vb, Zb, ss, rope, KS};
                    pg8::gemm_phase<pg8::EpiG1<4>, pg8::StaticOrder, true, true>(ldsp + RING_OFF, g, S, E); }
            } else if (kind == 1) {
                if (!isB) { if (MK_EN & 2)
                    for (int U = vcu; U < 2048; U += G) { const int vc = U & 255, i = U >> 8; const int bp = vc >> 2, qb = (vc & 3) * 8 + i;
                        attn_body::attn_unit<0, 8>(bp >> 3, (bp & 7) * 2, qb, Qb, Kb, Vb, Zb, Gb, sinks_a + (l >> 1) * NH, (char*)lds + RING_OFF); }
                } else { if (MK_EN & 4)
                    for (int U = vcu; U < 1024; U += G) { const int vc = U & 255, i = U >> 8; const int grp = vc >> 2, c4 = vc & 3;
                        const int x = c4 == 0 ? 5 : c4 == 1 ? 4 : c4 == 2 ? 6 : 7; const int qb = i == 0 ? c4 : i == 1 ? 15 - c4 : i == 2 ? x : 15 - x;
                        attn_body::attn_unit_moba2<8>(grp >> 3, grp & 7, qb, Qb, Kb, Vb, Zb, Gb, KS, (char*)lds + RING_OFF); }
                }
            } else {
                const bf16_t* W2t = (const bf16_t*)(ws + WS_W2T + l * W2T_STRIDE);
                if (MK_EN & 8) {
                pg8::Gemm g{Gb, W2t, M, DM, DM}; pg8::StaticOrder S; S.init(M, DM, G, bx);
                if (l == 0) { pg8::EpiG2<true, false> E{xin, H, Hb, ss, (LAS float*)(ldsp + RING_BYTES)}; pg8::gemm_phase<pg8::EpiG2<true, false>, pg8::StaticOrder, true, true>(ldsp + RING_OFF, g, S, E); }
                else { pg8::EpiG2<false, false> E{xin, H, Hb, ss, (LAS float*)(ldsp + RING_BYTES)}; pg8::gemm_phase<pg8::EpiG2<false, false>, pg8::StaticOrder, true, true>(ldsp + RING_OFF, g, S, E); } }
            }
        }
        if (pk + 1 < hi + (MK_DUP >= 0 ? 1 : 0)) { XcdBarrier b2 = bar; GAS unsigned* bg = (GAS unsigned*)bar.bar; asm volatile("" : "+s"(bg), "+s"(b2.x)); b2.bar = (unsigned*)bg; xcd_barrier(b2); }
    }
#undef xin
#undef norm_g
#undef w_in_a
#undef sinks_a
#undef w_in_b
#undef w_out
#undef final_g
#undef H
#undef rope
#undef ss
#undef KS
#undef Hb
#undef Qb
#undef Zb
#undef Gb
#undef Kb
#undef Vb
}

#ifndef MK_FAST_MASK
#define MK_FAST_MASK 0x3fff
#endif
#ifndef MK_ONE_LAUNCH
#define MK_ONE_LAUNCH 1
#endif
extern "C" void kernel_launch(void* const* d_in, const int* in_sizes, int n_in, void* d_out, int out_size, void* d_ws, size_t ws_size, hipStream_t stream) {
    static int grid = 0;
    if (grid == 0) {
        if (n_in != 7 || in_sizes[0] != M * DM || out_size != M * DM || ws_size < WS_END) { fprintf(stderr, "kernel_launch: unexpected shapes (n_in %d, in0 %d, out %d, ws %zu)\n", n_in, n_in > 0 ? in_sizes[0] : -1, out_size, ws_size); grid = -1; return; }
        int dev = 0, cus = 0, per_cu = 0;
        if (hipGetDevice(&dev) != hipSuccess || hipDeviceGetAttribute(&cus, hipDeviceAttributeMultiprocessorCount, dev) != hipSuccess) { grid = -1; return; }
        if (hipFuncSetAttribute((const void*)mk_fwd, hipFuncAttributeMaxDynamicSharedMemorySize, LDS_BYTES) != hipSuccess) { fprintf(stderr, "kernel_launch: hipFuncSetAttribute failed\n"); grid = -1; return; }
        if (hipOccupancyMaxActiveBlocksPerMultiprocessor(&per_cu, (const void*)mk_fwd, NWAVES * 64, LDS_BYTES) != hipSuccess || per_cu < 1) fprintf(stderr, "kernel_launch: occupancy query reports %d blocks per CU\n", per_cu);
        (void)hipGetLastError();
        grid = cus;
    }
    if (grid < 0) return;
    const float* x = (const float*)d_in[0]; const float* norm_g = (const float*)d_in[1]; const float* w_in_a = (const float*)d_in[2]; const float* sinks_a = (const float*)d_in[3];
    const float* w_in_b = (const float*)d_in[4]; const float* w_out = (const float*)d_in[5]; const float* final_g = (const float*)d_in[6];
    unsigned char* ws = (unsigned char*)d_ws; float* H = (float*)d_out;
    (void)hipMemsetAsync(ws + WS_CTL, 0, CTL_ZERO_BYTES, stream);
    Args a{};
    for (int i = 0; i < 7; ++i) a.in[i] = (const float*)d_in[i];
    a.out = H; a.ws = ws;
    if (MK_ONE_LAUNCH && MK_FAST_MASK == 0x3fff) { a.ph_lo = 0; a.ph_hi = NPH; hipLaunchKernelGGL(mk_fwd, dim3(grid), dim3(NWAVES * 64), LDS_BYTES, stream, a); return; }
    float2* rope = (float2*)(ws + WS_ROPE); float* ss = (float*)(ws + WS_SS); float* KS = (float*)(ws + WS_KS);
    bf16_t* Hb = (bf16_t*)(ws + WS_HB); bf16_t* Qb = (bf16_t*)(ws + WS_Q); bf16_t* Zb = (bf16_t*)(ws + WS_Z); bf16_t* Gb = (bf16_t*)(ws + WS_G); bf16_t* Kb = (bf16_t*)(ws + WS_K); bf16_t* Vb = (bf16_t*)(ws + WS_V);
    for (int p = 0; p < NPH; ++p) {
        if ((MK_FAST_MASK >> p) & 1) { a.ph_lo = p; a.ph_hi = p + 1; hipLaunchKernelGGL(mk_fwd, dim3(grid), dim3(NWAVES * 64), LDS_BYTES, stream, a); continue; }
        if (p == 0) {
            k_prep_rope<<<SEQ * 32 / 256, 256, 0, stream>>>(rope);
            for (int l = 0; l < DEPTH; ++l) { const bool isB = l & 1; const int IN = isB ? IN_B : IN_A, KVW = isB ? 256 : 128;
                const float* Win = (isB ? w_in_b : w_in_a) + (size_t)(l >> 1) * DM * IN;
                k_prep_w1<<<(unsigned)(((size_t)IN * DM + 255) / 256), 256, 0, stream>>>(Win, norm_g + l * DM, (bf16_t*)(ws + WS_W1T + l * W1T_STRIDE), IN, KVW);
                k_prep_w2<<<DM * DM / 256, 256, 0, stream>>>(w_out + (size_t)l * DM * DM, (bf16_t*)(ws + WS_W2T + l * W2T_STRIDE)); }
            k_prep_x<<<M / 4, 256, 0, stream>>>(x, Hb, ss);
        } else if (p == NPH - 1) { k_final<<<M / 4, 256, 0, stream>>>(H, final_g);
        } else { const int l = (p - 1) / 3, kind = (p - 1) % 3; const bool isB = l & 1;
            const bf16_t* W1t = (const bf16_t*)(ws + WS_W1T + l * W1T_STRIDE); const bf16_t* W2t = (const bf16_t*)(ws + WS_W2T + l * W2T_STRIDE);
            if (kind == 0) { if (!isB) k_gemm1_naive<2><<<(M / 16) * (IN_A / 64) / 4, 256, 0, stream>>>(Hb, W1t, ss, rope, Qb, Kb, Vb, Zb);
                             else { k_gemm1_naive<4><<<(M / 16) * (IN_B / 64) / 4, 256, 0, stream>>>(Hb, W1t, ss, rope, Qb, Kb, Vb, Zb); k_ksum_naive<<<BATCH * NBLK, 256, 0, stream>>>(Kb, KS); } }
            else if (kind == 1) { if (!isB) k_attn_swa_naive<<<M * NH / 4, 256, 0, stream>>>(Qb, Kb, Vb, Zb, sinks_a + (l >> 1) * NH, Gb); else k_attn_moba_naive<<<M * NH / 4, 256, 0, stream>>>(Qb, Kb, Vb, Zb, KS, Gb); }
            else k_gemm2_naive<<<(M / 16) * 16 / 4, 256, 0, stream>>>(Gb, W2t, l == 0 ? x : H, H, Hb, ss);
        }
    }
}
```

```cpp
#include <hip/hip_runtime.h>
#include <cstdint>
#include <cstdio>

typedef unsigned short bf16_t;
typedef short bf16x8 __attribute__((ext_vector_type(8)));
typedef float f32x4 __attribute__((ext_vector_type(4)));
typedef unsigned u32x4 __attribute__((ext_vector_type(4)));

constexpr int BATCH = 8, SEQ = 4096, DM = 1024, DEPTH = 4, HD = 64, NH = 16;
constexpr int M = BATCH * SEQ;
constexpr int IN_A = 2304, IN_B = 2560;
constexpr float EPS = 1e-5f;

constexpr size_t MiB = 1u << 20;
constexpr size_t WS_CTL = 0, WS_ROPE = 1 * MiB, WS_W1T = 2 * MiB, WS_W2T = 22 * MiB, WS_SS = 30 * MiB, WS_KS = 32 * MiB;
constexpr size_t WS_HB = 64 * MiB, WS_Q = 128 * MiB, WS_Z = 192 * MiB, WS_G = 256 * MiB, WS_K = 320 * MiB, WS_V = 336 * MiB, WS_END = 352 * MiB;
constexpr size_t W1T_STRIDE = 5 * MiB, W2T_STRIDE = 2 * MiB;

__host__ __device__ __forceinline__ int dmap(int cc) { return (((cc >> 2) & 1) << 5) | ((cc >> 5) << 4) | (((cc >> 3) & 3) << 2) | (cc & 3); }
__device__ __forceinline__ float wave_sum(float v) {
#pragma unroll
    for (int o = 1; o < 64; o <<= 1) v += __shfl_xor(v, o);
    return v;
}

namespace pg8 {
#define PG8_LAS __attribute__((address_space(3)))
typedef unsigned short bf16_t;
typedef short bf16x8 __attribute__((ext_vector_type(8)));
typedef float f32x4 __attribute__((ext_vector_type(4)));
typedef unsigned u32x4 __attribute__((ext_vector_type(4)));
constexpr int BM = 256, BK = 64, HALF = 128, HTB = HALF * BK * 2  , STAGE_BYTES = 8 * HTB, NXCD = 8, WGM = 8;

__host__ __device__ __forceinline__ int lds_byte(int r, int c) { const int st = (r >> 4) * 2 + (c >> 5), rr = r & 15, cc = c & 31, ob = rr * 64 + cc * 2; return st * 1024 + (ob ^ (((ob >> 9) & 1) << 5)); }
__host__ __device__ __forceinline__ void stage_rc(int b, int& R, int& C) { const int st = b / 1024, sb = b % 1024, swz = sb ^ (((sb >> 9) & 1) << 5); R = (st >> 1) * 16 + swz / 64; C = (st & 1) * 32 + (swz % 64) / 2; }
__host__ __device__ __forceinline__ int perm32(int rho) { const int n = rho >> 4, i = rho & 15; return 8 * (i >> 2) + 4 * n + (i & 3); }

struct Unit { int pm, pn; };
struct Gemm { const bf16_t* A; const bf16_t* Bt; int M, N, K; };

struct StaticOrder {
    int nM, nN, nwg, G, c;
    __host__ __device__ void init(int M, int N, int G_, int c_) { nM = M / BM; nN = N / BM; nwg = nM * nN; G = G_; c = c_; }
    __host__ __device__ bool next(int i, Unit& u) const {
        const long L = (long)i * G + c; if (L >= nwg) return false;
        int wgid = (int)L; { const int q = nwg / NXCD, r = nwg % NXCD, xcd = wgid % NXCD, off = wgid / NXCD; wgid = (xcd < r ? xcd * (q + 1) : r * (q + 1) + (xcd - r) * q) + off; }
        const int nig = WGM * nN, gid = wgid / nig, fm = gid * WGM, gsz = (nM - fm) < WGM ? (nM - fm) : WGM;
        u.pm = fm + ((wgid % nig) % gsz); u.pn = (wgid % nig) / gsz; return true;
    }
    __device__ __forceinline__ void a_ready(const Unit&) const {}
    __device__ __forceinline__ void done(const Unit&) const {}
};

__device__ __forceinline__ unsigned cvt_pk_bf16(float lo, float hi) { unsigned r; asm volatile("v_cvt_pk_bf16_f32 %0, %1, %2" : "=v"(r) : "v"(lo), "v"(hi)); return r; }
typedef unsigned u32x2 __attribute__((ext_vector_type(2)));

template <int KVH> struct EpiG1 {
    static constexpr bool PERM = true, AFTER_DRAIN = false;
    bf16_t *Q, *K, *V, *Z; const float* ss; const float* rope; float* KS;
    __device__ __forceinline__ void rstd8(float (&rs)[2][4], int row0) const {
        f32x4 sv[2][4];
#pragma unroll
        for (int ai = 0; ai < 2; ++ai)
#pragma unroll
            for (int m = 0; m < 4; ++m) sv[ai][m] = *(const f32x4*)(ss + (size_t)(row0 + ai * HALF + m * 16) * 4);
#pragma unroll
        for (int ai = 0; ai < 2; ++ai)
#pragma unroll
            for (int m = 0; m < 4; ++m) rs[ai][m] = __builtin_amdgcn_rsqf(((sv[ai][m][0] + sv[ai][m][1]) + (sv[ai][m][2] + sv[ai][m][3])) * (1.0f / 1024.0f) + 1e-5f);
    }
    __device__ __forceinline__ void rope4(f32x4 (&cc)[4], f32x4 (&sn)[4], int rowa, int wcl, int fq) const {
        f32x4 t0[4], t1[4];
#pragma unroll
        for (int m = 0; m < 4; ++m) { const int pos = (rowa + m * 16) & 4095; const f32x4* rp = (const f32x4*)(rope + ((size_t)pos * 32 + 16 * wcl + 4 * fq) * 2); t0[m] = rp[0]; t1[m] = rp[1]; }
#pragma unroll
        for (int m = 0; m < 4; ++m) { cc[m] = (f32x4){t0[m][0], t0[m][2], t1[m][0], t1[m][2]}; sn[m] = (f32x4){t0[m][1], t0[m][3], t1[m][1], t1[m][3]}; }
    }
    __device__ __forceinline__ void operator()(const f32x4 (&acc)[2][2][4][2], const Unit& u, int wr, int wc, int fr, int fq) const {
        constexpr int KVW = KVH * 64; constexpr float C2 = 0.125f * 1.4426950408889634f;
        const int pn = u.pn, wcl = wc & 1, hp = wc >> 1;
        const int row0 = u.pm * BM + wr * 64 + fr;
        if (pn < 4 || (pn == 4 && KVH == 4)) {
            const bool isq = pn < 4;
            f32x4 ks[2][2];
#pragma unroll
            for (int bj = 0; bj < 2; ++bj) { ks[bj][0] = (f32x4){0.f, 0.f, 0.f, 0.f}; ks[bj][1] = (f32x4){0.f, 0.f, 0.f, 0.f}; }
            float rsv[2][4]; rstd8(rsv, row0);
#pragma unroll
            for (int ai = 0; ai < 2; ++ai) { f32x4 ccv[4], snv[4]; rope4(ccv, snv, row0 + ai * HALF, wcl, fq);
#pragma unroll
                for (int m = 0; m < 4; ++m) {
                    const int row = row0 + ai * HALF + m * 16;
                    const float rs = rsv[ai][m], sc = isq ? rs * C2 : rs;
                    const f32x4 cc = ccv[m], sn = snv[m];
#pragma unroll
                    for (int bj = 0; bj < 2; ++bj) {
                        const f32x4 x1 = acc[ai][bj][m][0] * sc, x2 = acc[ai][bj][m][1] * sc;
                        const f32x4 o1 = x1 * cc - x2 * sn, o2 = x2 * cc + x1 * sn;
                        bf16_t* dst = isq ? Q + (size_t)row * 1024 + (4 * pn + 2 * bj + hp) * 64 + 16 * wcl + 4 * fq : K + (size_t)row * KVW + (2 * bj + hp) * 64 + 16 * wcl + 4 * fq;
                        u32x2 w1, w2; w1.x = cvt_pk_bf16(o1[0], o1[1]); w1.y = cvt_pk_bf16(o1[2], o1[3]); w2.x = cvt_pk_bf16(o2[0], o2[1]); w2.y = cvt_pk_bf16(o2[2], o2[3]);
                        *(u32x2*)dst = w1; *(u32x2*)(dst + 32) = w2;
                        if (!isq) { ks[bj][0] += o1; ks[bj][1] += o2; }
                    }
                } }
            if (!isq) {
#pragma unroll
                for (int bj = 0; bj < 2; ++bj)
#pragma unroll
                    for (int n = 0; n < 2; ++n) {
                        f32x4 v = ks[bj][n];
#pragma unroll
                        for (int j = 0; j < 4; ++j) { float s = v[j]; s += __shfl_xor(s, 1); s += __shfl_xor(s, 2); s += __shfl_xor(s, 4); s += __shfl_xor(s, 8); v[j] = s; }
                        if (fr == 0) *(f32x4*)(KS + ((size_t)(u.pm * 2 + wr)) * 256 + (2 * bj + hp) * 64 + 32 * n + 16 * wcl + 4 * fq) = v;
                    }
            }
        } else if (pn == 4) {
            float rsv[2][4]; rstd8(rsv, row0);
#pragma unroll
            for (int ai = 0; ai < 2; ++ai) { f32x4 ccv[4], snv[4]; rope4(ccv, snv, row0 + ai * HALF, wcl, fq);
#pragma unroll
                for (int m = 0; m < 4; ++m) {
                    const int row = row0 + ai * HALF + m * 16;
                    const float rs = rsv[ai][m];
                    const f32x4 cc = ccv[m], sn = snv[m];
                    { const f32x4 x1 = acc[ai][0][m][0] * rs, x2 = acc[ai][0][m][1] * rs;
                      const f32x4 o1 = x1 * cc - x2 * sn, o2 = x2 * cc + x1 * sn;
                      bf16_t* dst = K + (size_t)row * KVW + hp * 64 + 16 * wcl + 4 * fq;
                      u32x2 w1, w2; w1.x = cvt_pk_bf16(o1[0], o1[1]); w1.y = cvt_pk_bf16(o1[2], o1[3]); w2.x = cvt_pk_bf16(o2[0], o2[1]); w2.y = cvt_pk_bf16(o2[2], o2[3]);
                      *(u32x2*)dst = w1; *(u32x2*)(dst + 32) = w2; }
                    { const f32x4 v0 = acc[ai][1][m][0] * rs, v1 = acc[ai][1][m][1] * rs;
                      u32x4 w; w.x = cvt_pk_bf16(v0[0], v0[1]); w.y = cvt_pk_bf16(v0[2], v0[3]); w.z = cvt_pk_bf16(v1[0], v1[1]); w.w = cvt_pk_bf16(v1[2], v1[3]);
                      *(u32x4*)(V + (size_t)row * KVW + 32 * wc + 8 * fq) = w; }
                } }
        } else {
            const bool isv = (KVH == 4 && pn == 5);
            const int zt = pn - (KVH == 4 ? 6 : 5);
            float rsv[2][4]; rstd8(rsv, row0);
#pragma unroll
            for (int ai = 0; ai < 2; ++ai)
#pragma unroll
                for (int m = 0; m < 4; ++m) {
                    const int row = row0 + ai * HALF + m * 16;
                    const float rs = rsv[ai][m];
                    bf16_t* dst = isv ? V + (size_t)row * KVW + 32 * wc + 8 * fq : Z + (size_t)row * 1024 + zt * 256 + 32 * wc + 8 * fq;
#pragma unroll
                    for (int bj = 0; bj < 2; ++bj) {
                        const f32x4 v0 = acc[ai][bj][m][0] * rs, v1 = acc[ai][bj][m][1] * rs;
                        u32x4 w; w.x = cvt_pk_bf16(v0[0], v0[1]); w.y = cvt_pk_bf16(v0[2], v0[3]); w.z = cvt_pk_bf16(v1[0], v1[1]); w.w = cvt_pk_bf16(v1[2], v1[3]);
                        *(u32x4*)(dst + bj * HALF) = w;
                    }
                }
        }
    }
};
template <bool IN_F32, bool OUT_F32> struct EpiG2 {
    static constexpr bool PERM = true, AFTER_DRAIN = false;
    const float* xin; float* H; bf16_t* Hb; float* ss; PG8_LAS float* red;
    __device__ __forceinline__ void operator()(const f32x4 (&acc)[2][2][4][2], const Unit& u, int wr, int wc, int fr, int fq) const {
        const int row0 = u.pm * BM + wr * 64 + fr, col0 = u.pn * BM + 32 * wc + 8 * fq;
#pragma unroll
        for (int ai = 0; ai < 2; ++ai) {
            f32x4 r0[4][2], r1[4][2]; u32x4 rb[4][2];
#pragma unroll
            for (int m = 0; m < 4; ++m)
#pragma unroll
                for (int bj = 0; bj < 2; ++bj) { const size_t off = (size_t)(row0 + ai * HALF + m * 16) * 1024 + col0 + bj * HALF;
                    if (IN_F32) { r0[m][bj] = *(const f32x4*)(xin + off); r1[m][bj] = *(const f32x4*)(xin + off + 4); } else rb[m][bj] = *(const u32x4*)(Hb + off); }
#pragma unroll
            for (int m = 0; m < 4; ++m) {
                const int row = row0 + ai * HALF + m * 16; float s = 0.f;
#pragma unroll
                for (int bj = 0; bj < 2; ++bj) {
                    const size_t off = (size_t)row * 1024 + col0 + bj * HALF;
                    f32x4 h0, h1;
                    if (IN_F32) { h0 = r0[m][bj]; h1 = r1[m][bj]; }
                    else { const u32x4 w = rb[m][bj]; h0 = (f32x4){__uint_as_float(w.x << 16), __uint_as_float(w.x & 0xffff0000u), __uint_as_float(w.y << 16), __uint_as_float(w.y & 0xffff0000u)};
                           h1 = (f32x4){__uint_as_float(w.z << 16), __uint_as_float(w.z & 0xffff0000u), __uint_as_float(w.w << 16), __uint_as_float(w.w & 0xffff0000u)}; }
                    const f32x4 v0 = h0 + acc[ai][bj][m][0], v1 = h1 + acc[ai][bj][m][1];
                    s += ((v0[0] * v0[0] + v0[1] * v0[1]) + (v0[2] * v0[2] + v0[3] * v0[3])) + ((v1[0] * v1[0] + v1[1] * v1[1]) + (v1[2] * v1[2] + v1[3] * v1[3]));
                    if (OUT_F32) { *(f32x4*)(H + off) = v0; *(f32x4*)(H + off + 4) = v1; }
                    else { u32x4 w; w.x = cvt_pk_bf16(v0[0], v0[1]); w.y = cvt_pk_bf16(v0[2], v0[3]); w.z = cvt_pk_bf16(v1[0], v1[1]); w.w = cvt_pk_bf16(v1[2], v1[3]); *(u32x4*)(Hb + off) = w; }
                }
                s += __shfl_xor(s, 16); s += __shfl_xor(s, 32);
                if (fq == 0) red[(ai * HALF + wr * 64 + m * 16 + fr) * 4 + wc] = s;
            }
        }
        asm volatile("s_waitcnt lgkmcnt(0)\n\ts_barrier" ::: "memory");
        const int tid = (wr * 4 + wc) * 64 + fq * 16 + fr;
        if (tid < 256) { const f32x4 v = *(const PG8_LAS f32x4*)(red + tid * 4); ss[(size_t)(u.pm * BM + tid) * 4 + u.pn] = (v[0] + v[1]) + (v[2] + v[3]); }
    }
};
template <class Epi, class Sched, bool ALIGN_EPI = false, bool SP2 = false>
__device__ __forceinline__ void gemm_phase(PG8_LAS unsigned char* lds, const Gemm g, const Sched& S, const Epi& E) {
    int tid_ = threadIdx.x; asm volatile("" : "+v"(tid_));
    const int tid = tid_, wid = __builtin_amdgcn_readfirstlane(tid >> 6), lane = tid & 63, wr = wid >> 2, wc = wid & 3, fr = lane & 15, fq = lane >> 4;
    const int K = g.K, nt = K / BK;
    unsigned voffA[2], voffB[2];
#pragma unroll
    for (int i = 0; i < 2; ++i) { int R, C; stage_rc(tid * 16 + i * 8192, R, C); const int Rb = Epi::PERM ? ((R & ~31) + perm32(R & 31)) : R;
        voffA[i] = (unsigned)(R * K + C) * 2u; voffB[i] = (unsigned)(Rb * K + C) * 2u; }
    const size_t kstep = (size_t)(BK * 2);
    const size_t hstep = (size_t)HALF * K * 2;
    const size_t tstep = 2 * hstep;
    const unsigned ldsw = (unsigned)wid * 1024u;
    const int aoff = lds_byte(wr * 64 + fr, fq * 8), boff = lds_byte(wc * 32 + fr, fq * 8);
#define PG8_SA(b, h) (((b) * 2 + (h)) * HTB)
#define PG8_SB(b, h) ((4 + (b) * 2 + (h)) * HTB)
#define PG8_STAGE(bufoff, gbase, voff) do { _Pragma("unroll") for (int _i = 0; _i < 2; ++_i) \
        __builtin_amdgcn_global_load_lds((const unsigned*)((const char*)(gbase) + (voff)[_i]), (PG8_LAS unsigned*)(lds + (bufoff) + ldsw + _i * 8192), 16, 0, 0); } while (0)
#define PG8_LDA(dst, b, h) do { _Pragma("unroll") for (int m = 0; m < 4; ++m) _Pragma("unroll") for (int k = 0; k < 2; ++k) dst[m][k] = *(const PG8_LAS bf16x8*)(lds + PG8_SA(b, h) + aoff + m * 2048 + k * 1024); } while (0)
#define PG8_LDB(dst, b, h) do { _Pragma("unroll") for (int n = 0; n < 2; ++n) _Pragma("unroll") for (int k = 0; k < 2; ++k) dst[n][k] = *(const PG8_LAS bf16x8*)(lds + PG8_SB(b, h) + boff + n * 2048 + k * 1024); } while (0)
#define PG8_MMA(ai, bj, At, Bt) do { __builtin_amdgcn_s_setprio(1); _Pragma("unroll") for (int m = 0; m < 4; ++m) _Pragma("unroll") for (int n = 0; n < 2; ++n) _Pragma("unroll") for (int k = 0; k < 2; ++k) \
        acc[ai][bj][m][n] = __builtin_amdgcn_mfma_f32_16x16x32_bf16(Bt[n][k], At[m][k], acc[ai][bj][m][n], 0, 0, 0); __builtin_amdgcn_s_setprio(0); } while (0)
#define PG8_WAIT_V(n) asm volatile("s_waitcnt vmcnt(" #n ")" ::: "memory")
#define PG8_WAIT_L(n) asm volatile("s_waitcnt lgkmcnt(" #n ")" ::: "memory")
#define PG8_BAR __builtin_amdgcn_s_barrier()
#define PG8_SCHED __builtin_amdgcn_sched_barrier(0)
    Unit cur, nxt; int ui = 0;
    if (!S.next(0, cur)) return;
    f32x4 acc[2][2][4][2];
#pragma unroll
    for (int a = 0; a < 2; ++a)
#pragma unroll
        for (int b = 0; b < 2; ++b)
#pragma unroll
            for (int m = 0; m < 4; ++m)
#pragma unroll
                for (int n = 0; n < 2; ++n) acc[a][b][m][n] = (f32x4){0.f, 0.f, 0.f, 0.f};
    bf16x8 At[4][2], B0[2][2], B1[2][2];
    const char* cA = (const char*)g.A + (size_t)cur.pm * tstep; const char* cB = (const char*)g.Bt + (size_t)cur.pn * tstep;
    S.a_ready(cur);
    if constexpr (SP2) {
        PG8_STAGE(PG8_SB(0, 0), cB, voffB); PG8_STAGE(PG8_SB(0, 1), cB + hstep, voffB); PG8_STAGE(PG8_SA(0, 0), cA, voffA); PG8_STAGE(PG8_SA(0, 1), cA + hstep, voffA);
        if (wr == 1) PG8_BAR;
        PG8_WAIT_V(2); PG8_BAR;
        PG8_STAGE(PG8_SB(1, 0), cB + kstep, voffB); PG8_STAGE(PG8_SA(1, 0), cA + kstep, voffA); PG8_STAGE(PG8_SB(1, 1), cB + hstep + kstep, voffB);
        PG8_WAIT_V(6); PG8_BAR;
    } else {
        PG8_STAGE(PG8_SB(0, 0), cB, voffB); PG8_STAGE(PG8_SA(0, 0), cA, voffA); PG8_STAGE(PG8_SB(0, 1), cB + hstep, voffB); PG8_STAGE(PG8_SA(0, 1), cA + hstep, voffA);
        if (wr == 1) PG8_BAR;
        PG8_WAIT_V(4); PG8_BAR;
        PG8_STAGE(PG8_SB(1, 0), cB + kstep, voffB); PG8_STAGE(PG8_SA(1, 0), cA + kstep, voffA); PG8_STAGE(PG8_SB(1, 1), cB + hstep + kstep, voffB);
        PG8_WAIT_V(6); PG8_BAR;
    }
    for (;;) {
        const bool has_next = S.next(ui + 1, nxt);
        const char* nA = has_next ? (const char*)g.A + (size_t)nxt.pm * tstep : cA; const char* nB = has_next ? (const char*)g.Bt + (size_t)nxt.pn * tstep : cB;
        for (int t = 0; t < nt; t += 2) {
            const bool last = (t == nt - 2);
            const char* a1 = cA + (size_t)(t + 1) * kstep;
            const char* a2 = last ? nA : cA + (size_t)(t + 2) * kstep; const char* b2 = last ? nB : cB + (size_t)(t + 2) * kstep;
            const char* a3 = a2 + kstep; const char* b3 = b2 + kstep;
            if (last && has_next) S.a_ready(nxt);
            if constexpr (SP2) {
            PG8_LDB(B0, 0, 0); PG8_LDB(B1, 0, 1); PG8_SCHED; PG8_LDA(At, 0, 0); PG8_STAGE(PG8_SA(1, 1), a1 + hstep, voffA);
            PG8_WAIT_V(8); PG8_WAIT_L(0); PG8_BAR; PG8_MMA(0, 0, At, B0); PG8_MMA(0, 1, At, B1); PG8_BAR; PG8_SCHED;
            PG8_LDA(At, 0, 1); PG8_STAGE(PG8_SB(0, 0), b2, voffB); PG8_STAGE(PG8_SB(0, 1), b2 + hstep, voffB); PG8_STAGE(PG8_SA(0, 0), a2, voffA);
            PG8_WAIT_V(8); PG8_WAIT_L(0); PG8_BAR; PG8_MMA(1, 0, At, B0); PG8_MMA(1, 1, At, B1); PG8_BAR; PG8_SCHED;
            PG8_LDB(B0, 1, 0); PG8_LDB(B1, 1, 1); PG8_SCHED; PG8_LDA(At, 1, 0); PG8_STAGE(PG8_SA(0, 1), a2 + hstep, voffA);
            PG8_WAIT_V(8); PG8_WAIT_L(0); PG8_BAR; PG8_MMA(0, 0, At, B0); PG8_MMA(0, 1, At, B1); PG8_BAR; PG8_SCHED;
            PG8_LDA(At, 1, 1); PG8_STAGE(PG8_SB(1, 0), b3, voffB); PG8_STAGE(PG8_SB(1, 1), b3 + hstep, voffB); PG8_STAGE(PG8_SA(1, 0), a3, voffA);
            PG8_WAIT_V(8); PG8_WAIT_L(0); PG8_BAR; PG8_MMA(1, 0, At, B0); PG8_MMA(1, 1, At, B1); PG8_BAR; PG8_SCHED;
            } else {
            PG8_LDB(B0, 0, 0); PG8_SCHED; PG8_LDA(At, 0, 0); PG8_STAGE(PG8_SA(1, 1), a1 + hstep, voffA);
            PG8_WAIT_L(8); PG8_BAR; PG8_WAIT_L(0); PG8_MMA(0, 0, At, B0); PG8_BAR; PG8_SCHED;
            PG8_LDB(B1, 0, 1); PG8_STAGE(PG8_SB(0, 0), b2, voffB);
            PG8_BAR; PG8_WAIT_L(0); PG8_MMA(0, 1, At, B1); PG8_BAR;
            PG8_LDA(At, 0, 1); PG8_STAGE(PG8_SA(0, 0), a2, voffA);
            PG8_BAR; PG8_WAIT_L(0); PG8_MMA(1, 0, At, B0); PG8_BAR; PG8_SCHED;
            PG8_STAGE(PG8_SB(0, 1), b2 + hstep, voffB);
            PG8_WAIT_V(6); PG8_BAR; PG8_MMA(1, 1, At, B1); PG8_BAR;
            PG8_LDB(B0, 1, 0); PG8_SCHED; PG8_LDA(At, 1, 0); PG8_STAGE(PG8_SA(0, 1), a2 + hstep, voffA);
            PG8_WAIT_L(8); PG8_BAR; PG8_WAIT_L(0); PG8_MMA(0, 0, At, B0); PG8_BAR; PG8_SCHED;
            PG8_LDB(B1, 1, 1); PG8_STAGE(PG8_SB(1, 0), b3, voffB);
            PG8_BAR; PG8_WAIT_L(0); PG8_MMA(0, 1, At, B1); PG8_BAR;
            PG8_LDA(At, 1, 1); PG8_STAGE(PG8_SA(1, 0), a3, voffA);
            PG8_BAR; PG8_WAIT_L(0); PG8_MMA(1, 0, At, B0); PG8_BAR; PG8_SCHED;
            PG8_STAGE(PG8_SB(1, 1), b3 + hstep, voffB);
            PG8_WAIT_V(6); PG8_BAR; PG8_MMA(1, 1, At, B1); PG8_BAR;
            }
        }
        if constexpr (ALIGN_EPI) { if (wr == 0) PG8_BAR; }
        if constexpr (!Epi::AFTER_DRAIN) { E(acc, cur, wr, wc, fr, fq); S.done(cur); }
        if (!has_next) break;
#pragma unroll
        for (int a = 0; a < 2; ++a)
#pragma unroll
            for (int b = 0; b < 2; ++b)
#pragma unroll
                for (int m = 0; m < 4; ++m)
#pragma unroll
                    for (int n = 0; n < 2; ++n) acc[a][b][m][n] = (f32x4){0.f, 0.f, 0.f, 0.f};
        cur = nxt; cA = nA; cB = nB; ++ui;
        if constexpr (ALIGN_EPI) { if (wr == 1) PG8_BAR; }
    }
    PG8_WAIT_V(0);
    if constexpr (!ALIGN_EPI) { if (wr == 0) PG8_BAR; }
    PG8_BAR;
    if constexpr (Epi::AFTER_DRAIN) { E.fused(acc, cur, wr, wc, fr, fq, lds, wid, lane); S.done(cur); }
#undef PG8_SA
#undef PG8_SB
#undef PG8_STAGE
#undef PG8_LDA
#undef PG8_LDB
#undef PG8_MMA
#undef PG8_WAIT_V
#undef PG8_WAIT_L
#undef PG8_BAR
#undef PG8_SCHED
}
}

namespace attn_body {
using bf16=unsigned short;
using bf16x8=__attribute__((ext_vector_type(8)))short;
using s16x4=__attribute__((ext_vector_type(4)))short;
using f32x16=__attribute__((ext_vector_type(16)))float;
using u32x4=__attribute__((ext_vector_type(4)))unsigned;
constexpr int ASEQ=4096,D=64,ADM=1024;
constexpr int NW=8,QBLK=32,QB=QBLK*NW,KVBLK=64;
__device__ __forceinline__ int crow(int r,int hi){return (r&3)+8*(r>>2)+4*hi;}
#define SBAR() __builtin_amdgcn_sched_barrier(0)
__device__ __forceinline__ void cmask(f32x16&p0,f32x16&p1,int jb,int qrel,int hi){
  const float NEG=-INFINITY; int kb=qrel-(64*jb+4*hi); asm volatile("":"+v"(kb));
  #pragma unroll
  for(int r=0;r<16;++r){const int c=(r&3)+8*(r>>2); if(c>kb)p0[r]=NEG; if(c+32>kb)p1[r]=NEG;}
}
__device__ __forceinline__ void wmask(f32x16&p0,f32x16&p1,int delta,int hi){
  const float NEG=-INFINITY; int d0=delta-4*hi; asm volatile("":"+v"(d0));
  #pragma unroll
  for(int r=0;r<16;++r){const int dd=d0-((r&3)+8*(r>>2)); if((unsigned)dd>=128u)p0[r]=NEG; if((unsigned)(dd-32)>=128u)p1[r]=NEG;}
}

constexpr int NSLOT=3, SLOTB=8192;
constexpr int LDS_K=0, LDS_V=NSLOT*SLOTB, LDS_WS=2*NSLOT*SLOTB, LDS_OST=LDS_WS+NW*64*4, LDS_KM=LDS_OST+NW*8192, LDS_BYTES=LDS_KM+4096;
__device__ __forceinline__ void glds16(const void*sbase,unsigned voff,unsigned lds_dst){unsigned keep;
  asm volatile("s_nop 4\n\ts_mov_b32 %0, m0\n\ts_mov_b32 m0, %2\n\ts_nop 0\n\tglobal_load_lds_dwordx4 %1, %3\n\ts_mov_b32 m0, %0":"=&s"(keep):"v"(voff),"s"(lds_dst),"s"(sbase):"memory");}
__device__ __forceinline__ float max3f(float a,float b,float c){float r;asm("v_max3_f32 %0, %1, %2, %3":"=v"(r):"v"(a),"v"(b),"v"(c));return r;}
__device__ __forceinline__ float max2f(float a,float b){float r;asm("v_max_f32_e32 %0, %1, %2":"=v"(r):"v"(a),"v"(b));return r;}
__device__ __forceinline__ float fadd_s(float a,float b){float r;asm("v_add_f32_e32 %0, %1, %2":"=v"(r):"v"(a),"v"(b));return r;}
__device__ __forceinline__ float fsub_s(float a,float b){float r;asm("v_sub_f32_e32 %0, %1, %2":"=v"(r):"v"(a),"v"(b));return r;}
typedef float f32x2_t __attribute__((ext_vector_type(2))); typedef __bf16 bf16x2_t __attribute__((ext_vector_type(2)));
__device__ __forceinline__ unsigned cvtpk_s(float lo,float hi){f32x2_t v={lo,hi};bf16x2_t b=__builtin_convertvector(v,bf16x2_t);return __builtin_bit_cast(unsigned,b);}
#define WAIT_BAR(N) asm volatile("s_waitcnt vmcnt(" #N ") lgkmcnt(0)\n\ts_barrier":::"memory")

__device__ __forceinline__ void qkt(f32x16&p0,f32x16&p1,const char*Kslot,const bf16x8*qr,const f32x16&negm,int r32,int hi){
  const char*kb=Kslot+hi*1024+r32*16;
  #pragma unroll
  for(int d0=0;d0<4;++d0){
    const bf16x8 b0=*reinterpret_cast<const bf16x8*>(kb+d0*2048);
    const bf16x8 b1=*reinterpret_cast<const bf16x8*>(kb+d0*2048+512);
    if(d0==0){p0=__builtin_amdgcn_mfma_f32_32x32x16_bf16(b0,qr[0],negm,0,0,0);p1=__builtin_amdgcn_mfma_f32_32x32x16_bf16(b1,qr[0],negm,0,0,0);}
    else{p0=__builtin_amdgcn_mfma_f32_32x32x16_bf16(b0,qr[d0],p0,0,0,0);p1=__builtin_amdgcn_mfma_f32_32x32x16_bf16(b1,qr[d0],p1,0,0,0);}}
}
typedef __attribute__((address_space(3))) const char* lds_cptr;
typedef short v4i16_t __attribute__((ext_vector_type(4)));
__device__ __forceinline__ void kload8(bf16x8*kf,lds_cptr kp){
  kf[0]=*(const __attribute__((address_space(3))) bf16x8*)(kp);      kf[1]=*(const __attribute__((address_space(3))) bf16x8*)(kp+512);
  kf[2]=*(const __attribute__((address_space(3))) bf16x8*)(kp+2048); kf[3]=*(const __attribute__((address_space(3))) bf16x8*)(kp+2560);
  kf[4]=*(const __attribute__((address_space(3))) bf16x8*)(kp+4096); kf[5]=*(const __attribute__((address_space(3))) bf16x8*)(kp+4608);
  kf[6]=*(const __attribute__((address_space(3))) bf16x8*)(kp+6144); kf[7]=*(const __attribute__((address_space(3))) bf16x8*)(kp+6656);
}
__device__ __forceinline__ void kload2(bf16x8*kf,lds_cptr kp,int j){ kf[2*j]=*(const __attribute__((address_space(3))) bf16x8*)(kp+j*2048); kf[2*j+1]=*(const __attribute__((address_space(3))) bf16x8*)(kp+j*2048+512); }
__device__ __forceinline__ s16x4 vtr(lds_cptr p){ return __builtin_bit_cast(s16x4,__builtin_amdgcn_ds_read_tr16_b64_v4i16((__attribute__((address_space(3))) v4i16_t*)p)); }
__device__ __forceinline__ float rowmax(const f32x16&p0,const f32x16&p1){
  float a=max3f(p0[0],p0[1],p1[0]),b=max3f(p0[2],p0[3],p1[1]);a=max3f(a,p1[2],p1[3]);
  #pragma unroll
  for(int r=4;r<16;r+=4){a=max3f(a,p0[r],p0[r+1]);b=max3f(b,p0[r+2],p0[r+3]);a=max3f(a,p1[r],p1[r+1]);b=max3f(b,p1[r+2],p1[r+3]);}
  const float m=max2f(a,b);
  auto rr=__builtin_amdgcn_permlane32_swap(__float_as_uint(m),__float_as_uint(m),false,false);
  return max2f(__uint_as_float(rr[0]),__uint_as_float(rr[1]));
}
__device__ __forceinline__ void pv(f32x16*o,int vb,bf16x8 pa0,bf16x8 pa1,bf16x8 pa2,bf16x8 pa3){
  #pragma unroll
  for(int d0=0;d0<2;++d0){s16x4 lo[4],hi[4];
    #pragma unroll
    for(int ks=0;ks<4;++ks){
      asm volatile("ds_read_b64_tr_b16 %0,%1 offset:%c2":"=&v"(lo[ks]):"v"(vb),"i"(d0*4096+ks*1024):"memory");
      asm volatile("ds_read_b64_tr_b16 %0,%1 offset:%c2":"=&v"(hi[ks]):"v"(vb),"i"(d0*4096+ks*1024+512):"memory");}
    asm volatile("s_waitcnt lgkmcnt(0)":::"memory");SBAR();
    #define PK(k) (bf16x8){lo[k][0],lo[k][1],lo[k][2],lo[k][3],hi[k][0],hi[k][1],hi[k][2],hi[k][3]}
    o[d0]=__builtin_amdgcn_mfma_f32_32x32x16_bf16(pa0,PK(0),o[d0],0,0,0);
    o[d0]=__builtin_amdgcn_mfma_f32_32x32x16_bf16(pa1,PK(1),o[d0],0,0,0);
    o[d0]=__builtin_amdgcn_mfma_f32_32x32x16_bf16(pa2,PK(2),o[d0],0,0,0);
    o[d0]=__builtin_amdgcn_mfma_f32_32x32x16_bf16(pa3,PK(3),o[d0],0,0,0);
    #undef PK
  }
}

template<int MODE,int THRL> __device__ __forceinline__ void attn_unit(int b,int h,int qb,const bf16*Q,const bf16*__restrict__ K,const bf16*__restrict__ V,const bf16*__restrict__ Z,bf16*G,const float*__restrict__ aux,char*shm){
  constexpr int KVW=MODE?256:128;
  const int kvh=MODE?(h>>2):(h>>3);
  int tid_=threadIdx.x; asm volatile("":"+v"(tid_));
  const int tid=tid_,lane=tid&63,r32=lane&31,hi=lane>>5; const int wid=__builtin_amdgcn_readfirstlane(tid>>6);
  const int hw=MODE?h:h+(wid>>2), wrow=MODE?wid*QBLK:(wid&3)*QBLK;
  const long rowbase=(long)b*ASEQ; const int q0=MODE?qb*QB:qb*128;
  const bf16*Qw=Q+(rowbase+q0+wrow)*ADM+hw*D;
  const bf16*Kh=K+rowbase*KVW+kvh*D,*Vh=V+rowbase*KVW+kvh*D;
  const unsigned lds0=(unsigned)(uintptr_t)shm;
  float*wsf=(float*)(shm+LDS_WS)+wid*64;
  const int NT=MODE?(4*qb+4):4;
  const int ktA=MODE?(4*qb):(qb?2*qb-2:0);
  #define KT(s) (MODE?(((s)<4)?(ktA+(s)):((s)-4)):(ktA+(s)))
  if(MODE){ float*km=(float*)(shm+LDS_KM); const float*ks=aux+((size_t)(b*16)*2)*256+kvh*64;
    for(int idx=tid;idx<qb*64;idx+=512){const int j=idx>>6,d=idx&63; km[idx]=(ks[(size_t)(2*j)*256+d]+ks[(size_t)(2*j+1)*256+d])*(1.0f/256.0f);} }
  const unsigned kvoff=(unsigned)(lane*KVW+wid*8)*2u;
  const unsigned vvoff=(unsigned)((16*(wid&3)+(lane>>2))*KVW+(wid>>2)*32+(lane&3)*8)*2u;
  const unsigned kdst=lds0+LDS_K+wid*1024, vdst=lds0+LDS_V+wid*1024;
  #define DMA_K(s,slot) glds16(Kh+(long)KT(s)*KVBLK*KVW,kvoff,(unsigned)__builtin_amdgcn_readfirstlane(kdst+(slot)))
  #define DMA_V(s,slot) glds16(Vh+(long)KT(s)*KVBLK*KVW,vvoff,(unsigned)__builtin_amdgcn_readfirstlane(vdst+(slot)))
  const int vb0=(int)(lds0+LDS_V)+((lane>>4)&1)*32+(lane&3)*8+(4*hi+((lane&15)>>2))*64;
  const char*Kbase=shm+LDS_K; bf16x8 kf[8];
  const lds_cptr shm3=(lds_cptr)shm; const lds_cptr kp0=shm3+LDS_K+hi*1024+r32*16; const lds_cptr vp0=shm3+LDS_V+((lane>>4)&1)*32+(lane&3)*8+(4*hi+((lane&15)>>2))*64;
  DMA_K(0,0);DMA_V(0,0);DMA_K(1,SLOTB);
  bf16x8 qr[4];
  #pragma unroll
  for(int d0=0;d0<4;++d0)qr[d0]=*reinterpret_cast<const bf16x8*>(&Qw[(long)r32*ADM+d0*16+hi*8]);
  float mhat=0.f,l_reg=0.f;f32x16 o[2];o[0]=f32x16{};o[1]=f32x16{};
  const f32x16 zc=f32x16{};
  const int qrel=wrow+r32;
  #define AMASK(P0,P1,s) do{ if(MODE){ if((s)<4)cmask(P0,P1,(s),qrel,hi); } else { wmask(P0,P1,q0+qrel-64*KT(s),hi); } }while(0)
  bool resc=false; unsigned selmask=0u; unsigned pm_=0xffffffffu;
  #define PMOF(s) ((MODE&&(s)>=4)?((((selmask>>((((s)-4)>>2)&31))&1u)!=0u)?0xffffffffu:0u):0xffffffffu)
  #define RESC() do{ if(resc){ asm volatile("s_waitcnt lgkmcnt(0)":::"memory"); \
      _Pragma("unroll") for(int d_=0;d_<2;++d_) _Pragma("unroll") for(int r=0;r<16;++r)o[d_][r]*=wsf[crow(r,hi)]; } }while(0)
  #define REFUPD(C0,C1,rm,LOWOK) do{ resc=false; \
      const float gr_=rm-mhat; \
      if(__builtin_expect(__any((gr_>(float)THRL)||((LOWOK)&&(rm<-60.f)&&(rm>-INFINITY))),0)){ \
        const float dl=((LOWOK)&&(rm<-60.f)&&(rm>-INFINITY))?gr_:__builtin_fmaxf(gr_,0.f); mhat+=dl; \
        const float f=__builtin_amdgcn_exp2f(-dl); l_reg*=f; if(hi==0)wsf[r32]=f; resc=true; } \
      if(__builtin_expect(__any(mhat!=0.f),0)){ _Pragma("unroll") for(int r=0;r<16;++r){C0[r]-=mhat;C1[r]-=mhat;} } }while(0)
  f32x16 pA0,pA1,pB0,pB1;
  int sl_prev=0,sl_cur=0,sl_next=SLOTB;
  #define ROT() do{sl_prev=sl_cur;sl_cur=sl_next;sl_next=(sl_next==(NSLOT-1)*SLOTB)?0:sl_next+SLOTB;}while(0)
  DMA_K(2,2*SLOTB);
  WAIT_BAR(3);
  SBAR();
  if(MODE){
    const float*km=(const float*)(shm+LDS_KM)+8*hi; float qf[32];
    #pragma unroll
    for(int d0=0;d0<4;++d0){
      #pragma unroll
      for(int e=0;e<8;++e)qf[d0*8+e]=__uint_as_float(((unsigned)(unsigned short)qr[d0][e])<<16);}
    float v1=-INFINITY,v2=-INFINITY,v3=-INFINITY; unsigned b1=0u,b2=0u,b3=0u;
    for(int j=0;j<qb;++j){ const float*kp=km+j*64; float g=0.f;
      #pragma unroll
      for(int d0=0;d0<4;++d0){
        #pragma unroll
        for(int e=0;e<8;++e)g+=qf[d0*8+e]*kp[16*d0+e];}
      g+=__shfl_xor(g,32);
      const unsigned bj=1u<<j; const bool c1=g>v1,c2=g>v2,c3=g>v3;
      v3=c2?v2:(c3?g:v3); b3=c2?b2:(c3?bj:b3);
      v2=c1?v1:(c2?g:v2); b2=c1?b1:(c2?bj:b2);
      v1=c1?g:v1;         b1=c1?bj:b1; }
    selmask=b1|b2|b3; asm volatile("":"+v"(selmask)); }
  SBAR();
  qkt(pA0,pA1,Kbase,qr,zc,r32,hi);asm volatile("s_nop 15\n\ts_nop 7":"+v"(pA0),"+v"(pA1));AMASK(pA0,pA1,0);
  { const float rm0=rowmax(pA0,pA1); REFUPD(pA0,pA1,rm0,true); }
  _Pragma("unroll") for(int r=0;r<16;++r)pA0[r]=__builtin_amdgcn_exp2f(pA0[r]);
  _Pragma("unroll") for(int r=0;r<16;++r)pA1[r]=__builtin_amdgcn_exp2f(pA1[r]);
  WAIT_BAR(0);
  DMA_K(3,0);DMA_V(1,SLOTB);
  ROT();
  kload8(kf,kp0+sl_cur);
  WAIT_BAR(2);
  s16x4 vlo[8],vhi[8]; u32x4 pw0,pw1,pw2,pw3;
  #define PKW(P,B) (MODE?(cvtpk_s(P[B],P[B+1])&pm_):cvtpk_s(P[B],P[B+1]))
  #define PAF(k) __builtin_bit_cast(bf16x8,pw##k)
  #define VFR(i) (bf16x8){vlo[i][0],vlo[i][1],vlo[i][2],vlo[i][3],vhi[i][0],vhi[i][1],vhi[i][2],vhi[i][3]}
  #define PIN(x) asm volatile("":"+v"(x))
  #define MX3(a,b,c) __builtin_fmaxf(__builtin_fmaxf((a),(b)),(c))
  #define GAPA(MF,A0,A1,A2,A3,W0,W1,PW) do{ MF; sacc+=A0; sacc+=A1; sacc+=A2; sacc+=A3; PIN(sacc); W0; W1; PIN(PW); SBAR(); }while(0)
  #define EX(v) __builtin_amdgcn_exp2f(v)
  #define GAPB(MF,X,B) do{ MF; X[B]=EX(X[B]); X[B+1]=EX(X[B+1]); X[B+2]=EX(X[B+2]); X[B+3]=EX(X[B+3]); PIN(X); SBAR(); }while(0)
  #define VRD(i) do{ vlo[i]=vtr(vp_+(((i)>>2)*4096+((i)&3)*1024)); vhi[i]=vtr(vp_+(((i)>>2)*4096+((i)&3)*1024+512)); }while(0)
  #define KRD(G,j) do{ if(G){ kload2(kf,kp0+sl_next,j); SBAR(); } }while(0)
  #define STEP(C0,C1,P0,P1,t,GK,GV,GL) do{ SBAR(); \
    const lds_cptr vp_=vp0+sl_prev; \
    VRD(0); SBAR(); float sacc=(P0[0]+P0[1]); \
    GAPA(C0=__builtin_amdgcn_mfma_f32_32x32x16_bf16(kf[0],qr[0],zc,0,0,0), P0[2],P0[3],P0[4],P0[5],     pw0[0]=PKW(P0,0), pw0[1]=PKW(P0,2), pw0); \
    VRD(4); SBAR(); GAPA(C1=__builtin_amdgcn_mfma_f32_32x32x16_bf16(kf[1],qr[0],zc,0,0,0), P0[6],P0[7],P0[8],P0[9],     pw0[2]=PKW(P0,4), pw0[3]=PKW(P0,6), pw0); \
    VRD(1); SBAR(); GAPA(C0=__builtin_amdgcn_mfma_f32_32x32x16_bf16(kf[2],qr[1],C0,0,0,0),   P0[10],P0[11],P0[12],P0[13], pw1[0]=PKW(P0,8), pw1[1]=PKW(P0,10), pw1); \
    VRD(5); SBAR(); GAPA(C1=__builtin_amdgcn_mfma_f32_32x32x16_bf16(kf[3],qr[1],C1,0,0,0),   P0[14],P0[15],P1[0],P1[1],   pw1[2]=PKW(P0,12),pw1[3]=PKW(P0,14), pw1); \
    VRD(2); SBAR(); GAPA(C0=__builtin_amdgcn_mfma_f32_32x32x16_bf16(kf[4],qr[2],C0,0,0,0),   P1[2],P1[3],P1[4],P1[5],     pw2[0]=PKW(P1,0), pw2[1]=PKW(P1,2), pw2); \
    VRD(6); SBAR(); GAPA(C1=__builtin_amdgcn_mfma_f32_32x32x16_bf16(kf[5],qr[2],C1,0,0,0),   P1[6],P1[7],P1[8],P1[9],     pw2[2]=PKW(P1,4), pw2[3]=PKW(P1,6), pw2); \
    VRD(3); SBAR(); GAPA(C0=__builtin_amdgcn_mfma_f32_32x32x16_bf16(kf[6],qr[3],C0,0,0,0),   P1[10],P1[11],P1[12],P1[13], pw3[0]=PKW(P1,8), pw3[1]=PKW(P1,10), pw3); \
    VRD(7); SBAR(); GAPA(C1=__builtin_amdgcn_mfma_f32_32x32x16_bf16(kf[7],qr[3],C1,0,0,0),   P1[14],P1[15],0.f,0.f,       pw3[2]=PKW(P1,12),pw3[3]=PKW(P1,14), pw3); \
    l_reg+=(MODE?(pm_?sacc:0.f):sacc); \
    if(GK){DMA_K((t)+3,sl_cur);} if(GV){DMA_V((t)+1,sl_next);} \
    AMASK(C0,C1,t); \
    { float a=MX3(C0[0],C0[1],C1[0]),b=MX3(C0[2],C0[3],C1[1]); a=MX3(a,C1[2],C1[3]); \
      _Pragma("unroll") for(int r=4;r<16;r+=4){a=MX3(a,C0[r],C0[r+1]);b=MX3(b,C0[r+2],C0[r+3]);a=MX3(a,C1[r],C1[r+1]);b=MX3(b,C1[r+2],C1[r+3]);} \
      float rm=__builtin_fmaxf(a,b); { auto rr=__builtin_amdgcn_permlane32_swap(__float_as_uint(rm),__float_as_uint(rm),false,false); rm=__builtin_fmaxf(__uint_as_float(rr[0]),__uint_as_float(rr[1])); } \
      pm_=PMOF(t); if(MODE){ rm=pm_?rm:-INFINITY; } \
      REFUPD(C0,C1,rm,false); } \
    SBAR(); \
    GAPB(o[0]=__builtin_amdgcn_mfma_f32_32x32x16_bf16(PAF(0),VFR(0),o[0],0,0,0), C0,0); \
    GAPB(o[1]=__builtin_amdgcn_mfma_f32_32x32x16_bf16(PAF(0),VFR(4),o[1],0,0,0), C0,4); \
    KRD(GL,0); GAPB(o[0]=__builtin_amdgcn_mfma_f32_32x32x16_bf16(PAF(1),VFR(1),o[0],0,0,0), C0,8); \
    KRD(GL,1); GAPB(o[1]=__builtin_amdgcn_mfma_f32_32x32x16_bf16(PAF(1),VFR(5),o[1],0,0,0), C0,12); \
    KRD(GL,2); GAPB(o[0]=__builtin_amdgcn_mfma_f32_32x32x16_bf16(PAF(2),VFR(2),o[0],0,0,0), C1,0); \
    KRD(GL,3); GAPB(o[1]=__builtin_amdgcn_mfma_f32_32x32x16_bf16(PAF(2),VFR(6),o[1],0,0,0), C1,4); \
    GAPB(o[0]=__builtin_amdgcn_mfma_f32_32x32x16_bf16(PAF(3),VFR(3),o[0],0,0,0), C1,8); \
    GAPB(o[1]=__builtin_amdgcn_mfma_f32_32x32x16_bf16(PAF(3),VFR(7),o[1],0,0,0), C1,12); \
    }while(0)
  int t=1;
  for(;t+5<NT;t+=2){
    STEP(pB0,pB1,pA0,pA1,t,true,true,true);     WAIT_BAR(2); RESC(); ROT();
    STEP(pA0,pA1,pB0,pB1,t+1,true,true,true);   WAIT_BAR(2); RESC(); ROT();
  }
  #define ENDW(tt) do{ if((tt)+3<NT){WAIT_BAR(2);} else if((tt)+2<NT){WAIT_BAR(1);} else {WAIT_BAR(0);} }while(0)
  for(;t+1<NT;t+=2){
    STEP(pB0,pB1,pA0,pA1,t,(t+3<NT),(t+1<NT),(t+1<NT));       ENDW(t);   RESC(); ROT();
    STEP(pA0,pA1,pB0,pB1,t+1,(t+4<NT),(t+2<NT),(t+2<NT));     ENDW(t+1); RESC(); ROT();
  }
  STEP(pB0,pB1,pA0,pA1,NT-1,false,false,false); RESC();
  { float sacc=pB0[0]+pB0[1]; _Pragma("unroll") for(int r=2;r<16;++r)sacc+=pB0[r]; _Pragma("unroll") for(int r=0;r<16;++r)sacc+=pB1[r]; l_reg+=(MODE?(pm_?sacc:0.f):sacc);
    pw0=(u32x4){PKW(pB0,0),PKW(pB0,2),PKW(pB0,4),PKW(pB0,6)};pw1=(u32x4){PKW(pB0,8),PKW(pB0,10),PKW(pB0,12),PKW(pB0,14)};pw2=(u32x4){PKW(pB1,0),PKW(pB1,2),PKW(pB1,4),PKW(pB1,6)};pw3=(u32x4){PKW(pB1,8),PKW(pB1,10),PKW(pB1,12),PKW(pB1,14)};
    SBAR(); pv(o,vb0+sl_cur,PAF(0),PAF(1),PAF(2),PAF(3)); }
  #undef PKW
  #undef PAF
  #undef VFR
  #undef PIN
  #undef MX3
  #undef GAPA
  #undef GAPB
  #undef EX
  #undef VRD
  #undef KRD
  #undef STEP
  #undef ENDW
  {auto rr=__builtin_amdgcn_permlane32_swap(__float_as_uint(l_reg),__float_as_uint(l_reg),false,false);l_reg=__uint_as_float(rr[0])+__uint_as_float(rr[1]);}
  if(!MODE)l_reg+=__builtin_amdgcn_exp2f(aux[hw]*1.4426950408889634f-mhat);
  long grow0=rowbase+q0+wrow; asm volatile("":"+v"(grow0));
  u32x4 zv[4];
  #pragma unroll
  for(int i=0;i<4;++i){const int row=i*8+(lane>>3),ch=lane&7; zv[i]=*(const u32x4*)(Z+(grow0+row)*ADM+hw*D+ch*8);}
  if(hi==0)wsf[32+r32]=l_reg;asm volatile("s_waitcnt lgkmcnt(0)":::"memory");
  float rli[16];
  #pragma unroll
  for(int r=0;r<16;++r)rli[r]=__builtin_amdgcn_rcpf(wsf[32+crow(r,hi)]);
  { float*stg=(float*)(shm+LDS_OST)+wid*2048;
    #pragma unroll
    for(int r=0;r<16;++r){const int orow=crow(r,hi);
      #pragma unroll
      for(int d0=0;d0<2;++d0)stg[orow*64+d0*32+r32]=o[d0][r]*rli[r];}
    asm volatile("s_waitcnt lgkmcnt(0)":::"memory");
    #pragma unroll
    for(int i=0;i<4;++i){const int row=i*8+(lane>>3),ch=lane&7; const f32x4 a0=*(const f32x4*)(stg+row*64+ch*8),a1=*(const f32x4*)(stg+row*64+ch*8+4);
      float zf[8]; zf[0]=__uint_as_float(zv[i].x<<16);zf[1]=__uint_as_float(zv[i].x&0xffff0000u);zf[2]=__uint_as_float(zv[i].y<<16);zf[3]=__uint_as_float(zv[i].y&0xffff0000u);
      zf[4]=__uint_as_float(zv[i].z<<16);zf[5]=__uint_as_float(zv[i].z&0xffff0000u);zf[6]=__uint_as_float(zv[i].w<<16);zf[7]=__uint_as_float(zv[i].w&0xffff0000u);
      float gv[8];
      #pragma unroll
      for(int e=0;e<8;++e){const float ov=e<4?a0[e]:a1[e-4]; gv[e]=ov*zf[e]*__builtin_amdgcn_rcpf(1.0f+__builtin_amdgcn_exp2f(-1.4426950408889634f*zf[e]));}
      u32x4 w; w.x=cvtpk_s(gv[0],gv[1]);w.y=cvtpk_s(gv[2],gv[3]);w.z=cvtpk_s(gv[4],gv[5]);w.w=cvtpk_s(gv[6],gv[7]);
      *(u32x4*)(G+(grow0+row)*ADM+hw*D+ch*8)=w;} }
  asm volatile("s_waitcnt lgkmcnt(0)\n\ts_barrier":::"memory");
  #undef DMA_K
  #undef DMA_V
  #undef KT
  #undef AMASK
  #undef PMOF
  #undef REFUPD
  #undef RESC
  #undef ROT
}
#undef SBAR
#undef WAIT_BAR
constexpr int M2_ACC=LDS_OST, M2_QN=M2_ACC+65536, M2_LIST=M2_QN+32768, M2_CNT=M2_LIST+7680, M2_NJ=M2_CNT+960, M2_SCHED=M2_NJ+128, M2_LACC=M2_SCHED+128, M2_MACC=M2_LACC+2048, LDS_BYTES_MOBA2=M2_MACC+2048;
typedef __attribute__((address_space(3))) float* lds_fptr;
typedef __attribute__((address_space(3))) unsigned* lds_uptr;
typedef __attribute__((address_space(3))) const unsigned char* lds_bptr;
__device__ __forceinline__ unsigned pk2bf(float lo,float hi){f32x2_t v={lo,hi};bf16x2_t b=__builtin_convertvector(v,bf16x2_t);return __builtin_bit_cast(unsigned,b);}
__device__ __forceinline__ void moba2_flush(const f32x16 (&o)[2],float l_part,float m_part,int kind,lds_bptr lbase,int pos0,int nA,int nv,lds_cptr shm3,lds_fptr wsf,int wid,int r32,int hi){
  const lds_uptr acc=(lds_uptr)(shm3+M2_ACC); const lds_fptr lacc=(lds_fptr)(shm3+M2_LACC), macc=(lds_fptr)(shm3+M2_MACC);
  const float ltot=l_part+__shfl_xor(l_part,32);
  if(kind<2){
    const int base=256*kind+32*wid;
    #pragma unroll
    for(int r=0;r<16;++r)acc[(base+crow(r,hi))*32+r32]=pk2bf(o[0][r],o[1][r]);
    if(hi==0){lacc[base+r32]=ltot; macc[base+r32]=m_part;}
  } else {
    unsigned w4[4];
    #pragma unroll
    for(int g=0;g<4;++g)w4[g]=*(const __attribute__((address_space(3))) unsigned*)(lbase+8*g+4*hi);
    const bool valid=r32<nv; const int ridl=(int)lbase[r32]+((pos0+r32>=nA)?256:0); const float mcur=valid?macc[ridl]:m_part;
    if(!__any(mcur!=m_part)){
      #pragma unroll
      for(int g=0;g<4;++g){ unsigned a[4]; int ix[4];
        #pragma unroll
        for(int q=0;q<4;++q){const int cp=8*g+4*hi+q; ix[q]=((int)((w4[g]>>(8*q))&255u)+((pos0+cp>=nA)?256:0))*32+r32; a[q]=acc[ix[q]];}
        #pragma unroll
        for(int q=0;q<4;++q){ if(8*g+4*hi+q<nv)acc[ix[q]]=pk2bf(__uint_as_float(a[q]<<16)+o[0][4*g+q],__uint_as_float(a[q]&0xffff0000u)+o[1][4*g+q]); }
        asm volatile("":::"memory"); }
      if(hi==0&&valid)lacc[ridl]+=ltot;
    } else {
      const float mn=__builtin_fmaxf(mcur,m_part), fa=__builtin_amdgcn_exp2f(mcur-mn), fp=__builtin_amdgcn_exp2f(m_part-mn);
      if(hi==0){wsf[r32]=fa;wsf[32+r32]=fp;}
      asm volatile("s_waitcnt lgkmcnt(0)":::"memory");
      #pragma unroll
      for(int r=0;r<16;++r){const int cp=crow(r,hi); const int ix=((int)((w4[r>>2]>>(8*(r&3)))&255u)+((pos0+cp>=nA)?256:0))*32+r32; const float far=wsf[cp],fpr=wsf[32+cp];
        if(cp<nv){const unsigned a=acc[ix]; acc[ix]=pk2bf(__uint_as_float(a<<16)*far+o[0][r]*fpr,__uint_as_float(a&0xffff0000u)*far+o[1][r]*fpr);}}
      if(hi==0&&valid){lacc[ridl]=lacc[ridl]*fa+ltot*fp; macc[ridl]=mn;}
      asm volatile("s_waitcnt lgkmcnt(0)":::"memory");
    }
  }
}
__device__ __forceinline__ unsigned moba_gate(const bf16x8 (&qx)[4],lds_cptr kmb,int qb,int r32,int hi){
  f32x16 gacc=f32x16{};
  #pragma unroll
  for(int d0=0;d0<4;++d0){ const bf16x8 ah=*(const __attribute__((address_space(3))) bf16x8*)(kmb+r32*128+((2*d0+hi)<<4)), al=*(const __attribute__((address_space(3))) bf16x8*)(kmb+4096+r32*128+((2*d0+hi)<<4));
    gacc=__builtin_amdgcn_mfma_f32_32x32x16_bf16(ah,qx[d0],gacc,0,0,0); gacc=__builtin_amdgcn_mfma_f32_32x32x16_bf16(al,qx[d0],gacc,0,0,0); }
  float mine[8],oth[8];
  #pragma unroll
  for(int r=0;r<8;++r){mine[r]=gacc[r]; oth[r]=__shfl_xor(mine[r],32);}
  float v1=-INFINITY,v2=-INFINITY,v3=-INFINITY; unsigned b1=0u,b2=0u,b3=0u;
  #pragma unroll
  for(int j=0;j<16;++j){ const int own=(j>>2)&1, r=(j&3)+4*(j>>3); const float g=(hi==own)?mine[r]:oth[r];
    const unsigned bj=1u<<j; const bool in=j<qb; const bool c1=in&&(g>v1),c2=in&&(g>v2),c3=in&&(g>v3);
    v3=c2?v2:(c3?g:v3); b3=c2?b2:(c3?bj:b3);
    v2=c1?v1:(c2?g:v2); b2=c1?b1:(c2?bj:b2);
    v1=c1?g:v1;         b1=c1?bj:b1; }
  return b1|b2|b3;
}
#define SBAR() __builtin_amdgcn_sched_barrier(0)
#define WAIT_BAR(N) asm volatile("s_waitcnt vmcnt(" #N ") lgkmcnt(0)\n\ts_barrier":::"memory")
template<int THRL> __device__ __forceinline__ void attn_unit_moba2(int b,int hp,int qb,const bf16*Q,const bf16*__restrict__ K,const bf16*__restrict__ V,const bf16*__restrict__ Z,bf16*G,const float*__restrict__ KSUM,char*shm){
  constexpr int KVW=256;
  const int kvh=hp>>1, hA=2*hp;
  int tid_=threadIdx.x; asm volatile("":"+v"(tid_));
  const int tid=tid_,lane=tid&63,r32=lane&31,hi=lane>>5; const int wid=__builtin_amdgcn_readfirstlane(tid>>6);
  const long rowbase=(long)b*ASEQ; const int q0=qb*QB;
  const bf16*Kh=K+rowbase*KVW+kvh*D,*Vh=V+rowbase*KVW+kvh*D;
  const bf16*Qu=Q+(rowbase+q0)*ADM+hA*D;
  const unsigned lds0=(unsigned)(uintptr_t)shm;
  const lds_cptr shm3=(lds_cptr)shm;
  const lds_fptr wsf=(lds_fptr)(shm3+LDS_WS)+wid*64;
  const lds_uptr sched=(lds_uptr)(shm3+M2_SCHED);
  const int ktA=4*qb;
  int jseg_cur=0,jseg_nxt=0,gseg=0;
  #define KT(s) ((((s)>>2)<2)?(ktA+((s)&3)):(4*((((s)>>2)==gseg)?jseg_cur:jseg_nxt)+((s)&3)))
  { const float*ks=KSUM+((size_t)(b*16)*2)*256+kvh*64;
    for(int idx=tid;idx<qb*64;idx+=512){const int j=idx>>6,d=idx&63; const float m_=(ks[(size_t)(2*j)*256+d]+ks[(size_t)(2*j+1)*256+d])*(1.0f/256.0f);
      const unsigned hb_=pk2bf(m_,0.f)&0xffffu; const float hf_=__uint_as_float(hb_<<16); const unsigned lb_=pk2bf(m_-hf_,0.f)&0xffffu;
      *(__attribute__((address_space(3))) unsigned short*)(shm3+M2_LIST+idx*2)=(unsigned short)hb_; *(__attribute__((address_space(3))) unsigned short*)(shm3+M2_LIST+4096+idx*2)=(unsigned short)lb_; } }
  { u32x4 qv[4];
    #pragma unroll
    for(int k=0;k<4;++k){const int c=tid+512*k,row=c>>3,ch=c&7; qv[k]=*(const u32x4*)(Qu+(long)row*ADM+D+ch*8);}
    #pragma unroll
    for(int k=0;k<4;++k){const int c=tid+512*k,row=c>>3,ch=c&7; *(__attribute__((address_space(3))) u32x4*)(shm3+M2_QN+row*128+((ch^(row&7))<<4))=qv[k];} }
  const unsigned kvoff=(unsigned)(lane*KVW+wid*8)*2u;
  const unsigned vvoff=(unsigned)((16*(wid&3)+(lane>>2))*KVW+(wid>>2)*32+(lane&3)*8)*2u;
  const unsigned kdst=lds0+LDS_K+wid*1024, vdst=lds0+LDS_V+wid*1024;
  #define DMA_K(s,slot) glds16(Kh+(long)KT(s)*KVBLK*KVW,kvoff,(unsigned)__builtin_amdgcn_readfirstlane(kdst+(slot)))
  #define DMA_V(s,slot) glds16(Vh+(long)KT(s)*KVBLK*KVW,vvoff,(unsigned)__builtin_amdgcn_readfirstlane(vdst+(slot)))
  const char*Kbase=shm+LDS_K; bf16x8 kf[8];
  const lds_cptr kp0=shm3+LDS_K+hi*1024+r32*16; const lds_cptr vp0=shm3+LDS_V+((lane>>4)&1)*32+(lane&3)*8+(4*hi+((lane&15)>>2))*64;
  DMA_K(0,0);DMA_V(0,0);DMA_K(1,SLOTB);
  bf16x8 qr[4];
  #pragma unroll
  for(int d0=0;d0<4;++d0)qr[d0]=*reinterpret_cast<const bf16x8*>(Qu+(long)(32*wid+r32)*ADM+d0*16+hi*8);
  DMA_K(2,2*SLOTB);
  WAIT_BAR(3);
  #define QLOAD(slot_) do{ const int rq_=(slot_); _Pragma("unroll") for(int d0=0;d0<4;++d0)qr[d0]=*(const __attribute__((address_space(3))) bf16x8*)(shm3+M2_QN+rq_*128+((((2*d0+hi)^(rq_&7)))<<4)); }while(0)
  float mhat=0.f,l_reg=0.f;f32x16 o[2];o[0]=f32x16{};o[1]=f32x16{};
  const f32x16 zc=f32x16{};
  const int qrel=wid*QBLK+r32;
  bool resc=false; bool act_cur=true; int kind_cur=0, lofs_cur=0, pos0_cur=0, nA_cur=0, nv_cur=32;
  int NR=0;
  SBAR();
  {
    const lds_cptr km=shm3+M2_LIST;
    const unsigned selA=moba_gate(qr,km,qb,r32,hi);
    bf16x8 qb_[4]; { const int rq_=32*wid+r32;
      #pragma unroll
      for(int d0=0;d0<4;++d0)qb_[d0]=*(const __attribute__((address_space(3))) bf16x8*)(shm3+M2_QN+rq_*128+((((2*d0+hi)^(rq_&7)))<<4)); }
    const unsigned selB=moba_gate(qb_,km,qb,r32,hi);
    const lds_uptr cnt=(lds_uptr)(shm3+M2_CNT);
    { unsigned myA=0u,myB=0u;
      for(int j=0;j<qb;++j){ const unsigned mA=(unsigned)__ballot(((selA>>j)&1u)!=0u&&hi==0), mB=(unsigned)__ballot(((selB>>j)&1u)!=0u&&hi==0);
        if(lane==j){myA=(unsigned)__builtin_popcount(mA); myB=(unsigned)__builtin_popcount(mB);} }
      if(lane<qb){cnt[lane*16+wid]=myA; cnt[lane*16+8+wid]=myB;} }
    asm volatile("s_waitcnt lgkmcnt(0)\n\ts_barrier":::"memory");
    { unsigned nAj=0u,offAj=0u,offBj=0u,totj=0u;
      if(lane<qb){ const __attribute__((address_space(3))) u32x4* cp_=(const __attribute__((address_space(3))) u32x4*)(shm3+M2_CNT+lane*64);
        const u32x4 c0=cp_[0],c1=cp_[1],c2=cp_[2],c3=cp_[3]; const unsigned ca[8]={c0.x,c0.y,c0.z,c0.w,c1.x,c1.y,c1.z,c1.w}, cb[8]={c2.x,c2.y,c2.z,c2.w,c3.x,c3.y,c3.z,c3.w};
        unsigned nB=0u;
        #pragma unroll
        for(int w=0;w<8;++w){ nAj+=ca[w]; nB+=cb[w]; offAj+=(w<wid)?ca[w]:0u; offBj+=(w<wid)?cb[w]:0u; }
        offBj+=nAj; totj=nAj+nB;
        if(wid==0){((lds_uptr)(shm3+M2_NJ))[2*lane]=nAj;((lds_uptr)(shm3+M2_NJ))[2*lane+1]=totj;} }
      const unsigned below=(1u<<r32)-1u;
      for(int j=0;j<qb;++j){ const bool inA=((selA>>j)&1u)!=0u&&hi==0, inB=((selB>>j)&1u)!=0u&&hi==0; const unsigned mA=(unsigned)__ballot(inA), mB=(unsigned)__ballot(inB);
        const unsigned oa=(unsigned)__builtin_amdgcn_readlane((int)offAj,j), ob=(unsigned)__builtin_amdgcn_readlane((int)offBj,j);
        if(inA)*(__attribute__((address_space(3))) unsigned char*)(shm3+M2_LIST+j*512+oa+(unsigned)__builtin_popcount(mA&below))=(unsigned char)(32*wid+r32);
        if(inB)*(__attribute__((address_space(3))) unsigned char*)(shm3+M2_LIST+j*512+ob+(unsigned)__builtin_popcount(mB&below))=(unsigned char)(32*wid+r32); }
      if(wid==0){
        const int tot=(int)totj; const int nr=(tot+255)>>8; int pre=nr;
        #pragma unroll
        for(int d_=1;d_<16;d_<<=1){ const int v_=__shfl_up(pre,d_); if(lane>=d_)pre+=v_; }
        const int k0=pre-nr;
        if(nr>0)sched[k0]=(unsigned)(lane|(0<<8)|((tot<256?tot:256)<<16));
        if(nr>1)sched[k0+1]=(unsigned)(lane|(1<<8)|((tot-256)<<16));
        const int total=__shfl(pre,15); if(lane==0)sched[31]=(unsigned)total; } }
    asm volatile("s_waitcnt lgkmcnt(0)\n\ts_barrier":::"memory");
    NR=__builtin_amdgcn_readfirstlane((int)sched[31]);
  }
  const int NT=4*(2+NR);
  SBAR();
  #define RESC() do{ if(resc){ asm volatile("s_waitcnt lgkmcnt(0)":::"memory"); \
      _Pragma("unroll") for(int d_=0;d_<2;++d_) _Pragma("unroll") for(int r=0;r<16;++r)o[d_][r]*=wsf[crow(r,hi)]; } }while(0)
  #define REFUPD(C0,C1,rm,LOWOK) do{ resc=false; \
      const float gr_=rm-mhat; \
      if(__builtin_expect(__any((gr_>(float)THRL)||((LOWOK)&&(rm<-60.f)&&(rm>-INFINITY))),0)){ \
        const float dl=((LOWOK)&&(rm<-60.f)&&(rm>-INFINITY))?gr_:__builtin_fmaxf(gr_,0.f); mhat+=dl; \
        const float f=__builtin_amdgcn_exp2f(-dl); l_reg*=f; if(hi==0)wsf[r32]=f; resc=true; } \
      if(__builtin_expect(__any(mhat!=0.f),0)){ _Pragma("unroll") for(int r=0;r<16;++r){C0[r]-=mhat;C1[r]-=mhat;} } }while(0)
  f32x16 pA0,pA1,pB0,pB1;
  int sl_prev=0,sl_cur=0,sl_next=SLOTB;
  #define ROT() do{sl_prev=sl_cur;sl_cur=sl_next;sl_next=(sl_next==(NSLOT-1)*SLOTB)?0:sl_next+SLOTB;}while(0)
  qkt(pA0,pA1,Kbase,qr,zc,r32,hi);asm volatile("s_nop 15\n\ts_nop 7":"+v"(pA0),"+v"(pA1));cmask(pA0,pA1,0,qrel,hi);
  { const float rm0=rowmax(pA0,pA1); REFUPD(pA0,pA1,rm0,true); }
  _Pragma("unroll") for(int r=0;r<16;++r)pA0[r]=__builtin_amdgcn_exp2f(pA0[r]);
  _Pragma("unroll") for(int r=0;r<16;++r)pA1[r]=__builtin_amdgcn_exp2f(pA1[r]);
  WAIT_BAR(0);
  DMA_K(3,0);DMA_V(1,SLOTB);
  ROT();
  kload8(kf,kp0+sl_cur);
  WAIT_BAR(2);
  s16x4 vlo[8],vhi[8]; u32x4 pw0,pw1,pw2,pw3;
  #define PKW(P,B) cvtpk_s(P[B],P[B+1])
  #define PAF(k) __builtin_bit_cast(bf16x8,pw##k)
  #define VFR(i) (bf16x8){vlo[i][0],vlo[i][1],vlo[i][2],vlo[i][3],vhi[i][0],vhi[i][1],vhi[i][2],vhi[i][3]}
  #define PIN(x) asm volatile("":"+v"(x))
  #define MX3(a,b,c) __builtin_fmaxf(__builtin_fmaxf((a),(b)),(c))
  #define GAPA(MF,A0,A1,A2,A3,W0,W1,PW) do{ MF; sacc+=A0; sacc+=A1; sacc+=A2; sacc+=A3; PIN(sacc); W0; W1; PIN(PW); SBAR(); }while(0)
  #define EX(v) __builtin_amdgcn_exp2f(v)
  #define GAPB(MF,X,B) do{ MF; X[B]=EX(X[B]); X[B+1]=EX(X[B+1]); X[B+2]=EX(X[B+2]); X[B+3]=EX(X[B+3]); PIN(X); SBAR(); }while(0)
  #define VRD(i) do{ vlo[i]=vtr(vp_+(((i)>>2)*4096+((i)&3)*1024)); vhi[i]=vtr(vp_+(((i)>>2)*4096+((i)&3)*1024+512)); }while(0)
  #define KRD(G,j) do{ if(G){ kload2(kf,kp0+sl_next,j); SBAR(); } }while(0)
  #define QGATHER(k_) do{ const unsigned e_=(unsigned)__builtin_amdgcn_readfirstlane((int)sched[(k_)]); const int j_=(int)(e_&255u), r_=(int)((e_>>8)&255u); \
      const int nA_=__builtin_amdgcn_readfirstlane((int)((lds_uptr)(shm3+M2_NJ))[2*j_]); \
      _Pragma("unroll") for(int q_=0;q_<4;++q_){ const int slot_=32*wid+8*q_+(lane>>3); const int pos_=256*r_+slot_; \
        const int tok_=(int)*(lds_bptr)(shm3+M2_LIST+j_*512+pos_); const int hd_=(pos_>=nA_)?1:0; \
        glds16(Qu,(unsigned)((tok_*ADM+hd_*D)*2+(((lane&7)^(slot_&7))<<4)),(unsigned)__builtin_amdgcn_readfirstlane(lds0+M2_QN+(32*wid+8*q_)*128)); } }while(0)
  #define STEP(C0,C1,P0,P1,t,GK,GV,GL,BND,RF) do{ \
    const bool bnd_=(BND)&&(((t)&3)==0); const bool act_old_=act_cur; const int kind_old_=kind_cur, lofs_old_=lofs_cur, pos0_old_=pos0_cur, nA_old_=nA_cur, nv_old_=nv_cur; \
    if(bnd_){ const int g_=(t)>>2; gseg=g_; jseg_cur=jseg_nxt; jseg_nxt=(g_-1<NR)?(int)(__builtin_amdgcn_readfirstlane((int)sched[g_-1])&255):0; \
      if(g_==1){ kind_cur=1; act_cur=true; QLOAD(32*wid+r32); } \
      else { const unsigned e_=(unsigned)__builtin_amdgcn_readfirstlane((int)sched[g_-2]); const int j_=(int)(e_&255u), r_=(int)((e_>>8)&255u), n_=(int)(e_>>16); \
        kind_cur=2; lofs_cur=j_*512+256*r_+32*wid; pos0_cur=256*r_+32*wid; nA_cur=__builtin_amdgcn_readfirstlane((int)((lds_uptr)(shm3+M2_NJ))[2*j_]); nv_cur=n_-32*wid; act_cur=nv_cur>0; \
        if(act_cur){ QLOAD(32*wid+r32); } } } \
    if(GK){DMA_K((t)+3,sl_cur);} if(GV){DMA_V((t)+1,sl_next);} \
    if((RF)&&(((t)&3)==1)&&((t)>>2)>=1&&((t)>>2)-1<NR){ QGATHER(((t)>>2)-1); rf_=true; } \
    if(act_cur||act_old_){ SBAR(); \
    const lds_cptr vp_=vp0+sl_prev; \
    VRD(0); SBAR(); float sacc=(P0[0]+P0[1]); \
    GAPA(C0=__builtin_amdgcn_mfma_f32_32x32x16_bf16(kf[0],qr[0],zc,0,0,0), P0[2],P0[3],P0[4],P0[5],     pw0[0]=PKW(P0,0), pw0[1]=PKW(P0,2), pw0); \
    VRD(4); SBAR(); GAPA(C1=__builtin_amdgcn_mfma_f32_32x32x16_bf16(kf[1],qr[0],zc,0,0,0), P0[6],P0[7],P0[8],P0[9],     pw0[2]=PKW(P0,4), pw0[3]=PKW(P0,6), pw0); \
    VRD(1); SBAR(); GAPA(C0=__builtin_amdgcn_mfma_f32_32x32x16_bf16(kf[2],qr[1],C0,0,0,0),   P0[10],P0[11],P0[12],P0[13], pw1[0]=PKW(P0,8), pw1[1]=PKW(P0,10), pw1); \
    VRD(5); SBAR(); GAPA(C1=__builtin_amdgcn_mfma_f32_32x32x16_bf16(kf[3],qr[1],C1,0,0,0),   P0[14],P0[15],P1[0],P1[1],   pw1[2]=PKW(P0,12),pw1[3]=PKW(P0,14), pw1); \
    VRD(2); SBAR(); GAPA(C0=__builtin_amdgcn_mfma_f32_32x32x16_bf16(kf[4],qr[2],C0,0,0,0),   P1[2],P1[3],P1[4],P1[5],     pw2[0]=PKW(P1,0), pw2[1]=PKW(P1,2), pw2); \
    VRD(6); SBAR(); GAPA(C1=__builtin_amdgcn_mfma_f32_32x32x16_bf16(kf[5],qr[2],C1,0,0,0),   P1[6],P1[7],P1[8],P1[9],     pw2[2]=PKW(P1,4), pw2[3]=PKW(P1,6), pw2); \
    VRD(3); SBAR(); GAPA(C0=__builtin_amdgcn_mfma_f32_32x32x16_bf16(kf[6],qr[3],C0,0,0,0),   P1[10],P1[11],P1[12],P1[13], pw3[0]=PKW(P1,8), pw3[1]=PKW(P1,10), pw3); \
    VRD(7); SBAR(); GAPA(C1=__builtin_amdgcn_mfma_f32_32x32x16_bf16(kf[7],qr[3],C1,0,0,0),   P1[14],P1[15],0.f,0.f,       pw3[2]=PKW(P1,12),pw3[3]=PKW(P1,14), pw3); \
    l_reg+=sacc; \
    float l_old_=0.f,m_old_=0.f; \
    if(bnd_){ l_old_=l_reg; m_old_=mhat; l_reg=0.f; mhat=0.f; }     \
    if((t)<8)cmask(C0,C1,(t)&3,qrel,hi); \
    { float a=MX3(C0[0],C0[1],C1[0]),b=MX3(C0[2],C0[3],C1[1]); a=MX3(a,C1[2],C1[3]); \
      _Pragma("unroll") for(int r=4;r<16;r+=4){a=MX3(a,C0[r],C0[r+1]);b=MX3(b,C0[r+2],C0[r+3]);a=MX3(a,C1[r],C1[r+1]);b=MX3(b,C1[r+2],C1[r+3]);} \
      float rm=__builtin_fmaxf(a,b); { auto rr=__builtin_amdgcn_permlane32_swap(__float_as_uint(rm),__float_as_uint(rm),false,false); rm=__builtin_fmaxf(__uint_as_float(rr[0]),__uint_as_float(rr[1])); } \
      REFUPD(C0,C1,rm,(t)==4); } \
    SBAR(); \
    GAPB(o[0]=__builtin_amdgcn_mfma_f32_32x32x16_bf16(PAF(0),VFR(0),o[0],0,0,0), C0,0); \
    GAPB(o[1]=__builtin_amdgcn_mfma_f32_32x32x16_bf16(PAF(0),VFR(4),o[1],0,0,0), C0,4); \
    KRD(GL,0); GAPB(o[0]=__builtin_amdgcn_mfma_f32_32x32x16_bf16(PAF(1),VFR(1),o[0],0,0,0), C0,8); \
    KRD(GL,1); GAPB(o[1]=__builtin_amdgcn_mfma_f32_32x32x16_bf16(PAF(1),VFR(5),o[1],0,0,0), C0,12); \
    KRD(GL,2); GAPB(o[0]=__builtin_amdgcn_mfma_f32_32x32x16_bf16(PAF(2),VFR(2),o[0],0,0,0), C1,0); \
    KRD(GL,3); GAPB(o[1]=__builtin_amdgcn_mfma_f32_32x32x16_bf16(PAF(2),VFR(6),o[1],0,0,0), C1,4); \
    GAPB(o[0]=__builtin_amdgcn_mfma_f32_32x32x16_bf16(PAF(3),VFR(3),o[0],0,0,0), C1,8); \
    GAPB(o[1]=__builtin_amdgcn_mfma_f32_32x32x16_bf16(PAF(3),VFR(7),o[1],0,0,0), C1,12); \
    if(bnd_){ asm volatile("s_nop 15\n\ts_nop 7":"+v"(o[0]),"+v"(o[1])); \
      if(act_old_){ moba2_flush(o,l_old_,m_old_,kind_old_,(lds_bptr)(shm3+M2_LIST+lofs_old_),pos0_old_,nA_old_,nv_old_,shm3,wsf,wid,r32,hi); } \
      o[0]=f32x16{};o[1]=f32x16{}; } \
    } else { if(GL){kload8(kf,kp0+sl_next);} resc=false; } \
    }while(0)
  int t=1; bool rf_=false;
  for(;t+5<NT;t+=2){
    rf_=false;
    STEP(pB0,pB1,pA0,pA1,t,true,true,true,false,true);   if(rf_){WAIT_BAR(6);}else{WAIT_BAR(2);} RESC(); ROT();
    STEP(pA0,pA1,pB0,pB1,t+1,true,true,true,true,false);  WAIT_BAR(2); RESC(); ROT();
  }
  #define ENDW(tt) do{ if((tt)+3<NT){WAIT_BAR(2);} else if((tt)+2<NT){WAIT_BAR(1);} else {WAIT_BAR(0);} }while(0)
  for(;t+1<NT;t+=2){
    STEP(pB0,pB1,pA0,pA1,t,(t+3<NT),(t+1<NT),(t+1<NT),false,false);       ENDW(t);   RESC(); ROT();
    STEP(pA0,pA1,pB0,pB1,t+1,(t+4<NT),(t+2<NT),(t+2<NT),true,false);       ENDW(t+1); RESC(); ROT();
  }
  STEP(pB0,pB1,pA0,pA1,NT-1,false,false,false,false,false); RESC();
  if(act_cur){ float sacc=pB0[0]+pB0[1]; _Pragma("unroll") for(int r=2;r<16;++r)sacc+=pB0[r]; _Pragma("unroll") for(int r=0;r<16;++r)sacc+=pB1[r]; l_reg+=sacc;
    pw0=(u32x4){PKW(pB0,0),PKW(pB0,2),PKW(pB0,4),PKW(pB0,6)};pw1=(u32x4){PKW(pB0,8),PKW(pB0,10),PKW(pB0,12),PKW(pB0,14)};pw2=(u32x4){PKW(pB1,0),PKW(pB1,2),PKW(pB1,4),PKW(pB1,6)};pw3=(u32x4){PKW(pB1,8),PKW(pB1,10),PKW(pB1,12),PKW(pB1,14)};
    const int vb0=(int)(lds0+LDS_V)+((lane>>4)&1)*32+(lane&3)*8+(4*hi+((lane&15)>>2))*64;
    SBAR(); pv(o,vb0+sl_cur,PAF(0),PAF(1),PAF(2),PAF(3));
    asm volatile("s_nop 15\n\ts_nop 7":"+v"(o[0]),"+v"(o[1]));
    moba2_flush(o,l_reg,mhat,kind_cur,(lds_bptr)(shm3+M2_LIST+lofs_cur),pos0_cur,nA_cur,nv_cur,shm3,wsf,wid,r32,hi); }
  #undef PKW
  #undef PAF
  #undef VFR
  #undef PIN
  #undef MX3
  #undef GAPA
  #undef GAPB
  #undef EX
  #undef VRD
  #undef KRD
  #undef STEP
  #undef ENDW
  #undef QGATHER
  asm volatile("s_waitcnt lgkmcnt(0)\n\ts_barrier":::"memory");
  { const int hd=wid>>2; long grow0=rowbase+q0+(wid&3)*64; asm volatile("":"+v"(grow0));
    const lds_uptr acc=(lds_uptr)(shm3+M2_ACC)+wid*2048; const lds_fptr lacc=(lds_fptr)(shm3+M2_LACC)+wid*64;
    #pragma unroll
    for(int ib=0;ib<8;ib+=4){
      u32x4 zv[4];
      #pragma unroll
      for(int i=0;i<4;++i){const int row=(ib+i)*8+(lane>>3),ch=lane&7; zv[i]=*(const u32x4*)(Z+(grow0+row)*ADM+(hA+hd)*D+ch*8);}
      #pragma unroll
      for(int i=0;i<4;++i){const int row=(ib+i)*8+(lane>>3),ch=lane&7;
        const u32x4 a0=*(const __attribute__((address_space(3))) u32x4*)(acc+row*32+8*(ch&3)),a1=*(const __attribute__((address_space(3))) u32x4*)(acc+row*32+8*(ch&3)+4);
        const float li=__builtin_amdgcn_rcpf(lacc[row]); const bool up=ch>=4;
        float ov[8]; ov[0]=__uint_as_float(up?(a0.x&0xffff0000u):(a0.x<<16));ov[1]=__uint_as_float(up?(a0.y&0xffff0000u):(a0.y<<16));ov[2]=__uint_as_float(up?(a0.z&0xffff0000u):(a0.z<<16));ov[3]=__uint_as_float(up?(a0.w&0xffff0000u):(a0.w<<16));
        ov[4]=__uint_as_float(up?(a1.x&0xffff0000u):(a1.x<<16));ov[5]=__uint_as_float(up?(a1.y&0xffff0000u):(a1.y<<16));ov[6]=__uint_as_float(up?(a1.z&0xffff0000u):(a1.z<<16));ov[7]=__uint_as_float(up?(a1.w&0xffff0000u):(a1.w<<16));
        float zf[8]; zf[0]=__uint_as_float(zv[i].x<<16);zf[1]=__uint_as_float(zv[i].x&0xffff0000u);zf[2]=__uint_as_float(zv[i].y<<16);zf[3]=__uint_as_float(zv[i].y&0xffff0000u);
        zf[4]=__uint_as_float(zv[i].z<<16);zf[5]=__uint_as_float(zv[i].z&0xffff0000u);zf[6]=__uint_as_float(zv[i].w<<16);zf[7]=__uint_as_float(zv[i].w&0xffff0000u);
        float gv[8];
        #pragma unroll
        for(int e=0;e<8;++e)gv[e]=ov[e]*li*zf[e]*__builtin_amdgcn_rcpf(1.0f+__builtin_amdgcn_exp2f(-1.4426950408889634f*zf[e]));
        u32x4 w; w.x=cvtpk_s(gv[0],gv[1]);w.y=cvtpk_s(gv[2],gv[3]);w.z=cvtpk_s(gv[4],gv[5]);w.w=cvtpk_s(gv[6],gv[7]);
        *(u32x4*)(G+(grow0+row)*ADM+(hA+hd)*D+ch*8)=w;} } }
  asm volatile("s_waitcnt lgkmcnt(0)\n\ts_barrier":::"memory");
  #undef DMA_K
  #undef DMA_V
  #undef KT
  #undef QLOAD
  #undef REFUPD
  #undef RESC
  #undef ROT
}
#undef SBAR
#undef WAIT_BAR
constexpr int ATTN_LDS_BYTES=LDS_BYTES_MOBA2;
}

#define GAS __attribute__((address_space(1)))
#define LAS __attribute__((address_space(3)))
typedef unsigned short bf16;
typedef unsigned v4u __attribute__((ext_vector_type(4)));
typedef float f32x4 __attribute__((ext_vector_type(4)));
typedef short bf16x8 __attribute__((ext_vector_type(8)));
typedef GAS unsigned gu32;
typedef GAS unsigned long long gu64;
#define RLX_AGENT __ATOMIC_RELAXED, __HIP_MEMORY_SCOPE_AGENT
#define LDS_WAIT() asm volatile("s_waitcnt lgkmcnt(0)" ::: "memory")
#define VM_WAIT() asm volatile("s_waitcnt vmcnt(0)" ::: "memory")
__device__ __forceinline__ unsigned long long rt() { return __builtin_amdgcn_s_memrealtime(); }
__device__ __forceinline__ unsigned f2bf(float f) { unsigned u = __builtin_bit_cast(unsigned, f); return (u + 0x7fffu + ((u >> 16) & 1u)) >> 16; }
__device__ __forceinline__ unsigned pk2(float lo, float hi) { return f2bf(lo) | (f2bf(hi) << 16); }

#define XB_TMO      128
#define XB_XCNT(j)  (256  + 64 * (j))
#define XB_XSUB(j)  (1280 + 64 * (j))
#define XB_XGEN(j)  (2304 + 64 * (j))
#define XB_TOP      3328
#define XB_TOPGEN   3392
#define XCD_BAR_WORDS 3456
#define XB_SPIN_CAP (1u << 18)

__device__ __forceinline__ unsigned xb_ld(unsigned* p)              { return __hip_atomic_load(p, __ATOMIC_RELAXED, __HIP_MEMORY_SCOPE_AGENT); }
__device__ __forceinline__ unsigned xb_add(unsigned* p, unsigned v) { return __hip_atomic_fetch_add(p, v, __ATOMIC_RELAXED, __HIP_MEMORY_SCOPE_AGENT); }
__device__ __forceinline__ unsigned xb_xcc_id() { return (unsigned)__builtin_amdgcn_s_getreg((3 << 11) | 20) & 0xFu; }
#define XB_SPIN(cond, bar) do { unsigned _sp = 0; while (cond) { __builtin_amdgcn_s_sleep(1); \
    if ((++_sp & 255u) == 0u) { if (xb_ld(&(bar)[XB_TMO])) break; if (_sp > XB_SPIN_CAP) { atomicAdd(&(bar)[XB_TMO], 1u); break; } } } } while (0)

struct XcdBarrier {
    unsigned* bar; unsigned x;
    volatile LAS unsigned* st;
};

__device__ __forceinline__ XcdBarrier xcd_barrier_post(unsigned* bar, volatile LAS unsigned* st) {
    XcdBarrier b; b.bar = bar; b.x = xb_xcc_id(); b.st = st;
    if (threadIdx.x == 0) (void)xb_add(&bar[XB_XCNT(b.x)], 1u);
    return b;
}
__device__ __forceinline__ void xcd_barrier_complete(unsigned* bar, unsigned x, unsigned& nloc, unsigned& nx) {
    const unsigned G = gridDim.x * gridDim.y * gridDim.z;
    unsigned sum, cnt, mine, sp = 0u;
    for (;;) {
        sum = 0u; cnt = 0u; mine = 0u;
#pragma unroll
        for (unsigned j = 0; j < 16; ++j) { const unsigned c = xb_ld(&bar[XB_XCNT(j)]); sum += c; cnt += (c > 0u) ? 1u : 0u; mine = (j == x) ? c : mine; }
        if (sum == G) break;
        __builtin_amdgcn_s_sleep(1);
        if ((++sp & 255u) == 0u) { if (xb_ld(&bar[XB_TMO])) break; if (sp > XB_SPIN_CAP) { atomicAdd(&bar[XB_TMO], 1u); break; } }
    }
    nloc = mine > 0u ? mine : 1u; nx = cnt > 0u ? cnt : 1u;
}

__device__ __forceinline__ void xcd_barrier(const XcdBarrier& b) {
    asm volatile("s_waitcnt vmcnt(0)" ::: "memory");
    __syncthreads();
    if (threadIdx.x == 0) {
        unsigned* bar = b.bar;
        __builtin_amdgcn_s_waitcnt(0);
        unsigned nloc = b.st[0], nx = b.st[1];
        if (nloc == 0u) { xcd_barrier_complete(bar, b.x, nloc, nx); b.st[0] = nloc; b.st[1] = nx; }
        const unsigned old = xb_add(&bar[XB_XSUB(b.x)], 1u);
        const unsigned gen = old / nloc;
        if (old + 1u == (gen + 1u) * nloc) {
            __builtin_amdgcn_fence(__ATOMIC_RELEASE, "agent");
            asm volatile("s_waitcnt vmcnt(0)" ::: "memory");
            const unsigned og = xb_add(&bar[XB_TOP], 1u);
            const unsigned tg = og / nx;
            if (og + 1u == (tg + 1u) * nx) xb_add(&bar[XB_TOPGEN], 1u);
            else XB_SPIN(xb_ld(&bar[XB_TOPGEN]) == tg, bar);
            __builtin_amdgcn_fence(__ATOMIC_ACQUIRE, "agent");
            xb_add(&bar[XB_XGEN(b.x)], 1u);
            asm volatile("s_waitcnt vmcnt(0)" ::: "memory");
        } else {
            XB_SPIN(xb_ld(&bar[XB_XGEN(b.x)]) == gen, bar);
            __builtin_amdgcn_fence(__ATOMIC_ACQUIRE, "agent");
            asm volatile("s_waitcnt vmcnt(0)" ::: "memory");
        }
    }
    __syncthreads();
}

constexpr int NWAVES = 8;
constexpr int NPH = 14;
constexpr int RING_OFF = 0, RING_BYTES = 131072;
constexpr int LDS_BYTES = 163840;
constexpr int LDSCTL_OFF = LDS_BYTES - 512, MISC_OFF = LDSCTL_OFF + 320;
constexpr int CW_TMO = 0, CW_BAR = 4096;
constexpr size_t CTL_ZERO_BYTES = 64 * 1024;
static_assert((CW_BAR + XCD_BAR_WORDS) * 4 <= (int)CTL_ZERO_BYTES, "barrier words inside the memset region");
static_assert(attn_body::ATTN_LDS_BYTES <= LDSCTL_OFF && attn_body::LDS_BYTES <= RING_BYTES, "attention LDS");

__constant__ const unsigned ROPE_INV_BITS[32] = {0x3f800000u, 0x3f3ff911u, 0x3f0ff59au, 0x3ed7e89bu, 0x3ea1e89bu, 0x3e72d424u, 0x3e361887u, 0x3e088d77u, 0x3dcccccdu, 0x3d99940eu, 0x3d6655c3u, 0x3d2cba15u, 0x3d0186e2u, 0x3cc24350u, 0x3c91ad39u, 0x3c5a7bf1u,
    0x3c23d70au, 0x3bf5b9b0u, 0x3bb8449cu, 0x3b8a2e77u, 0x3b4f3e37u, 0x3b1b690du, 0x3ae91528u, 0x3aaec98eu, 0x3a83126fu, 0x3a44948cu, 0x3a136a16u, 0x39dd1726u, 0x39a5cb5fu, 0x3978a814u, 0x393a7753u, 0x390bd472u};
struct Args { const float* in[7]; float* out; unsigned char* ws; int ph_lo, ph_hi; };

__device__ __forceinline__ void p0_w_item(const float* __restrict__ W, int ldw, int k0, int n0, bool perm, const float* __restrict__ g, bf16_t* __restrict__ Wt, LAS float* scr, int lane) {
#pragma unroll
    for (int kb = 0; kb < 64; kb += 32) { float wv[32];
#pragma unroll
        for (int kk = 0; kk < 32; ++kk) wv[kk] = W[(size_t)(k0 + kb + kk) * ldw + n0 + lane];
#pragma unroll
        for (int kk = 0; kk < 32; ++kk) { const float gv = g ? g[k0 + kb + kk] : 1.0f; scr[(kb + kk) * 65 + lane] = wv[kk] * gv; } }
    LDS_WAIT(); asm volatile("" ::: "memory");
    const int c = lane & 7;
#pragma unroll
    for (int j = 0; j < 8; ++j) { const int n = (lane >> 3) + 8 * j; const int sc = perm ? dmap(n) : n; const LAS float* s = scr + (8 * c) * 65 + sc;
        v4u o; o.x = pk2(s[0 * 65], s[1 * 65]); o.y = pk2(s[2 * 65], s[3 * 65]); o.z = pk2(s[4 * 65], s[5 * 65]); o.w = pk2(s[6 * 65], s[7 * 65]);
        *(GAS v4u*)(Wt + (size_t)(n0 + n) * 1024 + k0 + 8 * c) = o; }
    LDS_WAIT(); asm volatile("" ::: "memory");
}

__global__ void __launch_bounds__(NWAVES * 64, 2) mk_fwd(Args args) {
    extern __shared__ __attribute__((aligned(16))) unsigned char lds[];
    LAS unsigned char* ldsp = (LAS unsigned char*)lds;
    volatile LAS unsigned* MISC = (volatile LAS unsigned*)(ldsp + MISC_OFF);
    const int tid0 = threadIdx.x;
    gu32* ctl = (gu32*)(args.ws + WS_CTL);
    for (int u = tid0; u < (LDS_BYTES - LDSCTL_OFF) / 4; u += NWAVES * 64) ((LAS unsigned*)(ldsp + LDSCTL_OFF))[u] = 0u;
    __syncthreads();
    const int lo = args.ph_lo, hi = args.ph_hi;
    XcdBarrier bar; bar.bar = (unsigned*)(ctl + CW_BAR); bar.x = 0; bar.st = nullptr;
    if (hi - lo > 1) bar = xcd_barrier_post((unsigned*)(ctl + CW_BAR), MISC + 8);

    for (int p = lo; p < hi; ++p) {
        int tid = threadIdx.x, G = gridDim.x, bx = blockIdx.x; asm volatile("" : "+v"(tid), "+s"(G), "+s"(bx));
        const int lane = tid & 63, wave = __builtin_amdgcn_readfirstlane(tid >> 6);
        const int vcu = (G % 8 == 0) ? (bx % 8) * (G / 8) + bx / 8 : bx;
        const int gw = vcu * NWAVES + wave, NGW = G * NWAVES;
        GAS unsigned char* wsg = (GAS unsigned char*)args.ws; asm volatile("" : "+s"(wsg)); unsigned char* ws = (unsigned char*)wsg;
#define xin (args.in[0])
#define norm_g (args.in[1])
#define w_in_a (args.in[2])
#define sinks_a (args.in[3])
#define w_in_b (args.in[4])
#define w_out (args.in[5])
#define final_g (args.in[6])
#define H (args.out)
#define rope ((float*)(ws + WS_ROPE))
#define ss ((float*)(ws + WS_SS))
#define KS ((float*)(ws + WS_KS))
#define Hb ((bf16_t*)(ws + WS_HB))
#define Qb ((bf16_t*)(ws + WS_Q))
#define Zb ((bf16_t*)(ws + WS_Z))
#define Gb ((bf16_t*)(ws + WS_G))
#define Kb ((bf16_t*)(ws + WS_K))
#define Vb ((bf16_t*)(ws + WS_V))
        if (p == 0) {
            for (int idx = bx * (NWAVES * 64) + tid; idx < SEQ * 32; idx += G * NWAVES * 64) {
                const int pos = idx >> 5, i = idx & 31;
                const float ang = (float)pos * __uint_as_float(ROPE_INV_BITS[i]);
                float sn, cs; sincosf(ang, &sn, &cs);
                rope[2 * idx] = cs; rope[2 * idx + 1] = sn;
            }
            LAS float* scr = (LAS float*)(ldsp + RING_OFF + wave * 16640);
            constexpr int I_A = (IN_A / 64) * 16, I_B = (IN_B / 64) * 16, I_O = 256, I_L2 = I_A + I_O + I_B + I_O, NITEMS = 2 * I_L2;
            for (int it = gw; it < NITEMS; it += NGW) {
                const int l2 = it / I_L2; int r = it % I_L2; int l; bool isw2 = false; int IN = IN_A;
                if (r < I_A) { l = 2 * l2; }
                else if (r < I_A + I_O) { r -= I_A; l = 2 * l2; isw2 = true; }
                else if (r < I_A + I_O + I_B) { r -= I_A + I_O; l = 2 * l2 + 1; IN = IN_B; }
                else { r -= I_A + I_O + I_B; l = 2 * l2 + 1; isw2 = true; }
                const int cg = r >> 4, kg = r & 15;
                if (isw2) p0_w_item(w_out + (size_t)l * DM * DM, DM, kg * 64, cg * 64, false, nullptr, (bf16_t*)(ws + WS_W2T + l * W2T_STRIDE), scr, lane);
                else { const float* Win = (l & 1) ? w_in_b + (size_t)l2 * DM * IN_B : w_in_a + (size_t)l2 * DM * IN_A; const int kvw = (l & 1) ? 256 : 128;
                       p0_w_item(Win, IN, kg * 64, cg * 64, cg * 64 < 1024 + kvw, norm_g + l * DM, (bf16_t*)(ws + WS_W1T + l * W1T_STRIDE), scr, lane); }
            }
            for (int row = gw; row < M; row += 2 * NGW) {
                const int row2 = row + NGW; const bool two = row2 < M;
                const f32x4* xr = (const f32x4*)(xin + (size_t)row * DM) + lane; const f32x4* xr2 = (const f32x4*)(xin + (size_t)(two ? row2 : row) * DM) + lane;
                f32x4 va[4], vb[4];
#pragma unroll
                for (int j = 0; j < 4; ++j) { va[j] = xr[64 * j]; vb[j] = xr2[64 * j]; }
                float s = 0.f, s2 = 0.f;
                unsigned long long* o8 = (unsigned long long*)(Hb + (size_t)row * DM) + lane; unsigned long long* o82 = (unsigned long long*)(Hb + (size_t)row2 * DM) + lane;
#pragma unroll
                for (int j = 0; j < 4; ++j) { const f32x4 v = va[j]; s += (v[0] * v[0] + v[1] * v[1]) + (v[2] * v[2] + v[3] * v[3]);
                    o8[64 * j] = (unsigned long long)pk2(v[0], v[1]) | ((unsigned long long)pk2(v[2], v[3]) << 32);
                    const f32x4 w = vb[j]; s2 += (w[0] * w[0] + w[1] * w[1]) + (w[2] * w[2] + w[3] * w[3]);
                    if (two) o82[64 * j] = (unsigned long long)pk2(w[0], w[1]) | ((unsigned long long)pk2(w[2], w[3]) << 32); }
                s = wave_sum(s); s2 = wave_sum(s2);
                if (lane < 4) { ss[(size_t)row * 4 + lane] = lane == 0 ? s : 0.f; if (two) ss[(size_t)row2 * 4 + lane] = lane == 0 ? s2 : 0.f; }
            }
        } else if (p == NPH - 1) {
            for (int row = gw; row < M; row += NGW) {
                const unsigned long long* hr = (const unsigned long long*)(Hb + (size_t)row * DM) + lane; f32x4* orow = (f32x4*)(H + (size_t)row * DM) + lane; const f32x4* gr = (const f32x4*)final_g + lane;
                unsigned long long hv[4];
#pragma unroll
                for (int j = 0; j < 4; ++j) hv[j] = hr[64 * j];
                const f32x4 s0 = *(const f32x4*)(ss + (size_t)row * 4);
                const float tot = (s0[0] + s0[1]) + (s0[2] + s0[3]);
                const float rstd = __builtin_amdgcn_rsqf(tot * (1.0f / DM) + EPS);
#pragma unroll
                for (int j = 0; j < 4; ++j) { const unsigned lo = (unsigned)hv[j], hi2 = (unsigned)(hv[j] >> 32);
                    const f32x4 v = (f32x4){__uint_as_float(lo << 16), __uint_as_float(lo & 0xffff0000u), __uint_as_float(hi2 << 16), __uint_as_float(hi2 & 0xffff0000u)};
                    orow[64 * j] = v * rstd * gr[64 * j]; }
            }
        } else {
            const int l = (p - 1) / 3, kind = (p - 1) % 3; const bool isB = l & 1;
            if (kind == 0) {
                const bf16_t* W1t = (const bf16_t*)(ws + WS_W1T + l * W1T_STRIDE);
                if (!isB) { pg8::Gemm g{Hb, W1t, M, IN_A, DM}; pg8::StaticOrder S; S.init(M, IN_A, G, bx);
                    pg8::EpiG1<2> E{Qb, Kb, Vb, Zb, ss, rope, KS};
                    pg8::gemm_phase<pg8::EpiG1<2>, pg8::StaticOrder, true, true>(ldsp + RING_OFF, g, S, E);
                } else { pg8::Gemm g{Hb, W1t, M, IN_B, DM}; pg8::StaticOrder S; S.init(M, IN_B, G, bx);
                    pg8::EpiG1<4> E{Qb, Kb, Vb, Zb, ss, rope, KS};
                    pg8::gemm_phase<pg8::EpiG1<4>, pg8::StaticOrder, true, true>(ldsp + RING_OFF, g, S, E); }
            } else if (kind == 1) {
                if (!isB) {
                    for (int U = vcu; U < 2048; U += G) { const int vc = U & 255, i = U >> 8; const int bp = vc >> 2, qb = (vc & 3) * 8 + i;
                        attn_body::attn_unit<0, 8>(bp >> 3, (bp & 7) * 2, qb, Qb, Kb, Vb, Zb, Gb, sinks_a + (l >> 1) * NH, (char*)lds + RING_OFF); }
                } else {
                    for (int U = vcu; U < 1024; U += G) { const int vc = U & 255, i = U >> 8; const int grp = vc >> 2, c4 = vc & 3;
                        const int x = c4 == 0 ? 5 : c4 == 1 ? 4 : c4 == 2 ? 6 : 7; const int qb = i == 0 ? c4 : i == 1 ? 15 - c4 : i == 2 ? x : 15 - x;
                        attn_body::attn_unit_moba2<8>(grp >> 3, grp & 7, qb, Qb, Kb, Vb, Zb, Gb, KS, (char*)lds + RING_OFF); }
                }
            } else {
                const bf16_t* W2t = (const bf16_t*)(ws + WS_W2T + l * W2T_STRIDE);
                {
                pg8::Gemm g{Gb, W2t, M, DM, DM}; pg8::StaticOrder S; S.init(M, DM, G, bx);
                if (l == 0) { pg8::EpiG2<true, false> E{xin, H, Hb, ss, (LAS float*)(ldsp + RING_BYTES)}; pg8::gemm_phase<pg8::EpiG2<true, false>, pg8::StaticOrder, true, true>(ldsp + RING_OFF, g, S, E); }
                else { pg8::EpiG2<false, false> E{xin, H, Hb, ss, (LAS float*)(ldsp + RING_BYTES)}; pg8::gemm_phase<pg8::EpiG2<false, false>, pg8::StaticOrder, true, true>(ldsp + RING_OFF, g, S, E); } }
            }
        }
        if (p + 1 < hi) { XcdBarrier b2 = bar; GAS unsigned* bg = (GAS unsigned*)bar.bar; asm volatile("" : "+s"(bg), "+s"(b2.x)); b2.bar = (unsigned*)bg; xcd_barrier(b2); }
    }
#undef xin
#undef norm_g
#undef w_in_a
#undef sinks_a
#undef w_in_b
#undef w_out
#undef final_g
#undef H
#undef rope
#undef ss
#undef KS
#undef Hb
#undef Qb
#undef Zb
#undef Gb
#undef Kb
#undef Vb
}

extern "C" void kernel_launch(void* const* d_in, const int* in_sizes, int n_in, void* d_out, int out_size, void* d_ws, size_t ws_size, hipStream_t stream) {
    static int grid = 0;
    if (grid == 0) {
        if (n_in != 7 || in_sizes[0] != M * DM || out_size != M * DM || ws_size < WS_END) { fprintf(stderr, "kernel_launch: unexpected shapes (n_in %d, in0 %d, out %d, ws %zu)\n", n_in, n_in > 0 ? in_sizes[0] : -1, out_size, ws_size); grid = -1; return; }
        int dev = 0, cus = 0, per_cu = 0;
        if (hipGetDevice(&dev) != hipSuccess || hipDeviceGetAttribute(&cus, hipDeviceAttributeMultiprocessorCount, dev) != hipSuccess) { grid = -1; return; }
        if (hipFuncSetAttribute((const void*)mk_fwd, hipFuncAttributeMaxDynamicSharedMemorySize, LDS_BYTES) != hipSuccess) { fprintf(stderr, "kernel_launch: hipFuncSetAttribute failed\n"); grid = -1; return; }
        if (hipOccupancyMaxActiveBlocksPerMultiprocessor(&per_cu, (const void*)mk_fwd, NWAVES * 64, LDS_BYTES) != hipSuccess || per_cu < 1) fprintf(stderr, "kernel_launch: occupancy query reports %d blocks per CU\n", per_cu);
        (void)hipGetLastError();
        grid = cus;
    }
    if (grid < 0) return;
    (void)hipMemsetAsync((unsigned char*)d_ws + WS_CTL, 0, CTL_ZERO_BYTES, stream);
    Args a{};
    for (int i = 0; i < 7; ++i) a.in[i] = (const float*)d_in[i];
    a.out = (float*)d_out; a.ws = (unsigned char*)d_ws; a.ph_lo = 0; a.ph_hi = NPH;
    hipLaunchKernelGGL(mk_fwd, dim3(grid), dim3(NWAVES * 64), LDS_BYTES, stream, a);
}
```
